# Optimizing an MI355X kernel written in HIP

```python
import jax, jax.numpy as jnp
from jax import lax
import numpy as np

D_MODEL = 1024
BATCH = 32
SEQ = 2048
DEPTH = 1

EPS = 1e-6
LN_EPS = 1e-5
N_Q_HEADS = 8
N_KV_HEADS = 2
HEAD_DIM = 64
Q_PER_KV = N_Q_HEADS // N_KV_HEADS
ATTN_WIDTH = N_Q_HEADS * HEAD_DIM
KV_WIDTH = N_KV_HEADS * HEAD_DIM
WINDOW = 128
BLOCK = 128
GMLP_GROUPS = 4
GMLP_GROUP_WIDTH = 128
GMLP_WIDTH = GMLP_GROUPS * GMLP_GROUP_WIDTH
CHUNK = 128
D_FF = -(-8 * D_MODEL // (3 * 256)) * 256
IN_WIDTH = ATTN_WIDTH + 2 * KV_WIDTH + 2 * GMLP_WIDTH + 2 * D_MODEL

kernel_name = "hybrid_swa_sink_gmlp_gated_block"


def rms_norm(x, g):
    xf = x.astype(jnp.float32)
    y = xf * lax.rsqrt(jnp.mean(xf * xf, axis=-1, keepdims=True) + EPS)
    return (y * g.astype(jnp.float32)).astype(x.dtype)


def layer_norm(x, g, b):
    xf = x.astype(jnp.float32)
    mu = jnp.mean(xf, axis=-1, keepdims=True)
    var = jnp.mean(jnp.square(xf - mu), axis=-1, keepdims=True)
    y = (xf - mu) * lax.rsqrt(var + LN_EPS)
    return (y * g.astype(jnp.float32) + b.astype(jnp.float32)).astype(x.dtype)


def alibi_slopes(n_heads):
    return 2.0 ** (-8.0 * jnp.arange(1, n_heads + 1, dtype=jnp.float32) / n_heads)


def banded_sink_attention(q, k, v, sinks):
    B, S = q.shape[0], q.shape[1]
    nb = S // BLOCK
    qb = q.reshape(B, nb, BLOCK, N_KV_HEADS, Q_PER_KV, HEAD_DIM)
    pad = ((0, 0), (BLOCK, 0), (0, 0), (0, 0))
    kp = jnp.pad(k, pad).reshape(B, nb + 1, BLOCK, N_KV_HEADS, HEAD_DIM)
    vp = jnp.pad(v, pad).reshape(B, nb + 1, BLOCK, N_KV_HEADS, HEAD_DIM)
    kb = jnp.concatenate([kp[:, :-1], kp[:, 1:]], axis=2)
    vb = jnp.concatenate([vp[:, :-1], vp[:, 1:]], axis=2)
    scale = HEAD_DIM ** -0.5
    s = jnp.einsum('bnqhgd,bnkhd->bhgnqk', qb, kb).astype(jnp.float32) * scale
    a = jnp.arange(BLOCK)[:, None]
    j = jnp.arange(2 * BLOCK)[None, :]
    rel = BLOCK + a - j
    blk = jnp.arange(nb)[:, None, None]
    s_abs = (blk - 1) * BLOCK + j[None]
    valid = (rel[None] >= 0) & (rel[None] < WINDOW) & (s_abs >= 0)
    slopes = alibi_slopes(N_Q_HEADS).reshape(N_KV_HEADS, Q_PER_KV)
    alibi = -slopes[:, :, None, None, None] * rel.astype(jnp.float32)[None, None, None]
    logits = jnp.where(valid, s + alibi, -1e30)
    sink = sinks.astype(jnp.float32).reshape(N_KV_HEADS, Q_PER_KV)[:, :, None, None]
    m = jnp.maximum(jnp.max(logits, axis=-1), sink)
    p = jnp.exp(logits - m[..., None])
    denom = jnp.sum(p, axis=-1) + jnp.exp(sink - m)
    probs = (p / denom[..., None]).astype(v.dtype)
    o = jnp.einsum('bhgnqk,bnkhd->bnqhgd', probs, vb)
    return o.reshape(B, S, ATTN_WIDTH)


def chunked_spatial_gating(z, ln_g, ln_b, w_s, b_s):
    B, S = z.shape[0], z.shape[1]
    u, v = jnp.split(z, 2, axis=-1)
    v = layer_norm(v, ln_g, ln_b)
    nc = S // CHUNK
    vc = v.reshape(B, nc, CHUNK, GMLP_GROUPS, GMLP_GROUP_WIDTH)
    causal = jnp.tril(jnp.ones((CHUNK, CHUNK), dtype=w_s.dtype))
    w = w_s * causal[None]
    f = jnp.einsum('gts,bnsgc->bntgc', w, vc) + b_s.T[:, :, None]
    return u * f.reshape(B, S, GMLP_WIDTH)


def mixer_block(xn, w_in, attn_sinks, gmlp_ln_g, gmlp_ln_b, gmlp_w_s, gmlp_b_s,
                w_attn_branch, w_gmlp_branch, w_out):
    B, S = xn.shape[0], xn.shape[1]
    proj = jnp.einsum('bsd,de->bse', xn, w_in)
    splits = np.cumsum([ATTN_WIDTH, KV_WIDTH, KV_WIDTH, 2 * GMLP_WIDTH, D_MODEL])
    q, k, v, zg, g_a, g_b = jnp.split(proj, splits, axis=-1)
    q = q.reshape(B, S, N_Q_HEADS, HEAD_DIM)
    k = k.reshape(B, S, N_KV_HEADS, HEAD_DIM)
    v = v.reshape(B, S, N_KV_HEADS, HEAD_DIM)
    attn = banded_sink_attention(q, k, v, attn_sinks)
    gm = chunked_spatial_gating(jax.nn.gelu(zg, approximate=False),
                                gmlp_ln_g, gmlp_ln_b, gmlp_w_s, gmlp_b_s)
    br_a = jnp.einsum('bse,ed->bsd', attn, w_attn_branch)
    br_b = jnp.einsum('bse,ed->bsd', gm, w_gmlp_branch)
    merged = jax.nn.sigmoid(g_a) * br_a + jax.nn.sigmoid(g_b) * br_b
    return jnp.einsum('bsd,de->bse', merged, w_out)


def swiglu(x, w_gate, w_up, w_down):
    h = jax.nn.silu(jnp.einsum('bsd,df->bsf', x, w_gate)) * jnp.einsum('bsd,df->bsf', x, w_up)
    return jnp.einsum('bsf,fd->bsd', h, w_down)


def setup_inputs(seed: int = 0) -> dict:
    key = jax.random.key(seed)
    ks = jax.random.split(key, 20)
    f32 = jnp.float32

    def nrm(k, shape, scale):
        return jax.random.normal(k, shape, f32) * scale

    def gain(k, n):
        return 1.0 + 0.05 * jax.random.normal(k, (DEPTH, n), f32)

    return {
        "x": jax.random.normal(ks[0], (BATCH, SEQ, D_MODEL), f32),
        "norm_mix_pre": gain(ks[1], D_MODEL),
        "w_in": nrm(ks[2], (DEPTH, D_MODEL, IN_WIDTH), D_MODEL ** -0.5),
        "attn_sinks": nrm(ks[3], (DEPTH, N_Q_HEADS), 0.5),
        "gmlp_ln_g": gain(ks[4], GMLP_WIDTH),
        "gmlp_ln_b": nrm(ks[5], (DEPTH, GMLP_WIDTH), 0.02),
        "gmlp_w_s": nrm(ks[6], (DEPTH, GMLP_GROUPS, CHUNK, CHUNK), CHUNK ** -0.5),
        "gmlp_b_s": 1.0 + 0.1 * jax.random.normal(ks[7], (DEPTH, GMLP_GROUPS, CHUNK), f32),
        "w_attn_branch": nrm(ks[8], (DEPTH, ATTN_WIDTH, D_MODEL), ATTN_WIDTH ** -0.5),
        "w_gmlp_branch": nrm(ks[9], (DEPTH, GMLP_WIDTH, D_MODEL), GMLP_WIDTH ** -0.5),
        "w_out": nrm(ks[10], (DEPTH, D_MODEL, D_MODEL), D_MODEL ** -0.5),
        "norm_mix_post": gain(ks[11], D_MODEL),
        "norm_ffn_pre": gain(ks[12], D_MODEL),
        "w_ffn_gate": nrm(ks[13], (DEPTH, D_MODEL, D_FF), D_MODEL ** -0.5),
        "w_ffn_up": nrm(ks[14], (DEPTH, D_MODEL, D_FF), D_MODEL ** -0.5),
        "w_ffn_down": nrm(ks[15], (DEPTH, D_FF, D_MODEL), D_FF ** -0.5),
        "norm_ffn_post": gain(ks[16], D_MODEL),
    }


def reference(x, norm_mix_pre, w_in, attn_sinks, gmlp_ln_g, gmlp_ln_b, gmlp_w_s, gmlp_b_s,
              w_attn_branch, w_gmlp_branch, w_out, norm_mix_post, norm_ffn_pre,
              w_ffn_gate, w_ffn_up, w_ffn_down, norm_ffn_post):
    h = x
    for l in range(DEPTH):
        xn = rms_norm(h, norm_mix_pre[l])
        mix = mixer_block(xn, w_in[l], attn_sinks[l], gmlp_ln_g[l], gmlp_ln_b[l],
                          gmlp_w_s[l], gmlp_b_s[l], w_attn_branch[l], w_gmlp_branch[l], w_out[l])
        h = h + rms_norm(mix, norm_mix_post[l])
        hn = rms_norm(h, norm_ffn_pre[l])
        ff = swiglu(hn, w_ffn_gate[l], w_ffn_up[l], w_ffn_down[l])
        h = h + rms_norm(ff, norm_ffn_post[l])
    return h
```

```cpp
#include <hip/hip_runtime.h>
#include <hip/hip_cooperative_groups.h>
#include <cstdio>
#include <cstdint>
namespace cg = cooperative_groups;
#ifndef MK_N_LAUNCHES
#define MK_N_LAUNCHES 1
#endif
namespace pg8 {
#define PG8_LAS __attribute__((address_space(3)))
typedef unsigned short bf16_t;
typedef short bf16x8 __attribute__((ext_vector_type(8)));
typedef float f32x4 __attribute__((ext_vector_type(4)));
typedef unsigned u32x4 __attribute__((ext_vector_type(4)));
constexpr int BM = 256, BK = 64, HALF = 128, HTB = HALF * BK * 2  , STAGE_BYTES = 8 * HTB, NXCD = 8, WGM = 8;

__host__ __device__ __forceinline__ int lds_byte(int r, int c) { const int st = (r >> 4) * 2 + (c >> 5), rr = r & 15, cc = c & 31, ob = rr * 64 + cc * 2; return st * 1024 + (ob ^ (((ob >> 9) & 1) << 5)); }
__host__ __device__ __forceinline__ void stage_rc(int b, int& R, int& C) { const int st = b / 1024, sb = b % 1024, swz = sb ^ (((sb >> 9) & 1) << 5); R = (st >> 1) * 16 + swz / 64; C = (st & 1) * 32 + (swz % 64) / 2; }
__host__ __device__ __forceinline__ int perm32(int rho) { const int n = rho >> 4, i = rho & 15; return 8 * (i >> 2) + 4 * n + (i & 3); }

struct Unit { int pm, pn; };
struct Gemm { const bf16_t* A; const bf16_t* Bt; int M, N, K; };

struct StaticOrder {
    int nM, nN, nwg, G, c;
    __host__ __device__ void init(int M, int N, int G_, int c_) { nM = M / BM; nN = N / BM; nwg = nM * nN; G = G_; c = c_; }
    __host__ __device__ bool next(int i, Unit& u) const {
        const long L = (long)i * G + c; if (L >= nwg) return false;
        int wgid = (int)L; { const int q = nwg / NXCD, r = nwg % NXCD, xcd = wgid % NXCD, off = wgid / NXCD; wgid = (xcd < r ? xcd * (q + 1) : r * (q + 1) + (xcd - r) * q) + off; }
        const int nig = WGM * nN, gid = wgid / nig, fm = gid * WGM, gsz = (nM - fm) < WGM ? (nM - fm) : WGM;
        u.pm = fm + ((wgid % nig) % gsz); u.pn = (wgid % nig) / gsz; return true;
    }
    __device__ __forceinline__ void a_ready(const Unit&) const {}
    __device__ __forceinline__ void done(const Unit&) const {}
};

__device__ __forceinline__ unsigned cvt_pk_bf16(float lo, float hi) { unsigned r; asm volatile("v_cvt_pk_bf16_f32 %0, %1, %2" : "=v"(r) : "v"(lo), "v"(hi)); return r; }
typedef float f32x2 __attribute__((ext_vector_type(2)));
__device__ __forceinline__ f32x2 gelu_pk(f32x2 v) {
    const f32x2 av = __builtin_elementwise_abs(v), d = av * 0.2316418882f + 1.0f;
    f32x2 t; t.x = __builtin_amdgcn_rcpf(d.x); t.y = __builtin_amdgcn_rcpf(d.y);
    f32x2 q = t * 0.5307027145f + (-0.7265760135f); q = q * t + 0.7107068705f; q = q * t + (-0.142248368f); q = q * t + 0.127414796f; q = q * t;
    const f32x2 s = (v * v) * (-0.72134752044f);
    f32x2 e; e.x = __builtin_amdgcn_exp2f(s.x); e.y = __builtin_amdgcn_exp2f(s.y);
    const f32x2 m = v * (q * e), r = v - m;
    f32x2 o; o.x = v.x < 0.f ? m.x : r.x; o.y = v.y < 0.f ? m.y : r.y; return o;
}
typedef __bf16 bf16x2_t __attribute__((ext_vector_type(2)));
__device__ __forceinline__ unsigned cvtpk(float lo, float hi) { f32x2 v = {lo, hi}; bf16x2_t b = __builtin_convertvector(v, bf16x2_t); return __builtin_bit_cast(unsigned, b); }
__device__ __forceinline__ float bflo(unsigned u) { return __uint_as_float(u << 16); }
__device__ __forceinline__ float bfhi(unsigned u) { return __uint_as_float(u & 0xffff0000u); }
__device__ __forceinline__ float sigm(float x) { return __builtin_amdgcn_rcpf(1.0f + __builtin_amdgcn_exp2f(-1.4426950408889634f * x)); }
__device__ __forceinline__ u32x4 pack8(f32x4 v0, f32x4 v1) { u32x4 w; w.x = cvtpk(v0[0], v0[1]); w.y = cvtpk(v0[2], v0[3]); w.z = cvtpk(v1[0], v1[1]); w.w = cvtpk(v1[2], v1[3]); return w; }
constexpr int PROJ_LD = 3840;
constexpr float QSCALE = 0.125f * 1.4426950408889634f;

struct EpiProj {
    static constexpr bool PERM = true, AFTER_DRAIN = false, MID = false;
    bf16_t* O;
    __device__ __forceinline__ void mid(f32x4 (&)[2][2][4][2], const Unit&, int, int, int, int) const {}
    __device__ __forceinline__ void operator()(const f32x4 (&acc)[2][2][4][2], const Unit& u, int wr, int wc, int fr, int fq) const {
        const int row0 = u.pm * BM + wr * 64 + fr, col0 = u.pn * BM + wc * 32 + 8 * fq;
        const int mode = u.pn < 3 ? 0 : (u.pn < 7 ? 1 : 2); const float sc = u.pn < 2 ? QSCALE : 1.0f;
#pragma unroll
        for (int ai = 0; ai < 2; ++ai)
#pragma unroll
            for (int m = 0; m < 4; ++m) { bf16_t* rowp = O + (size_t)(row0 + ai * HALF + m * 16) * PROJ_LD + col0;
#pragma unroll
                for (int bj = 0; bj < 2; ++bj) { f32x4 v0 = acc[ai][bj][m][0], v1 = acc[ai][bj][m][1];
                    if (mode == 1) { f32x2 a = gelu_pk((f32x2){v0[0], v0[1]}), b = gelu_pk((f32x2){v0[2], v0[3]}), c = gelu_pk((f32x2){v1[0], v1[1]}), d = gelu_pk((f32x2){v1[2], v1[3]});
                        v0 = (f32x4){a.x, a.y, b.x, b.y}; v1 = (f32x4){c.x, c.y, d.x, d.y}; }
                    else if (mode == 2) { v0 = (f32x4){sigm(v0[0]), sigm(v0[1]), sigm(v0[2]), sigm(v0[3])}; v1 = (f32x4){sigm(v1[0]), sigm(v1[1]), sigm(v1[2]), sigm(v1[3])}; }
                    else { v0 = v0 * sc; v1 = v1 * sc; }
                    *(u32x4*)(rowp + bj * HALF) = pack8(v0, v1); } }
    }
};
struct EpiMerge {
    static constexpr bool PERM = true, AFTER_DRAIN = false, MID = true;
    const bf16_t* P; bf16_t* O;
    __device__ __forceinline__ void mid(f32x4 (&acc)[2][2][4][2], const Unit& u, int wr, int wc, int fr, int fq) const {
        asm volatile("" : "+v"(fr), "+v"(fq));
        const int row0 = u.pm * BM + wr * 64 + fr, col0 = u.pn * BM + wc * 32 + 8 * fq;
#pragma unroll
        for (int ai = 0; ai < 2; ++ai)
#pragma unroll
            for (int m = 0; m < 4; ++m) { const bf16_t* rowp = P + (size_t)(row0 + ai * HALF + m * 16) * PROJ_LD + col0;
#pragma unroll
                for (int bj = 0; bj < 2; ++bj) { const u32x4 a = *(const u32x4*)(rowp + 1792 + bj * HALF), b = *(const u32x4*)(rowp + 2816 + bj * HALF);
                    f32x4 r0, r1;
                    r0[0] = bflo(a.x) * __builtin_amdgcn_rcpf(bflo(b.x)); r0[1] = bfhi(a.x) * __builtin_amdgcn_rcpf(bfhi(b.x)); r0[2] = bflo(a.y) * __builtin_amdgcn_rcpf(bflo(b.y)); r0[3] = bfhi(a.y) * __builtin_amdgcn_rcpf(bfhi(b.y));
                    r1[0] = bflo(a.z) * __builtin_amdgcn_rcpf(bflo(b.z)); r1[1] = bfhi(a.z) * __builtin_amdgcn_rcpf(bfhi(b.z)); r1[2] = bflo(a.w) * __builtin_amdgcn_rcpf(bflo(b.w)); r1[3] = bfhi(a.w) * __builtin_amdgcn_rcpf(bfhi(b.w));
                    acc[ai][bj][m][0] *= r0; acc[ai][bj][m][1] *= r1; }
                asm volatile("" ::: "memory"); }
    }
    __device__ __forceinline__ void operator()(const f32x4 (&acc)[2][2][4][2], const Unit& u, int wr, int wc, int fr, int fq) const {
        const int row0 = u.pm * BM + wr * 64 + fr, col0 = u.pn * BM + wc * 32 + 8 * fq;
#pragma unroll
        for (int ai = 0; ai < 2; ++ai)
#pragma unroll
            for (int m = 0; m < 4; ++m) { const size_t row = (size_t)(row0 + ai * HALF + m * 16); const bf16_t* rowp = P + row * PROJ_LD + col0;
#pragma unroll
                for (int bj = 0; bj < 2; ++bj) { const u32x4 b = *(const u32x4*)(rowp + 2816 + bj * HALF);
                    const f32x4 s0 = {bflo(b.x), bfhi(b.x), bflo(b.y), bfhi(b.y)}, s1 = {bflo(b.z), bfhi(b.z), bflo(b.w), bfhi(b.w)};
                    *(u32x4*)(O + row * 1024 + col0 + bj * HALF) = pack8(acc[ai][bj][m][0] * s0, acc[ai][bj][m][1] * s1); }
                asm volatile("" ::: "memory"); }
    }
};
struct EpiSsq {
    static constexpr bool PERM = true, AFTER_DRAIN = false, MID = false;
    bf16_t* O; float* ssq;
    __device__ __forceinline__ void mid(f32x4 (&)[2][2][4][2], const Unit&, int, int, int, int) const {}
    __device__ __forceinline__ void operator()(const f32x4 (&acc)[2][2][4][2], const Unit& u, int wr, int wc, int fr, int fq) const {
        const int row0 = u.pm * BM + wr * 64 + fr, col0 = u.pn * BM + wc * 32 + 8 * fq;
#pragma unroll
        for (int ai = 0; ai < 2; ++ai)
#pragma unroll
            for (int m = 0; m < 4; ++m) { const size_t row = (size_t)(row0 + ai * HALF + m * 16); float s = 0.f;
#pragma unroll
                for (int bj = 0; bj < 2; ++bj) { const f32x4 v0 = acc[ai][bj][m][0], v1 = acc[ai][bj][m][1];
                    s += (v0[0] * v0[0] + v0[1] * v0[1]) + (v0[2] * v0[2] + v0[3] * v0[3]) + (v1[0] * v1[0] + v1[1] * v1[1]) + (v1[2] * v1[2] + v1[3] * v1[3]);
                    *(u32x4*)(O + row * 1024 + col0 + bj * HALF) = pack8(v0, v1); }
                s += __shfl_xor(s, 16); s += __shfl_xor(s, 32);
                if (fq == 0) ssq[row * 16 + u.pn * 4 + wc] = s; }
    }
};
struct EpiSwiglu {
    static constexpr bool PERM = true, AFTER_DRAIN = false, MID = false;
    bf16_t* O;
    __device__ __forceinline__ void mid(f32x4 (&)[2][2][4][2], const Unit&, int, int, int, int) const {}
    __device__ __forceinline__ void operator()(const f32x4 (&acc)[2][2][4][2], const Unit& u, int wr, int wc, int fr, int fq) const {
        const int row0 = u.pm * BM + wr * 64 + fr, col0 = u.pn * HALF + wc * 32 + 8 * fq;
#pragma unroll
        for (int ai = 0; ai < 2; ++ai)
#pragma unroll
            for (int m = 0; m < 4; ++m) { const size_t row = (size_t)(row0 + ai * HALF + m * 16);
                const f32x4 g0 = acc[ai][0][m][0], g1 = acc[ai][0][m][1], u0 = acc[ai][1][m][0], u1 = acc[ai][1][m][1];
                f32x4 h0, h1;
#pragma unroll
                for (int e = 0; e < 4; ++e) { h0[e] = g0[e] * sigm(g0[e]) * u0[e]; h1[e] = g1[e] * sigm(g1[e]) * u1[e]; }
                *(u32x4*)(O + row * 2816 + col0) = pack8(h0, h1); }
    }
};
template <class Epi, class Sched, bool ALIGN_EPI = false, bool SP2 = false>
__device__ __forceinline__ void gemm_phase(PG8_LAS unsigned char* lds, const Gemm g, const Sched& S, const Epi& E) {
    const int tid = threadIdx.x, wid = __builtin_amdgcn_readfirstlane(tid >> 6), lane = tid & 63, wr = wid >> 2, wc = wid & 3, fr = lane & 15, fq = lane >> 4;
    const int K = g.K, nt = K / BK;
    unsigned voffA[2], voffB[2];
#pragma unroll
    for (int i = 0; i < 2; ++i) { int R, C; stage_rc(tid * 16 + i * 8192, R, C); const int Rb = Epi::PERM ? ((R & ~31) + perm32(R & 31)) : R;
        voffA[i] = (unsigned)(R * K + C) * 2u; voffB[i] = (unsigned)(Rb * K + C) * 2u; }
    const size_t kstep = (size_t)(BK * 2);
    const size_t hstep = (size_t)HALF * K * 2;
    const size_t tstep = 2 * hstep;
    const unsigned ldsw = (unsigned)wid * 1024u;
    const int aoff = lds_byte(wr * 64 + fr, fq * 8), boff = lds_byte(wc * 32 + fr, fq * 8);
#define PG8_SA(b, h) (((b) * 2 + (h)) * HTB)
#define PG8_SB(b, h) ((4 + (b) * 2 + (h)) * HTB)
#define PG8_STAGE(bufoff, gbase, voff) do { _Pragma("unroll") for (int _i = 0; _i < 2; ++_i) \
        __builtin_amdgcn_global_load_lds((const unsigned*)((const char*)(gbase) + (voff)[_i]), (PG8_LAS unsigned*)(lds + (bufoff) + ldsw + _i * 8192), 16, 0, 0); } while (0)
#define PG8_LDA(dst, b, h) do { _Pragma("unroll") for (int m = 0; m < 4; ++m) _Pragma("unroll") for (int k = 0; k < 2; ++k) dst[m][k] = *(const PG8_LAS bf16x8*)(lds + PG8_SA(b, h) + aoff + m * 2048 + k * 1024); } while (0)
#define PG8_LDB(dst, b, h) do { _Pragma("unroll") for (int n = 0; n < 2; ++n) _Pragma("unroll") for (int k = 0; k < 2; ++k) dst[n][k] = *(const PG8_LAS bf16x8*)(lds + PG8_SB(b, h) + boff + n * 2048 + k * 1024); } while (0)
#define PG8_MMA(ai, bj, At, Bt) do { __builtin_amdgcn_s_setprio(1); _Pragma("unroll") for (int m = 0; m < 4; ++m) _Pragma("unroll") for (int n = 0; n < 2; ++n) _Pragma("unroll") for (int k = 0; k < 2; ++k) \
        acc[ai][bj][m][n] = __builtin_amdgcn_mfma_f32_16x16x32_bf16(Bt[n][k], At[m][k], acc[ai][bj][m][n], 0, 0, 0); __builtin_amdgcn_s_setprio(0); } while (0)
#define PG8_WAIT_V(n) asm volatile("s_waitcnt vmcnt(" #n ")" ::: "memory")
#define PG8_WAIT_L(n) asm volatile("s_waitcnt lgkmcnt(" #n ")" ::: "memory")
#define PG8_BAR __builtin_amdgcn_s_barrier()
#define PG8_SCHED __builtin_amdgcn_sched_barrier(0)
    Unit cur, nxt; int ui = 0;
    if (!S.next(0, cur)) return;
    f32x4 acc[2][2][4][2];
#pragma unroll
    for (int a = 0; a < 2; ++a)
#pragma unroll
        for (int b = 0; b < 2; ++b)
#pragma unroll
            for (int m = 0; m < 4; ++m)
#pragma unroll
                for (int n = 0; n < 2; ++n) acc[a][b][m][n] = (f32x4){0.f, 0.f, 0.f, 0.f};
    bf16x8 At[4][2], B0[2][2], B1[2][2];
    const char* cA = (const char*)g.A + (size_t)cur.pm * tstep; const char* cB = (const char*)g.Bt + (size_t)cur.pn * tstep;
    S.a_ready(cur);
    if constexpr (SP2) {
        PG8_STAGE(PG8_SB(0, 0), cB, voffB); PG8_STAGE(PG8_SB(0, 1), cB + hstep, voffB); PG8_STAGE(PG8_SA(0, 0), cA, voffA); PG8_STAGE(PG8_SA(0, 1), cA + hstep, voffA);
        if (wr == 1) PG8_BAR;
        PG8_WAIT_V(2); PG8_BAR;
        PG8_STAGE(PG8_SB(1, 0), cB + kstep, voffB); PG8_STAGE(PG8_SA(1, 0), cA + kstep, voffA); PG8_STAGE(PG8_SB(1, 1), cB + hstep + kstep, voffB);
        PG8_WAIT_V(6); PG8_BAR;
    } else {
        PG8_STAGE(PG8_SB(0, 0), cB, voffB); PG8_STAGE(PG8_SA(0, 0), cA, voffA); PG8_STAGE(PG8_SB(0, 1), cB + hstep, voffB); PG8_STAGE(PG8_SA(0, 1), cA + hstep, voffA);
        if (wr == 1) PG8_BAR;
        PG8_WAIT_V(4); PG8_BAR;
        PG8_STAGE(PG8_SB(1, 0), cB + kstep, voffB); PG8_STAGE(PG8_SA(1, 0), cA + kstep, voffA); PG8_STAGE(PG8_SB(1, 1), cB + hstep + kstep, voffB);
        PG8_WAIT_V(6); PG8_BAR;
    }
    for (;;) {
        const bool has_next = S.next(ui + 1, nxt);
        const char* nA = has_next ? (const char*)g.A + (size_t)nxt.pm * tstep : cA; const char* nB = has_next ? (const char*)g.Bt + (size_t)nxt.pn * tstep : cB;
        for (int t = 0; t < nt; t += 2) {
            const bool last = (t == nt - 2);
            if constexpr (Epi::MID) { if (t == (nt >> 1)) E.mid(acc, cur, wr, wc, fr, fq); }
            const char* a1 = cA + (size_t)(t + 1) * kstep;
            const char* a2 = last ? nA : cA + (size_t)(t + 2) * kstep; const char* b2 = last ? nB : cB + (size_t)(t + 2) * kstep;
            const char* a3 = a2 + kstep; const char* b3 = b2 + kstep;
            if (last && has_next) S.a_ready(nxt);
            if constexpr (SP2) {
            PG8_LDB(B0, 0, 0); PG8_LDB(B1, 0, 1); PG8_SCHED; PG8_LDA(At, 0, 0); PG8_STAGE(PG8_SA(1, 1), a1 + hstep, voffA);
            PG8_WAIT_V(8); PG8_WAIT_L(0); PG8_BAR; PG8_MMA(0, 0, At, B0); PG8_MMA(0, 1, At, B1); PG8_BAR; PG8_SCHED;
            PG8_LDA(At, 0, 1); PG8_STAGE(PG8_SB(0, 0), b2, voffB); PG8_STAGE(PG8_SB(0, 1), b2 + hstep, voffB); PG8_STAGE(PG8_SA(0, 0), a2, voffA);
            PG8_WAIT_V(8); PG8_WAIT_L(0); PG8_BAR; PG8_MMA(1, 0, At, B0); PG8_MMA(1, 1, At, B1); PG8_BAR; PG8_SCHED;
            PG8_LDB(B0, 1, 0); PG8_LDB(B1, 1, 1); PG8_SCHED; PG8_LDA(At, 1, 0); PG8_STAGE(PG8_SA(0, 1), a2 + hstep, voffA);
            PG8_WAIT_V(8); PG8_WAIT_L(0); PG8_BAR; PG8_MMA(0, 0, At, B0); PG8_MMA(0, 1, At, B1); PG8_BAR; PG8_SCHED;
            PG8_LDA(At, 1, 1); PG8_STAGE(PG8_SB(1, 0), b3, voffB); PG8_STAGE(PG8_SB(1, 1), b3 + hstep, voffB); PG8_STAGE(PG8_SA(1, 0), a3, voffA);
            PG8_WAIT_V(8); PG8_WAIT_L(0); PG8_BAR; PG8_MMA(1, 0, At, B0); PG8_MMA(1, 1, At, B1); PG8_BAR; PG8_SCHED;
            } else {
            PG8_LDB(B0, 0, 0); PG8_SCHED; PG8_LDA(At, 0, 0); PG8_STAGE(PG8_SA(1, 1), a1 + hstep, voffA);
            PG8_WAIT_L(8); PG8_BAR; PG8_WAIT_L(0); PG8_MMA(0, 0, At, B0); PG8_BAR; PG8_SCHED;
            PG8_LDB(B1, 0, 1); PG8_STAGE(PG8_SB(0, 0), b2, voffB);
            PG8_BAR; PG8_WAIT_L(0); PG8_MMA(0, 1, At, B1); PG8_BAR;
            PG8_LDA(At, 0, 1); PG8_STAGE(PG8_SA(0, 0), a2, voffA);
            PG8_BAR; PG8_WAIT_L(0); PG8_MMA(1, 0, At, B0); PG8_BAR; PG8_SCHED;
            PG8_STAGE(PG8_SB(0, 1), b2 + hstep, voffB);
            PG8_WAIT_V(6); PG8_BAR; PG8_MMA(1, 1, At, B1); PG8_BAR;
            PG8_LDB(B0, 1, 0); PG8_SCHED; PG8_LDA(At, 1, 0); PG8_STAGE(PG8_SA(0, 1), a2 + hstep, voffA);
            PG8_WAIT_L(8); PG8_BAR; PG8_WAIT_L(0); PG8_MMA(0, 0, At, B0); PG8_BAR; PG8_SCHED;
            PG8_LDB(B1, 1, 1); PG8_STAGE(PG8_SB(1, 0), b3, voffB);
            PG8_BAR; PG8_WAIT_L(0); PG8_MMA(0, 1, At, B1); PG8_BAR;
            PG8_LDA(At, 1, 1); PG8_STAGE(PG8_SA(1, 0), a3, voffA);
            PG8_BAR; PG8_WAIT_L(0); PG8_MMA(1, 0, At, B0); PG8_BAR; PG8_SCHED;
            PG8_STAGE(PG8_SB(1, 1), b3 + hstep, voffB);
            PG8_WAIT_V(6); PG8_BAR; PG8_MMA(1, 1, At, B1); PG8_BAR;
            }
        }
        if constexpr (ALIGN_EPI) { if (wr == 0) PG8_BAR; }
        if constexpr (!Epi::AFTER_DRAIN) { E(acc, cur, wr, wc, fr, fq); S.done(cur); }
        if (!has_next) break;
#pragma unroll
        for (int a = 0; a < 2; ++a)
#pragma unroll
            for (int b = 0; b < 2; ++b)
#pragma unroll
                for (int m = 0; m < 4; ++m)
#pragma unroll
                    for (int n = 0; n < 2; ++n) acc[a][b][m][n] = (f32x4){0.f, 0.f, 0.f, 0.f};
        cur = nxt; cA = nA; cB = nB; ++ui;
        if constexpr (ALIGN_EPI) { if (wr == 1) PG8_BAR; }
    }
    PG8_WAIT_V(0);
    if constexpr (!ALIGN_EPI) { if (wr == 0) PG8_BAR; }
    PG8_BAR;
    if constexpr (Epi::AFTER_DRAIN) { E.fused(acc, cur, wr, wc, fr, fq, lds, wid, lane); S.done(cur); }
#undef PG8_SA
#undef PG8_SB
#undef PG8_STAGE
#undef PG8_LDA
#undef PG8_LDB
#undef PG8_MMA
#undef PG8_WAIT_V
#undef PG8_WAIT_L
#undef PG8_BAR
#undef PG8_SCHED
}
}

constexpr int NWAVES = 8, NTHR = 512;
constexpr int BATCH = 32, SEQ = 2048, D = 1024, M = BATCH * SEQ;
constexpr int INW = 3840, FF = 2816;
constexpr int C_K = 512, C_V = 640, C_U = 768, C_VG = 1280;
constexpr float EPS = 1e-6f, LN_EPS = 1e-5f, LOG2E = 1.4426950408889634f;
constexpr size_t MiB = 1u << 20;
constexpr size_t WS_WIN = 0;
constexpr size_t WS_WAB = 8 * MiB;
constexpr size_t WS_WOUT = 10 * MiB;
constexpr size_t WS_WGU = 12 * MiB;
constexpr size_t WS_WD = 24 * MiB;
constexpr size_t WS_WSP = 30 * MiB;
constexpr size_t WS_SSQ1 = 31 * MiB;
constexpr size_t WS_SSQA = 32 * MiB;
constexpr size_t WS_SSQB = 36 * MiB;
constexpr size_t WS_XN = 40 * MiB;
constexpr size_t WS_AG = 168 * MiB;
constexpr size_t WS_MG = 296 * MiB;
constexpr size_t WS_PROJ = 424 * MiB;
constexpr size_t WS_END = 904 * MiB;
constexpr int LDS_BYTES = 147456;

#define GAS __attribute__((address_space(1)))
#define LAS __attribute__((address_space(3)))
typedef unsigned short bf16;
typedef unsigned v4u __attribute__((ext_vector_type(4)));
typedef unsigned v2u __attribute__((ext_vector_type(2)));
typedef float f32x4 __attribute__((ext_vector_type(4)));
typedef float f32x16 __attribute__((ext_vector_type(16)));
typedef short bf16x8 __attribute__((ext_vector_type(8)));
typedef short s16x4 __attribute__((ext_vector_type(4)));
using pg8::cvtpk; using pg8::bflo; using pg8::bfhi;
#define LDS_WAIT() asm volatile("s_waitcnt lgkmcnt(0)" ::: "memory")
__device__ __forceinline__ unsigned short f2bf(float f) { return (unsigned short)(cvtpk(f, 0.f) & 0xffffu); }
__device__ __forceinline__ float bf2f(unsigned short h) { return __uint_as_float((unsigned)h << 16); }
__device__ __forceinline__ float wave_sum(float v) {
#pragma unroll
    for (int o = 1; o < 64; o <<= 1) v += __shfl_xor(v, o);
    return v;
}
__device__ __forceinline__ int crow(int r, int hi) { return (r & 3) + 8 * (r >> 2) + 4 * hi; }

struct Frame {
    LAS unsigned char* lds;
    int tid, lane, wave, G, bid;
    const float* in[17]; float* out; unsigned char* ws;
};
__device__ __forceinline__ int rowmap(int mode, int n) { return mode == 0 ? n : (((n >> 7) << 8) + (n & 127) + (mode == 2 ? 128 : 0)); }
__device__ __forceinline__ void p0_transpose_item(const float* W, int N, bf16* WT, int ldk, int koff, int mode, LAS float* scr, int item, int lane) {
    const int nblk = N / 32, kb = item / nblk, nb = item % nblk, k0 = 64 * kb, n0 = 32 * nb;
#pragma unroll 8
    for (int i = 0; i < 32; ++i) { const int kk = 2 * i + (lane >> 5); scr[kk * 33 + (lane & 31)] = W[(size_t)(k0 + kk) * N + n0 + (lane & 31)]; }
    LDS_WAIT(); asm volatile("" ::: "memory");
    const int c = lane & 7;
#pragma unroll
    for (int j = 0; j < 4; ++j) { const int n = (lane >> 3) + 8 * j; const LAS float* s = scr + (8 * c) * 33 + n;
        v4u o; o.x = cvtpk(s[0 * 33], s[1 * 33]); o.y = cvtpk(s[2 * 33], s[3 * 33]); o.z = cvtpk(s[4 * 33], s[5 * 33]); o.w = cvtpk(s[6 * 33], s[7 * 33]);
        *(GAS v4u*)(WT + (size_t)rowmap(mode, n0 + n) * ldk + koff + k0 + 8 * c) = o; }
    LDS_WAIT(); asm volatile("" ::: "memory");
}
__device__ __forceinline__ void rms_row_to_bf16(int lane, const float* xrow, const float* g, bf16* orow) {
    const GAS f32x4* xr = (const GAS f32x4*)xrow + lane; const GAS f32x4* gr = (const GAS f32x4*)g + lane;
    f32x4 v[4]; float s = 0.f;
#pragma unroll
    for (int j = 0; j < 4; ++j) { v[j] = xr[64 * j]; s += (v[j].x * v[j].x + v[j].y * v[j].y) + (v[j].z * v[j].z + v[j].w * v[j].w); }
    const float rstd = 1.0f / sqrtf(wave_sum(s) * (1.f / D) + EPS);
    GAS v2u* o8 = (GAS v2u*)orow + lane;
#pragma unroll
    for (int j = 0; j < 4; ++j) { const f32x4 gg = gr[64 * j]; v2u w; w.x = cvtpk(v[j].x * rstd * gg.x, v[j].y * rstd * gg.y); w.y = cvtpk(v[j].z * rstd * gg.z, v[j].w * rstd * gg.w); o8[64 * j] = w; }
}
__device__ __forceinline__ void p0_prologue(Frame& F) {
    LAS float* scr = (LAS float*)(F.lds + F.wave * 16384);
    const int gw = F.bid * NWAVES + F.wave, NGW = F.G * NWAVES;
    unsigned char* ws = F.ws;
    constexpr int I_IN = (1024 / 64) * (INW / 32), I_A = (512 / 64) * (1024 / 32), I_O = (1024 / 64) * (1024 / 32), I_G = (1024 / 64) * (FF / 32), I_D = (FF / 64) * (1024 / 32);
    constexpr int NITEMS = I_IN + 2 * I_A + I_O + 2 * I_G + I_D;
    for (int it = gw; it < NITEMS; it += NGW) {
        int r = it;
        if (r < I_IN) { p0_transpose_item(F.in[2], INW, (bf16*)(ws + WS_WIN), 1024, 0, 0, scr, r, F.lane); continue; } r -= I_IN;
        if (r < I_A) { p0_transpose_item(F.in[8], 1024, (bf16*)(ws + WS_WAB), 1024, 0, 0, scr, r, F.lane); continue; } r -= I_A;
        if (r < I_A) { p0_transpose_item(F.in[9], 1024, (bf16*)(ws + WS_WAB), 1024, 512, 0, scr, r, F.lane); continue; } r -= I_A;
        if (r < I_O) { p0_transpose_item(F.in[10], 1024, (bf16*)(ws + WS_WOUT), 1024, 0, 0, scr, r, F.lane); continue; } r -= I_O;
        if (r < I_G) { p0_transpose_item(F.in[13], FF, (bf16*)(ws + WS_WGU), 1024, 0, 1, scr, r, F.lane); continue; } r -= I_G;
        if (r < I_G) { p0_transpose_item(F.in[14], FF, (bf16*)(ws + WS_WGU), 1024, 0, 2, scr, r, F.lane); continue; } r -= I_G;
        p0_transpose_item(F.in[15], 1024, (bf16*)(ws + WS_WD), FF, 0, 0, scr, r, F.lane);
    }
    { const float* wsrc = F.in[6]; bf16* wdst = (bf16*)(ws + WS_WSP);
      for (int i = gw * 64 + F.lane; i < 4 * 128 * 128; i += NGW * 64) { const int t = (i >> 7) & 127, s = i & 127; wdst[i] = f2bf(s <= t ? wsrc[i] : 0.f); } }
    bf16* XN = (bf16*)(ws + WS_XN);
    for (int m = gw; m < M; m += NGW) rms_row_to_bf16(F.lane, F.in[0] + (size_t)m * D, F.in[1], XN + (size_t)m * D);
}
constexpr int KS_ROW = 144, VT_ROW = 260  , KS_BYTES = 256 * KS_ROW;
__device__ __forceinline__ void attn_unit(Frame& F, const bf16* PROJ, bf16* AG, const float* sinks, int unit) {
    const int tid = F.tid, lane = F.lane, wave = F.wave, lq = lane & 31, hi = lane >> 5;
    const int kvh = unit & 1, n = (unit >> 1) & 15, b = unit >> 5;
    const long T0 = (long)b * SEQ + n * 128;
    LAS unsigned char* Ks = F.lds; LAS unsigned short* VT = (LAS unsigned short*)(F.lds + KS_BYTES);
    const int jstart = (n == 0) ? 128 : 0;
#pragma unroll
    for (int it = 0; it < 4; ++it) { const int id = it * NTHR + tid, key = id >> 3, ch = id & 7;
        if (key >= jstart) { const bf16* src = PROJ + (T0 - 128 + key) * INW + C_K + kvh * 64 + ch * 8;
            const v4u kv = *(const GAS v4u*)src, vv = *(const GAS v4u*)(src + 128);
            *(LAS v4u*)(Ks + key * KS_ROW + ch * 16) = kv;
            LAS unsigned short* vt = VT + (ch * 8) * VT_ROW + key;
            vt[0 * VT_ROW] = (unsigned short)(vv.x & 0xffffu); vt[1 * VT_ROW] = (unsigned short)(vv.x >> 16);
            vt[2 * VT_ROW] = (unsigned short)(vv.y & 0xffffu); vt[3 * VT_ROW] = (unsigned short)(vv.y >> 16);
            vt[4 * VT_ROW] = (unsigned short)(vv.z & 0xffffu); vt[5 * VT_ROW] = (unsigned short)(vv.z >> 16);
            vt[6 * VT_ROW] = (unsigned short)(vv.w & 0xffffu); vt[7 * VT_ROW] = (unsigned short)(vv.w >> 16); } }
    __syncthreads();
#pragma unroll 1
    for (int pass = 0; pass < 2; ++pass) {
        int lqo = lq; asm volatile("" : "+v"(lqo));
        const int g = pass * 2 + (wave >> 2), wq = wave & 3, hq = kvh * 4 + g;
        const float slope2 = __builtin_amdgcn_exp2f(-(float)(hq + 1)) * LOG2E, sink2 = sinks[hq] * LOG2E;
        const bf16* qp = PROJ + (T0 + 32 * wq + lq) * INW + hq * 64 + 8 * hi;
        bf16x8 qf[4];
#pragma unroll
        for (int ds = 0; ds < 4; ++ds) qf[ds] = *(const GAS bf16x8*)(qp + 16 * ds);
        f32x16 S[5];
#pragma unroll
        for (int i = 0; i < 5; ++i) { const int kt = wq + i; const bool skip = (n == 0 && kt < 4);
#pragma unroll
            for (int r = 0; r < 16; ++r) S[i][r] = 0.f;
            if (!skip) {
#pragma unroll
                for (int ds = 0; ds < 4; ++ds) { const bf16x8 kf = *(const LAS bf16x8*)(Ks + (32 * kt + lq) * KS_ROW + (16 * ds + 8 * hi) * 2);
                    S[i] = __builtin_amdgcn_mfma_f32_32x32x16_bf16(kf, qf[ds], S[i], 0, 0, 0); } }
            __builtin_amdgcn_sched_barrier(0); }
        float mx = sink2;
#pragma unroll
        for (int i = 0; i < 5; ++i) { const bool skip = (n == 0 && wq + i < 4);
#pragma unroll
            for (int r = 0; r < 16; ++r) { const int rel = 128 - 32 * i + lqo - crow(r, hi);
                const bool valid = !skip && (i == 0 ? rel <= 127 : (i == 4 ? rel >= 0 : true));
                const float lg = valid ? S[i][r] - slope2 * (float)rel : -1e30f; S[i][r] = lg; mx = fmaxf(mx, lg); } }
        mx = fmaxf(mx, __shfl_xor(mx, 32));
        float sum = 0.f;
#pragma unroll
        for (int i = 0; i < 5; ++i)
#pragma unroll
            for (int r = 0; r < 16; ++r) { const float p = __builtin_amdgcn_exp2f(S[i][r] - mx); S[i][r] = p; sum += p; }
        sum += __shfl_xor(sum, 32); sum += __builtin_amdgcn_exp2f(sink2 - mx);
        const float inv = 1.0f / sum;
        f32x16 O[2];
#pragma unroll
        for (int r = 0; r < 16; ++r) { O[0][r] = 0.f; O[1][r] = 0.f; }
#pragma unroll
        for (int i = 0; i < 5; ++i) { const int kt = wq + i; const bool skip = (n == 0 && kt < 4);
            if (!skip) {
#pragma unroll
                for (int s = 0; s < 2; ++s) {
                    v4u pw; pw.x = cvtpk(S[i][8 * s + 0], S[i][8 * s + 1]); pw.y = cvtpk(S[i][8 * s + 2], S[i][8 * s + 3]); pw.z = cvtpk(S[i][8 * s + 4], S[i][8 * s + 5]); pw.w = cvtpk(S[i][8 * s + 6], S[i][8 * s + 7]);
                    const bf16x8 pf = __builtin_bit_cast(bf16x8, pw);
#pragma unroll
                    for (int dt = 0; dt < 2; ++dt) { const LAS unsigned short* vp = VT + (32 * dt + lq) * VT_ROW + 32 * kt + 16 * s + 4 * hi;
                        const s16x4 lo = *(const LAS s16x4*)vp, h8 = *(const LAS s16x4*)(vp + 8);
                        const bf16x8 vf = __builtin_shufflevector(lo, h8, 0, 1, 2, 3, 4, 5, 6, 7);
                        O[dt] = __builtin_amdgcn_mfma_f32_32x32x16_bf16(vf, pf, O[dt], 0, 0, 0); } } }
            __builtin_amdgcn_sched_barrier(0); }
        bf16* op = AG + (T0 + 32 * wq + lq) * 1024 + hq * 64 + 4 * hi;
#pragma unroll
        for (int dt = 0; dt < 2; ++dt)
#pragma unroll
            for (int j = 0; j < 4; ++j) { v2u w; w.x = cvtpk(O[dt][4 * j] * inv, O[dt][4 * j + 1] * inv); w.y = cvtpk(O[dt][4 * j + 2] * inv, O[dt][4 * j + 3] * inv);
                *(GAS v2u*)(op + 32 * dt + 8 * j) = w; }
    }
    __syncthreads();
}
constexpr int GV_ROW = 132;
__device__ __forceinline__ void gmlp_unit(Frame& F, const bf16* PROJ, bf16* AG, const float* ln_g, const float* ln_b, const bf16* WSP, const float* b_s, int unit) {
    const int lane = F.lane, wave = F.wave, lq = lane & 31, hi = lane >> 5;
    const int n = unit & 15, b = unit >> 4; const long T0 = (long)b * SEQ + n * 128;
    LAS unsigned short* VT = (LAS unsigned short*)F.lds;
    float gch[8], bch[8];
#pragma unroll
    for (int i = 0; i < 8; ++i) { gch[i] = ln_g[lane + 64 * i]; bch[i] = ln_b[lane + 64 * i]; }
#pragma unroll 2
    for (int tk = 0; tk < 16; ++tk) { const int s = 16 * wave + tk; const bf16* vp = PROJ + (T0 + s) * INW + C_VG + lane;
        float x[8]; float sm = 0.f;
#pragma unroll
        for (int i = 0; i < 8; ++i) { x[i] = bf2f(vp[64 * i]); sm += x[i]; }
        const float mean = wave_sum(sm) * (1.f / 512.f); float q = 0.f;
#pragma unroll
        for (int i = 0; i < 8; ++i) { x[i] -= mean; q += x[i] * x[i]; }
        const float rstd = 1.0f / sqrtf(wave_sum(q) * (1.f / 512.f) + LN_EPS);
#pragma unroll
        for (int i = 0; i < 8; ++i) VT[(lane + 64 * i) * GV_ROW + s] = f2bf(x[i] * rstd * gch[i] + bch[i]); }
    __syncthreads();
    const int g = wave >> 1, cb = g * 128 + 64 * (wave & 1);
    f32x16 acc[2][4];
#pragma unroll
    for (int mt = 0; mt < 2; ++mt)
#pragma unroll
        for (int nt = 0; nt < 4; ++nt)
#pragma unroll
            for (int r = 0; r < 16; ++r) acc[mt][nt][r] = 0.f;
    const bf16* wg = WSP + (size_t)g * 128 * 128 + (size_t)lq * 128 + 8 * hi;
#pragma unroll 1
    for (int ks = 0; ks < 8; ++ks) {
        bf16x8 af[2];
#pragma unroll
        for (int mt = 0; mt < 2; ++mt) { const LAS unsigned short* ap = VT + (cb + 32 * mt + lq) * GV_ROW + 16 * ks + 8 * hi;
            const s16x4 lo = *(const LAS s16x4*)ap, h8 = *(const LAS s16x4*)(ap + 4); af[mt] = __builtin_shufflevector(lo, h8, 0, 1, 2, 3, 4, 5, 6, 7); }
#pragma unroll
        for (int nt = 0; nt < 4; ++nt) if (ks < 2 * (nt + 1)) { const bf16x8 bfr = *(const GAS bf16x8*)(wg + (size_t)(32 * nt) * 128 + 16 * ks);
#pragma unroll
            for (int mt = 0; mt < 2; ++mt) acc[mt][nt] = __builtin_amdgcn_mfma_f32_32x32x16_bf16(af[mt], bfr, acc[mt][nt], 0, 0, 0); }
    }
#pragma unroll
    for (int nt = 0; nt < 4; ++nt) { const int t = 32 * nt + lq; const float bias = b_s[g * 128 + t];
        const bf16* up = PROJ + (T0 + t) * INW + C_U + cb + 4 * hi; bf16* op = AG + (T0 + t) * 1024 + 512 + cb + 4 * hi;
#pragma unroll
        for (int mt = 0; mt < 2; ++mt)
#pragma unroll
            for (int j = 0; j < 4; ++j) { const v2u uu = *(const GAS v2u*)(up + 32 * mt + 8 * j);
                v2u w; w.x = cvtpk(bflo(uu.x) * (acc[mt][nt][4 * j] + bias), bfhi(uu.x) * (acc[mt][nt][4 * j + 1] + bias));
                w.y = cvtpk(bflo(uu.y) * (acc[mt][nt][4 * j + 2] + bias), bfhi(uu.y) * (acc[mt][nt][4 * j + 3] + bias));
                *(GAS v2u*)(op + 32 * mt + 8 * j) = w; } }
    __syncthreads();
}
__device__ __forceinline__ void e1_row(int lane, const float* xrow, const bf16* mixrow, const float* ssq, const float* gpost, const float* gpre, float* hrow, bf16* hnrow) {
    float t = (lane < 16) ? ssq[lane] : 0.f; t = wave_sum(t);
    const float rstd = 1.0f / sqrtf(t * (1.f / D) + EPS);
    f32x4 h[2][2]; float s = 0.f;
#pragma unroll
    for (int j = 0; j < 2; ++j) { const int c = 8 * lane + 512 * j; const v4u mv = *(const GAS v4u*)(mixrow + c);
        const f32x4 x0 = *(const GAS f32x4*)(xrow + c), x1 = *(const GAS f32x4*)(xrow + c + 4), g0 = *(const GAS f32x4*)(gpost + c), g1 = *(const GAS f32x4*)(gpost + c + 4);
        const f32x4 m0 = {bflo(mv.x), bfhi(mv.x), bflo(mv.y), bfhi(mv.y)}, m1 = {bflo(mv.z), bfhi(mv.z), bflo(mv.w), bfhi(mv.w)};
        h[j][0] = x0 + m0 * rstd * g0; h[j][1] = x1 + m1 * rstd * g1;
        *(GAS f32x4*)(hrow + c) = h[j][0]; *(GAS f32x4*)(hrow + c + 4) = h[j][1];
#pragma unroll
        for (int e = 0; e < 4; ++e) s += h[j][0][e] * h[j][0][e] + h[j][1][e] * h[j][1][e]; }
    const float r2 = 1.0f / sqrtf(wave_sum(s) * (1.f / D) + EPS);
#pragma unroll
    for (int j = 0; j < 2; ++j) { const int c = 8 * lane + 512 * j; const f32x4 g0 = *(const GAS f32x4*)(gpre + c), g1 = *(const GAS f32x4*)(gpre + c + 4);
        *(GAS v4u*)(hnrow + c) = pg8::pack8(h[j][0] * r2 * g0, h[j][1] * r2 * g1); }
}
__device__ __forceinline__ void e2_row(int lane, const bf16* ffrow, const float* ssq, const float* gpost, float* hrow) {
    float t = (lane < 16) ? ssq[lane] : 0.f; t = wave_sum(t);
    const float rstd = 1.0f / sqrtf(t * (1.f / D) + EPS);
#pragma unroll
    for (int j = 0; j < 2; ++j) { const int c = 8 * lane + 512 * j; const v4u mv = *(const GAS v4u*)(ffrow + c);
        const f32x4 x0 = *(const GAS f32x4*)(hrow + c), x1 = *(const GAS f32x4*)(hrow + c + 4), g0 = *(const GAS f32x4*)(gpost + c), g1 = *(const GAS f32x4*)(gpost + c + 4);
        const f32x4 m0 = {bflo(mv.x), bfhi(mv.x), bflo(mv.y), bfhi(mv.y)}, m1 = {bflo(mv.z), bfhi(mv.z), bflo(mv.w), bfhi(mv.w)};
        *(GAS f32x4*)(hrow + c) = x0 + m0 * rstd * g0; *(GAS f32x4*)(hrow + c + 4) = x1 + m1 * rstd * g1; }
}
constexpr int N_PHASES = 9;
struct Args { const float* in[17]; float* out; unsigned char* ws; int ph_lo, ph_hi; };
__global__ void __launch_bounds__(NTHR, 2) fwd_megakernel(Args args) {
    extern __shared__ __attribute__((aligned(16))) unsigned char lds[];
    cg::grid_group grid = cg::this_grid();
    Frame F;
    F.lds = (LAS unsigned char*)lds;
    F.tid = threadIdx.x; F.lane = F.tid & 63; F.wave = __builtin_amdgcn_readfirstlane(F.tid >> 6);
    F.G = gridDim.x; F.bid = blockIdx.x;
#pragma unroll
    for (int i = 0; i < 17; ++i) F.in[i] = args.in[i];
    F.out = args.out; F.ws = args.ws;
    unsigned char* ws = args.ws;
    const int lo = args.ph_lo, hi = args.ph_hi;
    bf16* W_IN = (bf16*)(ws + WS_WIN); bf16* W_AB = (bf16*)(ws + WS_WAB); bf16* W_OUT = (bf16*)(ws + WS_WOUT); bf16* W_GU = (bf16*)(ws + WS_WGU); bf16* W_D = (bf16*)(ws + WS_WD); bf16* W_SP = (bf16*)(ws + WS_WSP);
    float* SSQA = (float*)(ws + WS_SSQA); float* SSQB = (float*)(ws + WS_SSQB);
    bf16* XN = (bf16*)(ws + WS_XN); bf16* AG = (bf16*)(ws + WS_AG); bf16* MG = (bf16*)(ws + WS_MG); bf16* PROJ = (bf16*)(ws + WS_PROJ);
    bf16* MIX = AG; bf16* FFO = MG; bf16* HB = PROJ; bf16* HN = XN;
#define IN(k) (lo <= (k) && (k) < hi)
#define SEAM(k) do { if (IN(k) && IN((k) + 1)) grid.sync(); else __syncthreads(); } while (0)

    if (IN(0)) { p0_prologue(F); }
    SEAM(0);
    if (IN(1)) { pg8::Gemm g{XN, W_IN, M, INW, D}; pg8::StaticOrder S; S.init(M, INW, F.G, F.bid); pg8::EpiProj E{PROJ};
        pg8::gemm_phase<pg8::EpiProj, pg8::StaticOrder, true, true>(F.lds, g, S, E); }
    SEAM(1);
    if (IN(2)) {
        for (int u = F.bid; u < BATCH * 16 * 2; u += F.G) attn_unit(F, PROJ, AG, F.in[3], u);
        for (int u = F.bid; u < BATCH * 16; u += F.G) gmlp_unit(F, PROJ, AG, F.in[4], F.in[5], W_SP, F.in[7], u);
    }
    SEAM(2);
    if (IN(3)) { pg8::Gemm g{AG, W_AB, M, D, D}; pg8::StaticOrder S; S.init(M, D, F.G, F.bid); pg8::EpiMerge E{PROJ, MG};
        pg8::gemm_phase<pg8::EpiMerge, pg8::StaticOrder, true, true>(F.lds, g, S, E); }
    SEAM(3);
    if (IN(4)) { pg8::Gemm g{MG, W_OUT, M, D, D}; pg8::StaticOrder S; S.init(M, D, F.G, F.bid); pg8::EpiSsq E{MIX, SSQA};
        pg8::gemm_phase<pg8::EpiSsq, pg8::StaticOrder, true, true>(F.lds, g, S, E); }
    SEAM(4);
    if (IN(5)) { const int gw = F.bid * NWAVES + F.wave, NGW = F.G * NWAVES;
        for (int m = gw; m < M; m += NGW) e1_row(F.lane, F.in[0] + (size_t)m * D, MIX + (size_t)m * D, SSQA + (size_t)m * 16, F.in[11], F.in[12], F.out + (size_t)m * D, HN + (size_t)m * D); }
    SEAM(5);
    if (IN(6)) { pg8::Gemm g{HN, W_GU, M, 2 * FF, D}; pg8::StaticOrder S; S.init(M, 2 * FF, F.G, F.bid); pg8::EpiSwiglu E{HB};
        pg8::gemm_phase<pg8::EpiSwiglu, pg8::StaticOrder, true, true>(F.lds, g, S, E); }
    SEAM(6);
    if (IN(7)) { pg8::Gemm g{HB, W_D, M, D, FF}; pg8::StaticOrder S; S.init(M, D, F.G, F.bid); pg8::EpiSsq E{FFO, SSQB};
        pg8::gemm_phase<pg8::EpiSsq, pg8::StaticOrder, true, true>(F.lds, g, S, E); }
    SEAM(7);
    if (IN(8)) { const int gw = F.bid * NWAVES + F.wave, NGW = F.G * NWAVES;
        for (int m = gw; m < M; m += NGW) e2_row(F.lane, FFO + (size_t)m * D, SSQB + (size_t)m * 16, F.in[16], F.out + (size_t)m * D); }
#undef IN
#undef SEAM
}

extern "C" void kernel_launch(void* const* d_in, const int* in_sizes, int n_in, void* d_out, int out_size, void* d_ws, size_t ws_size, hipStream_t stream) {
    static int grid = 0;
    if (grid == 0) {
        if (n_in != 17 || out_size != M * D || ws_size < WS_END) { fprintf(stderr, "kernel_launch: unexpected problem: n_in %d out %d ws %zu\n", n_in, out_size, ws_size); grid = -1; return; }
        int dev = 0, cus = 0, per_cu = 0;
        (void)hipGetDevice(&dev); (void)hipDeviceGetAttribute(&cus, hipDeviceAttributeMultiprocessorCount, dev);
        if (hipFuncSetAttribute((const void*)fwd_megakernel, hipFuncAttributeMaxDynamicSharedMemorySize, LDS_BYTES) != hipSuccess) fprintf(stderr, "kernel_launch: hipFuncSetAttribute failed\n");
        if (hipOccupancyMaxActiveBlocksPerMultiprocessor(&per_cu, (const void*)fwd_megakernel, NTHR, LDS_BYTES) != hipSuccess || per_cu < 1) { fprintf(stderr, "kernel_launch: occupancy query says %d\n", per_cu); per_cu = 1; }
        (void)hipGetLastError();
        grid = cus * per_cu;
        fprintf(stderr, "kernel_launch: grid %d (cus %d x %d)\n", grid, cus, per_cu);
    }
    if (grid < 0) return;
    Args a{};
    for (int i = 0; i < 17; ++i) a.in[i] = (const float*)d_in[i];
    a.out = (float*)d_out; a.ws = (unsigned char*)d_ws;
#if MK_N_LAUNCHES == 1
    a.ph_lo = 0; a.ph_hi = N_PHASES;
    void* kargs[] = {&a};
    hipError_t e = hipLaunchCooperativeKernel((const void*)fwd_megakernel, dim3(grid), dim3(NTHR), kargs, LDS_BYTES, stream);
    if (e != hipSuccess) fprintf(stderr, "kernel_launch: cooperative launch failed: %s (grid %d)\n", hipGetErrorString(e), grid);
#else
    for (int k = 0; k < N_PHASES; ++k) { a.ph_lo = k; a.ph_hi = k + 1;
        hipLaunchKernelGGL(fwd_megakernel, dim3(grid), dim3(NTHR), LDS_BYTES, stream, a);
        const hipError_t le = hipPeekAtLastError(); if (le != hipSuccess) { fprintf(stderr, "kernel_launch: launch %d failed: %s\n", k, hipGetErrorName(le)); break; } }
#endif
}
```

```cpp
#include <hip/hip_runtime.h>
#include <hip/hip_cooperative_groups.h>
#include <cstdio>
#include <cstdint>
namespace cg = cooperative_groups;
#ifndef MK_N_LAUNCHES
#define MK_N_LAUNCHES 1
#endif
namespace pg8 {
#define PG8_LAS __attribute__((address_space(3)))
typedef unsigned short bf16_t;
typedef short bf16x8 __attribute__((ext_vector_type(8)));
typedef float f32x4 __attribute__((ext_vector_type(4)));
typedef unsigned u32x4 __attribute__((ext_vector_type(4)));
constexpr int BM = 256, BK = 64, HALF = 128, HTB = HALF * BK * 2  , STAGE_BYTES = 8 * HTB, NXCD = 8, WGM = 8;

__host__ __device__ __forceinline__ int lds_byte(int r, int c) { const int st = (r >> 4) * 2 + (c >> 5), rr = r & 15, cc = c & 31, ob = rr * 64 + cc * 2; return st * 1024 + (ob ^ (((ob >> 9) & 1) << 5)); }
__host__ __device__ __forceinline__ void stage_rc(int b, int& R, int& C) { const int st = b / 1024, sb = b % 1024, swz = sb ^ (((sb >> 9) & 1) << 5); R = (st >> 1) * 16 + swz / 64; C = (st & 1) * 32 + (swz % 64) / 2; }
__host__ __device__ __forceinline__ int perm32(int rho) { const int n = rho >> 4, i = rho & 15; return 8 * (i >> 2) + 4 * n + (i & 3); }

struct Unit { int pm, pn; };
struct Gemm { const bf16_t* A; const bf16_t* Bt; int M, N, K; };

struct StaticOrder {
    int nM, nN, nwg, G, c;
    __host__ __device__ void init(int M, int N, int G_, int c_) { nM = M / BM; nN = N / BM; nwg = nM * nN; G = G_; c = c_; }
    __host__ __device__ bool next(int i, Unit& u) const {
        const long L = (long)i * G + c; if (L >= nwg) return false;
        int wgid = (int)L; { const int q = nwg / NXCD, r = nwg % NXCD, xcd = wgid % NXCD, off = wgid / NXCD; wgid = (xcd < r ? xcd * (q + 1) : r * (q + 1) + (xcd - r) * q) + off; }
        const int nig = WGM * nN, gid = wgid / nig, fm = gid * WGM, gsz = (nM - fm) < WGM ? (nM - fm) : WGM;
        u.pm = fm + ((wgid % nig) % gsz); u.pn = (wgid % nig) / gsz; return true;
    }
    __device__ __forceinline__ void a_ready(const Unit&) const {}
    __device__ __forceinline__ void done(const Unit&) const {}
};

__device__ __forceinline__ unsigned cvt_pk_bf16(float lo, float hi) { unsigned r; asm volatile("v_cvt_pk_bf16_f32 %0, %1, %2" : "=v"(r) : "v"(lo), "v"(hi)); return r; }
typedef float f32x2 __attribute__((ext_vector_type(2)));
__device__ __forceinline__ f32x2 gelu_pk(f32x2 v) {
    const f32x2 av = __builtin_elementwise_abs(v), d = av * 0.2316418882f + 1.0f;
    f32x2 t; t.x = __builtin_amdgcn_rcpf(d.x); t.y = __builtin_amdgcn_rcpf(d.y);
    f32x2 q = t * 0.5307027145f + (-0.7265760135f); q = q * t + 0.7107068705f; q = q * t + (-0.142248368f); q = q * t + 0.127414796f; q = q * t;
    const f32x2 s = (v * v) * (-0.72134752044f);
    f32x2 e; e.x = __builtin_amdgcn_exp2f(s.x); e.y = __builtin_amdgcn_exp2f(s.y);
    const f32x2 m = v * (q * e), r = v - m;
    f32x2 o; o.x = v.x < 0.f ? m.x : r.x; o.y = v.y < 0.f ? m.y : r.y; return o;
}
typedef __bf16 bf16x2_t __attribute__((ext_vector_type(2)));
__device__ __forceinline__ unsigned cvtpk(float lo, float hi) { f32x2 v = {lo, hi}; bf16x2_t b = __builtin_convertvector(v, bf16x2_t); return __builtin_bit_cast(unsigned, b); }
__device__ __forceinline__ float bflo(unsigned u) { return __uint_as_float(u << 16); }
__device__ __forceinline__ float bfhi(unsigned u) { return __uint_as_float(u & 0xffff0000u); }
__device__ __forceinline__ float sigm(float x) { return __builtin_amdgcn_rcpf(1.0f + __builtin_amdgcn_exp2f(-1.4426950408889634f * x)); }
__device__ __forceinline__ u32x4 pack8(f32x4 v0, f32x4 v1) { u32x4 w; w.x = cvtpk(v0[0], v0[1]); w.y = cvtpk(v0[2], v0[3]); w.z = cvtpk(v1[0], v1[1]); w.w = cvtpk(v1[2], v1[3]); return w; }
constexpr int PROJ_LD = 3840;
constexpr float QSCALE = 0.125f * 1.4426950408889634f;

struct EpiProj {
    static constexpr bool PERM = true, AFTER_DRAIN = false, MID = false;
    bf16_t* O;
    __device__ __forceinline__ void mid(f32x4 (&)[2][2][4][2], const Unit&, int, int, int, int) const {}
    __device__ __forceinline__ void operator()(const f32x4 (&acc)[2][2][4][2], const Unit& u, int wr, int wc, int fr, int fq) const {
        const int row0 = u.pm * BM + wr * 64 + fr, col0 = u.pn * BM + wc * 32 + 8 * fq;
        const int mode = u.pn < 3 ? 0 : (u.pn < 7 ? 1 : 2); const float sc = u.pn < 2 ? QSCALE : 1.0f;
#pragma unroll
        for (int ai = 0; ai < 2; ++ai)
#pragma unroll
            for (int m = 0; m < 4; ++m) { bf16_t* rowp = O + (size_t)(row0 + ai * HALF + m * 16) * PROJ_LD + col0;
#pragma unroll
                for (int bj = 0; bj < 2; ++bj) { f32x4 v0 = acc[ai][bj][m][0], v1 = acc[ai][bj][m][1];
                    if (mode == 1) { f32x2 a = gelu_pk((f32x2){v0[0], v0[1]}), b = gelu_pk((f32x2){v0[2], v0[3]}), c = gelu_pk((f32x2){v1[0], v1[1]}), d = gelu_pk((f32x2){v1[2], v1[3]});
                        v0 = (f32x4){a.x, a.y, b.x, b.y}; v1 = (f32x4){c.x, c.y, d.x, d.y}; }
                    else if (mode == 2) { v0 = (f32x4){sigm(v0[0]), sigm(v0[1]), sigm(v0[2]), sigm(v0[3])}; v1 = (f32x4){sigm(v1[0]), sigm(v1[1]), sigm(v1[2]), sigm(v1[3])}; }
                    else { v0 = v0 * sc; v1 = v1 * sc; }
                    *(u32x4*)(rowp + bj * HALF) = pack8(v0, v1); } }
    }
};
struct EpiMerge {
    static constexpr bool PERM = true, AFTER_DRAIN = false, MID = true;
    const bf16_t* P; bf16_t* O;
    __device__ __forceinline__ void mid(f32x4 (&acc)[2][2][4][2], const Unit& u, int wr, int wc, int fr, int fq) const {
        asm volatile("" : "+v"(fr), "+v"(fq));
        const int row0 = u.pm * BM + wr * 64 + fr, col0 = u.pn * BM + wc * 32 + 8 * fq;
#pragma unroll
        for (int ai = 0; ai < 2; ++ai)
#pragma unroll
            for (int m = 0; m < 4; ++m) { const bf16_t* rowp = P + (size_t)(row0 + ai * HALF + m * 16) * PROJ_LD + col0;
#pragma unroll
                for (int bj = 0; bj < 2; ++bj) { const u32x4 a = *(const u32x4*)(rowp + 1792 + bj * HALF), b = *(const u32x4*)(rowp + 2816 + bj * HALF);
                    f32x4 r0, r1;
                    r0[0] = bflo(a.x) * __builtin_amdgcn_rcpf(bflo(b.x)); r0[1] = bfhi(a.x) * __builtin_amdgcn_rcpf(bfhi(b.x)); r0[2] = bflo(a.y) * __builtin_amdgcn_rcpf(bflo(b.y)); r0[3] = bfhi(a.y) * __builtin_amdgcn_rcpf(bfhi(b.y));
                    r1[0] = bflo(a.z) * __builtin_amdgcn_rcpf(bflo(b.z)); r1[1] = bfhi(a.z) * __builtin_amdgcn_rcpf(bfhi(b.z)); r1[2] = bflo(a.w) * __builtin_amdgcn_rcpf(bflo(b.w)); r1[3] = bfhi(a.w) * __builtin_amdgcn_rcpf(bfhi(b.w));
                    acc[ai][bj][m][0] *= r0; acc[ai][bj][m][1] *= r1; }
                if (m & 1) asm volatile("" ::: "memory"); }
    }
    __device__ __forceinline__ void operator()(const f32x4 (&acc)[2][2][4][2], const Unit& u, int wr, int wc, int fr, int fq) const {
        const int row0 = u.pm * BM + wr * 64 + fr, col0 = u.pn * BM + wc * 32 + 8 * fq;
#pragma unroll
        for (int ai = 0; ai < 2; ++ai)
#pragma unroll
            for (int m = 0; m < 4; ++m) { const size_t row = (size_t)(row0 + ai * HALF + m * 16); const bf16_t* rowp = P + row * PROJ_LD + col0;
#pragma unroll
                for (int bj = 0; bj < 2; ++bj) { const u32x4 b = *(const u32x4*)(rowp + 2816 + bj * HALF);
                    const f32x4 s0 = {bflo(b.x), bfhi(b.x), bflo(b.y), bfhi(b.y)}, s1 = {bflo(b.z), bfhi(b.z), bflo(b.w), bfhi(b.w)};
                    *(u32x4*)(O + row * 1024 + col0 + bj * HALF) = pack8(acc[ai][bj][m][0] * s0, acc[ai][bj][m][1] * s1); }
                asm volatile("" ::: "memory"); }
    }
};
struct EpiSsq {
    static constexpr bool PERM = true, AFTER_DRAIN = false, MID = false;
    bf16_t* O; float* ssq;
    __device__ __forceinline__ void mid(f32x4 (&)[2][2][4][2], const Unit&, int, int, int, int) const {}
    __device__ __forceinline__ void operator()(const f32x4 (&acc)[2][2][4][2], const Unit& u, int wr, int wc, int fr, int fq) const {
        const int row0 = u.pm * BM + wr * 64 + fr, col0 = u.pn * BM + wc * 32 + 8 * fq;
#pragma unroll
        for (int ai = 0; ai < 2; ++ai)
#pragma unroll
            for (int m = 0; m < 4; ++m) { const size_t row = (size_t)(row0 + ai * HALF + m * 16); float s = 0.f;
#pragma unroll
                for (int bj = 0; bj < 2; ++bj) { const f32x4 v0 = acc[ai][bj][m][0], v1 = acc[ai][bj][m][1];
                    s += (v0[0] * v0[0] + v0[1] * v0[1]) + (v0[2] * v0[2] + v0[3] * v0[3]) + (v1[0] * v1[0] + v1[1] * v1[1]) + (v1[2] * v1[2] + v1[3] * v1[3]);
                    *(u32x4*)(O + row * 1024 + col0 + bj * HALF) = pack8(v0, v1); }
                s += __shfl_xor(s, 16); s += __shfl_xor(s, 32);
                if (fq == 0) ssq[row * 16 + u.pn * 4 + wc] = s; }
    }
};
struct EpiSwiglu {
    static constexpr bool PERM = true, AFTER_DRAIN = false, MID = false;
    bf16_t* O;
    __device__ __forceinline__ void mid(f32x4 (&)[2][2][4][2], const Unit&, int, int, int, int) const {}
    __device__ __forceinline__ void operator()(const f32x4 (&acc)[2][2][4][2], const Unit& u, int wr, int wc, int fr, int fq) const {
        const int row0 = u.pm * BM + wr * 64 + fr, col0 = u.pn * HALF + wc * 32 + 8 * fq;
#pragma unroll
        for (int ai = 0; ai < 2; ++ai)
#pragma unroll
            for (int m = 0; m < 4; ++m) { const size_t row = (size_t)(row0 + ai * HALF + m * 16);
                const f32x4 g0 = acc[ai][0][m][0], g1 = acc[ai][0][m][1], u0 = acc[ai][1][m][0], u1 = acc[ai][1][m][1];
                f32x4 h0, h1;
#pragma unroll
                for (int e = 0; e < 4; ++e) { h0[e] = g0[e] * sigm(g0[e]) * u0[e]; h1[e] = g1[e] * sigm(g1[e]) * u1[e]; }
                *(u32x4*)(O + row * 2816 + col0) = pack8(h0, h1); }
    }
};
template <class Epi, class Sched, bool ALIGN_EPI = false, bool SP2 = false>
__device__ __forceinline__ void gemm_phase(PG8_LAS unsigned char* lds, const Gemm g, const Sched& S, const Epi& E) {
    const int tid = threadIdx.x, wid = __builtin_amdgcn_readfirstlane(tid >> 6), lane = tid & 63, wr = wid >> 2, wc = wid & 3, fr = lane & 15, fq = lane >> 4;
    const int K = g.K, nt = K / BK;
    unsigned voffA[2], voffB[2];
#pragma unroll
    for (int i = 0; i < 2; ++i) { int R, C; stage_rc(tid * 16 + i * 8192, R, C); const int Rb = Epi::PERM ? ((R & ~31) + perm32(R & 31)) : R;
        voffA[i] = (unsigned)(R * K + C) * 2u; voffB[i] = (unsigned)(Rb * K + C) * 2u; }
    const size_t kstep = (size_t)(BK * 2);
    const size_t hstep = (size_t)HALF * K * 2;
    const size_t tstep = 2 * hstep;
    const unsigned ldsw = (unsigned)wid * 1024u;
    const int aoff = lds_byte(wr * 64 + fr, fq * 8), boff = lds_byte(wc * 32 + fr, fq * 8);
#define PG8_SA(b, h) (((b) * 2 + (h)) * HTB)
#define PG8_SB(b, h) ((4 + (b) * 2 + (h)) * HTB)
#define PG8_STAGE(bufoff, gbase, voff) do { _Pragma("unroll") for (int _i = 0; _i < 2; ++_i) \
        __builtin_amdgcn_global_load_lds((const unsigned*)((const char*)(gbase) + (voff)[_i]), (PG8_LAS unsigned*)(lds + (bufoff) + ldsw + _i * 8192), 16, 0, 0); } while (0)
#define PG8_LDA(dst, b, h) do { _Pragma("unroll") for (int m = 0; m < 4; ++m) _Pragma("unroll") for (int k = 0; k < 2; ++k) dst[m][k] = *(const PG8_LAS bf16x8*)(lds + PG8_SA(b, h) + aoff + m * 2048 + k * 1024); } while (0)
#define PG8_LDB(dst, b, h) do { _Pragma("unroll") for (int n = 0; n < 2; ++n) _Pragma("unroll") for (int k = 0; k < 2; ++k) dst[n][k] = *(const PG8_LAS bf16x8*)(lds + PG8_SB(b, h) + boff + n * 2048 + k * 1024); } while (0)
#define PG8_MMA(ai, bj, At, Bt) do { __builtin_amdgcn_s_setprio(1); _Pragma("unroll") for (int m = 0; m < 4; ++m) _Pragma("unroll") for (int n = 0; n < 2; ++n) _Pragma("unroll") for (int k = 0; k < 2; ++k) \
        acc[ai][bj][m][n] = __builtin_amdgcn_mfma_f32_16x16x32_bf16(Bt[n][k], At[m][k], acc[ai][bj][m][n], 0, 0, 0); __builtin_amdgcn_s_setprio(0); } while (0)
#define PG8_WAIT_V(n) asm volatile("s_waitcnt vmcnt(" #n ")" ::: "memory")
#define PG8_WAIT_L(n) asm volatile("s_waitcnt lgkmcnt(" #n ")" ::: "memory")
#define PG8_BAR __builtin_amdgcn_s_barrier()
#define PG8_SCHED __builtin_amdgcn_sched_barrier(0)
    Unit cur, nxt; int ui = 0;
    if (!S.next(0, cur)) return;
    f32x4 acc[2][2][4][2];
#pragma unroll
    for (int a = 0; a < 2; ++a)
#pragma unroll
        for (int b = 0; b < 2; ++b)
#pragma unroll
            for (int m = 0; m < 4; ++m)
#pragma unroll
                for (int n = 0; n < 2; ++n) acc[a][b][m][n] = (f32x4){0.f, 0.f, 0.f, 0.f};
    bf16x8 At[4][2], B0[2][2], B1[2][2];
    const char* cA = (const char*)g.A + (size_t)cur.pm * tstep; const char* cB = (const char*)g.Bt + (size_t)cur.pn * tstep;
    S.a_ready(cur);
    if constexpr (SP2) {
        PG8_STAGE(PG8_SB(0, 0), cB, voffB); PG8_STAGE(PG8_SB(0, 1), cB + hstep, voffB); PG8_STAGE(PG8_SA(0, 0), cA, voffA); PG8_STAGE(PG8_SA(0, 1), cA + hstep, voffA);
        if (wr == 1) PG8_BAR;
        PG8_WAIT_V(2); PG8_BAR;
        PG8_STAGE(PG8_SB(1, 0), cB + kstep, voffB); PG8_STAGE(PG8_SA(1, 0), cA + kstep, voffA); PG8_STAGE(PG8_SB(1, 1), cB + hstep + kstep, voffB);
        PG8_WAIT_V(6); PG8_BAR;
    } else {
        PG8_STAGE(PG8_SB(0, 0), cB, voffB); PG8_STAGE(PG8_SA(0, 0), cA, voffA); PG8_STAGE(PG8_SB(0, 1), cB + hstep, voffB); PG8_STAGE(PG8_SA(0, 1), cA + hstep, voffA);
        if (wr == 1) PG8_BAR;
        PG8_WAIT_V(4); PG8_BAR;
        PG8_STAGE(PG8_SB(1, 0), cB + kstep, voffB); PG8_STAGE(PG8_SA(1, 0), cA + kstep, voffA); PG8_STAGE(PG8_SB(1, 1), cB + hstep + kstep, voffB);
        PG8_WAIT_V(6); PG8_BAR;
    }
    for (;;) {
        const bool has_next = S.next(ui + 1, nxt);
        const char* nA = has_next ? (const char*)g.A + (size_t)nxt.pm * tstep : cA; const char* nB = has_next ? (const char*)g.Bt + (size_t)nxt.pn * tstep : cB;
        for (int t = 0; t < nt; t += 2) {
            const bool last = (t == nt - 2);
            if constexpr (Epi::MID) { if (t == (nt >> 1)) E.mid(acc, cur, wr, wc, fr, fq); }
            const char* a1 = cA + (size_t)(t + 1) * kstep;
            const char* a2 = last ? nA : cA + (size_t)(t + 2) * kstep; const char* b2 = last ? nB : cB + (size_t)(t + 2) * kstep;
            const char* a3 = a2 + kstep; const char* b3 = b2 + kstep;
            if (last && has_next) S.a_ready(nxt);
            if constexpr (SP2) {
            PG8_LDB(B0, 0, 0); PG8_LDB(B1, 0, 1); PG8_SCHED; PG8_LDA(At, 0, 0); PG8_STAGE(PG8_SA(1, 1), a1 + hstep, voffA);
            PG8_WAIT_V(8); PG8_WAIT_L(0); PG8_BAR; PG8_MMA(0, 0, At, B0); PG8_MMA(0, 1, At, B1); PG8_BAR; PG8_SCHED;
            PG8_LDA(At, 0, 1); PG8_STAGE(PG8_SB(0, 0), b2, voffB); PG8_STAGE(PG8_SB(0, 1), b2 + hstep, voffB); PG8_STAGE(PG8_SA(0, 0), a2, voffA);
            PG8_WAIT_V(8); PG8_WAIT_L(0); PG8_BAR; PG8_MMA(1, 0, At, B0); PG8_MMA(1, 1, At, B1); PG8_BAR; PG8_SCHED;
            PG8_LDB(B0, 1, 0); PG8_LDB(B1, 1, 1); PG8_SCHED; PG8_LDA(At, 1, 0); PG8_STAGE(PG8_SA(0, 1), a2 + hstep, voffA);
            PG8_WAIT_V(8); PG8_WAIT_L(0); PG8_BAR; PG8_MMA(0, 0, At, B0); PG8_MMA(0, 1, At, B1); PG8_BAR; PG8_SCHED;
            PG8_LDA(At, 1, 1); PG8_STAGE(PG8_SB(1, 0), b3, voffB); PG8_STAGE(PG8_SB(1, 1), b3 + hstep, voffB); PG8_STAGE(PG8_SA(1, 0), a3, voffA);
            PG8_WAIT_V(8); PG8_WAIT_L(0); PG8_BAR; PG8_MMA(1, 0, At, B0); PG8_MMA(1, 1, At, B1); PG8_BAR; PG8_SCHED;
            } else {
            PG8_LDB(B0, 0, 0); PG8_SCHED; PG8_LDA(At, 0, 0); PG8_STAGE(PG8_SA(1, 1), a1 + hstep, voffA);
            PG8_WAIT_L(8); PG8_BAR; PG8_WAIT_L(0); PG8_MMA(0, 0, At, B0); PG8_BAR; PG8_SCHED;
            PG8_LDB(B1, 0, 1); PG8_STAGE(PG8_SB(0, 0), b2, voffB);
            PG8_BAR; PG8_WAIT_L(0); PG8_MMA(0, 1, At, B1); PG8_BAR;
            PG8_LDA(At, 0, 1); PG8_STAGE(PG8_SA(0, 0), a2, voffA);
            PG8_BAR; PG8_WAIT_L(0); PG8_MMA(1, 0, At, B0); PG8_BAR; PG8_SCHED;
            PG8_STAGE(PG8_SB(0, 1), b2 + hstep, voffB);
            PG8_WAIT_V(6); PG8_BAR; PG8_MMA(1, 1, At, B1); PG8_BAR;
            PG8_LDB(B0, 1, 0); PG8_SCHED; PG8_LDA(At, 1, 0); PG8_STAGE(PG8_SA(0, 1), a2 + hstep, voffA);
            PG8_WAIT_L(8); PG8_BAR; PG8_WAIT_L(0); PG8_MMA(0, 0, At, B0); PG8_BAR; PG8_SCHED;
            PG8_LDB(B1, 1, 1); PG8_STAGE(PG8_SB(1, 0), b3, voffB);
            PG8_BAR; PG8_WAIT_L(0); PG8_MMA(0, 1, At, B1); PG8_BAR;
            PG8_LDA(At, 1, 1); PG8_STAGE(PG8_SA(1, 0), a3, voffA);
            PG8_BAR; PG8_WAIT_L(0); PG8_MMA(1, 0, At, B0); PG8_BAR; PG8_SCHED;
            PG8_STAGE(PG8_SB(1, 1), b3 + hstep, voffB);
            PG8_WAIT_V(6); PG8_BAR; PG8_MMA(1, 1, At, B1); PG8_BAR;
            }
        }
        if constexpr (ALIGN_EPI) { if (wr == 0) PG8_BAR; }
        if constexpr (!Epi::AFTER_DRAIN) { E(acc, cur, wr, wc, fr, fq); S.done(cur); }
        if (!has_next) break;
#pragma unroll
        for (int a = 0; a < 2; ++a)
#pragma unroll
            for (int b = 0; b < 2; ++b)
#pragma unroll
                for (int m = 0; m < 4; ++m)
#pragma unroll
                    for (int n = 0; n < 2; ++n) acc[a][b][m][n] = (f32x4){0.f, 0.f, 0.f, 0.f};
        cur = nxt; cA = nA; cB = nB; ++ui;
        if constexpr (ALIGN_EPI) { if (wr == 1) PG8_BAR; }
    }
    PG8_WAIT_V(0);
    if constexpr (!ALIGN_EPI) { if (wr == 0) PG8_BAR; }
    PG8_BAR;
    if constexpr (Epi::AFTER_DRAIN) { E.fused(acc, cur, wr, wc, fr, fq, lds, wid, lane); S.done(cur); }
#undef PG8_SA
#undef PG8_SB
#undef PG8_STAGE
#undef PG8_LDA
#undef PG8_LDB
#undef PG8_MMA
#undef PG8_WAIT_V
#undef PG8_WAIT_L
#undef PG8_BAR
#undef PG8_SCHED
}
}

constexpr int NWAVES = 8, NTHR = 512;
constexpr int BATCH = 32, SEQ = 2048, D = 1024, M = BATCH * SEQ;
constexpr int INW = 3840, FF = 2816;
constexpr int C_K = 512, C_V = 640, C_U = 768, C_VG = 1280;
constexpr float EPS = 1e-6f, LN_EPS = 1e-5f, LOG2E = 1.4426950408889634f;
constexpr size_t MiB = 1u << 20;
constexpr size_t WS_WIN = 0;
constexpr size_t WS_WAB = 8 * MiB;
constexpr size_t WS_WOUT = 10 * MiB;
constexpr size_t WS_WGU = 12 * MiB;
constexpr size_t WS_WD = 24 * MiB;
constexpr size_t WS_WSP = 30 * MiB;
constexpr size_t WS_RSTD = 31 * MiB;
constexpr size_t WS_SSQA = 32 * MiB;
constexpr size_t WS_SSQB = 36 * MiB;
constexpr size_t WS_XN = 40 * MiB;
constexpr size_t WS_AG = 168 * MiB;
constexpr size_t WS_MG = 296 * MiB;
constexpr size_t WS_PROJ = 424 * MiB;
constexpr size_t WS_HB16 = WS_PROJ + 352 * MiB;
constexpr size_t WS_END = 904 * MiB;
constexpr int LDS_BYTES = 147456;

#define GAS __attribute__((address_space(1)))
#define LAS __attribute__((address_space(3)))
typedef unsigned short bf16;
typedef unsigned v4u __attribute__((ext_vector_type(4)));
typedef unsigned v2u __attribute__((ext_vector_type(2)));
typedef float f32x4 __attribute__((ext_vector_type(4)));
typedef float f32x16 __attribute__((ext_vector_type(16)));
typedef short bf16x8 __attribute__((ext_vector_type(8)));
typedef short s16x4 __attribute__((ext_vector_type(4)));
using pg8::cvtpk; using pg8::bflo; using pg8::bfhi;
#define LDS_WAIT() asm volatile("s_waitcnt lgkmcnt(0)" ::: "memory")
__device__ __forceinline__ unsigned short f2bf(float f) { return (unsigned short)(cvtpk(f, 0.f) & 0xffffu); }
__device__ __forceinline__ float bf2f(unsigned short h) { return __uint_as_float((unsigned)h << 16); }
__device__ __forceinline__ float wave_sum(float v) {
#pragma unroll
    for (int o = 1; o < 64; o <<= 1) v += __shfl_xor(v, o);
    return v;
}
__device__ __forceinline__ int crow(int r, int hi) { return (r & 3) + 8 * (r >> 2) + 4 * hi; }

struct Frame {
    LAS unsigned char* lds;
    int tid, lane, wave, G, bid;
    const float* in[17]; float* out; unsigned char* ws;
};
__device__ __forceinline__ int rowmap(int mode, int n) { return mode == 0 ? n : (((n >> 7) << 8) + (n & 127) + (mode == 2 ? 128 : 0)); }
__device__ __forceinline__ void p0_transpose_item(const float* W, int N, bf16* WT, int ldk, int koff, int mode, LAS float* scr, int item, int lane, const float* kscale = nullptr) {
    const int nblk = N / 32, kb = item / nblk, nb = item % nblk, k0 = 64 * kb, n0 = 32 * nb;
#pragma unroll 8
    for (int i = 0; i < 32; ++i) { const int kk = 2 * i + (lane >> 5); float w = W[(size_t)(k0 + kk) * N + n0 + (lane & 31)]; if (kscale) w *= kscale[k0 + kk]; scr[kk * 33 + (lane & 31)] = w; }
    LDS_WAIT(); asm volatile("" ::: "memory");
    const int c = lane & 7;
#pragma unroll
    for (int j = 0; j < 4; ++j) { const int n = (lane >> 3) + 8 * j; const LAS float* s = scr + (8 * c) * 33 + n;
        v4u o; o.x = cvtpk(s[0 * 33], s[1 * 33]); o.y = cvtpk(s[2 * 33], s[3 * 33]); o.z = cvtpk(s[4 * 33], s[5 * 33]); o.w = cvtpk(s[6 * 33], s[7 * 33]);
        *(GAS v4u*)(WT + (size_t)rowmap(mode, n0 + n) * ldk + koff + k0 + 8 * c) = o; }
    LDS_WAIT(); asm volatile("" ::: "memory");
}
__device__ __forceinline__ void rms_row_to_bf16(int lane, const float* xrow, float* rstd_out, bf16* orow) {
    const GAS f32x4* xr = (const GAS f32x4*)xrow + lane;
    f32x4 v[4]; float s = 0.f;
#pragma unroll
    for (int j = 0; j < 4; ++j) { v[j] = xr[64 * j]; s += (v[j].x * v[j].x + v[j].y * v[j].y) + (v[j].z * v[j].z + v[j].w * v[j].w); }
    const float rstd = 1.0f / sqrtf(wave_sum(s) * (1.f / D) + EPS);
    if (lane == 0) *rstd_out = rstd;
    GAS v2u* o8 = (GAS v2u*)orow + lane;
#pragma unroll
    for (int j = 0; j < 4; ++j) { v2u w; w.x = cvtpk(v[j].x * rstd, v[j].y * rstd); w.y = cvtpk(v[j].z * rstd, v[j].w * rstd); o8[64 * j] = w; }
}
__device__ __forceinline__ void p0_prologue(Frame& F) {
    LAS float* scr = (LAS float*)(F.lds + F.wave * 16384);
    const int gw = F.bid * NWAVES + F.wave, NGW = F.G * NWAVES;
    unsigned char* ws = F.ws;
    constexpr int I_IN = (1024 / 64) * (INW / 32), I_A = (512 / 64) * (1024 / 32), I_O = (1024 / 64) * (1024 / 32), I_G = (1024 / 64) * (FF / 32), I_D = (FF / 64) * (1024 / 32);
    constexpr int NITEMS = I_IN + 2 * I_A + I_O + 2 * I_G + I_D;
    for (int it = gw; it < NITEMS; it += NGW) {
        int r = it;
        if (r < I_IN) { p0_transpose_item(F.in[2], INW, (bf16*)(ws + WS_WIN), 1024, 0, 0, scr, r, F.lane, F.in[1]); continue; } r -= I_IN;
        if (r < I_A) { p0_transpose_item(F.in[8], 1024, (bf16*)(ws + WS_WAB), 1024, 0, 0, scr, r, F.lane); continue; } r -= I_A;
        if (r < I_A) { p0_transpose_item(F.in[9], 1024, (bf16*)(ws + WS_WAB), 1024, 512, 0, scr, r, F.lane); continue; } r -= I_A;
        if (r < I_O) { p0_transpose_item(F.in[10], 1024, (bf16*)(ws + WS_WOUT), 1024, 0, 0, scr, r, F.lane); continue; } r -= I_O;
        if (r < I_G) { p0_transpose_item(F.in[13], FF, (bf16*)(ws + WS_WGU), 1024, 0, 1, scr, r, F.lane); continue; } r -= I_G;
        if (r < I_G) { p0_transpose_item(F.in[14], FF, (bf16*)(ws + WS_WGU), 1024, 0, 2, scr, r, F.lane); continue; } r -= I_G;
        p0_transpose_item(F.in[15], 1024, (bf16*)(ws + WS_WD), FF, 0, 0, scr, r, F.lane);
    }
    { const float* wsrc = F.in[6]; bf16* wdst = (bf16*)(ws + WS_WSP);
      for (int i = gw * 64 + F.lane; i < 4 * 128 * 128; i += NGW * 64) { const int t = (i >> 7) & 127, s = i & 127; wdst[i] = f2bf(s <= t ? wsrc[i] : 0.f); } }
    bf16* XN = (bf16*)(ws + WS_XN);
    float* RSTD = (float*)(ws + WS_RSTD);
    for (int m = gw; m < M; m += NGW) rms_row_to_bf16(F.lane, F.in[0] + (size_t)m * D, RSTD + m, XN + (size_t)m * D);
}
constexpr int KS_ROW = 144, VT_ROW = 260  , KS_BYTES = 256 * KS_ROW;
__device__ __forceinline__ void attn_unit(Frame& F, const bf16* PROJ, bf16* AG, const float* sinks, int unit) {
    const int tid = F.tid, lane = F.lane, wave = F.wave, lq = lane & 31, hi = lane >> 5;
    const int kvh = unit & 1, n = (unit >> 1) & 15, b = unit >> 5;
    const long T0 = (long)b * SEQ + n * 128;
    LAS unsigned char* Ks = F.lds; LAS unsigned short* VT = (LAS unsigned short*)(F.lds + KS_BYTES);
    const int jstart = (n == 0) ? 128 : 0;
#pragma unroll
    for (int it = 0; it < 4; ++it) { const int id = it * NTHR + tid, key = id >> 3, ch = id & 7;
        if (key >= jstart) { const bf16* src = PROJ + (T0 - 128 + key) * INW + C_K + kvh * 64 + ch * 8;
            const v4u kv = *(const GAS v4u*)src, vv = *(const GAS v4u*)(src + 128);
            *(LAS v4u*)(Ks + key * KS_ROW + ch * 16) = kv;
            LAS unsigned short* vt = VT + (ch * 8) * VT_ROW + key;
            vt[0 * VT_ROW] = (unsigned short)(vv.x & 0xffffu); vt[1 * VT_ROW] = (unsigned short)(vv.x >> 16);
            vt[2 * VT_ROW] = (unsigned short)(vv.y & 0xffffu); vt[3 * VT_ROW] = (unsigned short)(vv.y >> 16);
            vt[4 * VT_ROW] = (unsigned short)(vv.z & 0xffffu); vt[5 * VT_ROW] = (unsigned short)(vv.z >> 16);
            vt[6 * VT_ROW] = (unsigned short)(vv.w & 0xffffu); vt[7 * VT_ROW] = (unsigned short)(vv.w >> 16); } }
    __syncthreads();
#pragma unroll 1
    for (int pass = 0; pass < 2; ++pass) {
        int lqo = lq; asm volatile("" : "+v"(lqo));
        const int g = pass * 2 + (wave >> 2), wq = wave & 3, hq = kvh * 4 + g;
        const float slope2 = __builtin_amdgcn_exp2f(-(float)(hq + 1)) * LOG2E, sink2 = sinks[hq] * LOG2E;
        const bf16* qp = PROJ + (T0 + 32 * wq + lq) * INW + hq * 64 + 8 * hi;
        bf16x8 qf[4];
#pragma unroll
        for (int ds = 0; ds < 4; ++ds) qf[ds] = *(const GAS bf16x8*)(qp + 16 * ds);
        f32x16 S[5];
#pragma unroll
        for (int i = 0; i < 5; ++i) { const int kt = wq + i; const bool skip = (n == 0 && kt < 4);
#pragma unroll
            for (int r = 0; r < 16; ++r) S[i][r] = 0.f;
            if (!skip) {
#pragma unroll
                for (int ds = 0; ds < 4; ++ds) { const bf16x8 kf = *(const LAS bf16x8*)(Ks + (32 * kt + lq) * KS_ROW + (16 * ds + 8 * hi) * 2);
                    S[i] = __builtin_amdgcn_mfma_f32_32x32x16_bf16(kf, qf[ds], S[i], 0, 0, 0); } }
            __builtin_amdgcn_sched_barrier(0); }
        float mx = sink2;
#pragma unroll
        for (int i = 0; i < 5; ++i) { const bool skip = (n == 0 && wq + i < 4);
#pragma unroll
            for (int r = 0; r < 16; ++r) { const int rel = 128 - 32 * i + lqo - crow(r, hi);
                const bool valid = !skip && (i == 0 ? rel <= 127 : (i == 4 ? rel >= 0 : true));
                const float lg = valid ? S[i][r] - slope2 * (float)rel : -1e30f; S[i][r] = lg; mx = fmaxf(mx, lg); } }
        mx = fmaxf(mx, __shfl_xor(mx, 32));
        float sum = 0.f;
#pragma unroll
        for (int i = 0; i < 5; ++i)
#pragma unroll
            for (int r = 0; r < 16; ++r) { const float p = __builtin_amdgcn_exp2f(S[i][r] - mx); S[i][r] = p; sum += p; }
        sum += __shfl_xor(sum, 32); sum += __builtin_amdgcn_exp2f(sink2 - mx);
        const float inv = 1.0f / sum;
        f32x16 O[2];
#pragma unroll
        for (int r = 0; r < 16; ++r) { O[0][r] = 0.f; O[1][r] = 0.f; }
#pragma unroll
        for (int i = 0; i < 5; ++i) { const int kt = wq + i; const bool skip = (n == 0 && kt < 4);
            if (!skip) {
#pragma unroll
                for (int s = 0; s < 2; ++s) {
                    v4u pw; pw.x = cvtpk(S[i][8 * s + 0], S[i][8 * s + 1]); pw.y = cvtpk(S[i][8 * s + 2], S[i][8 * s + 3]); pw.z = cvtpk(S[i][8 * s + 4], S[i][8 * s + 5]); pw.w = cvtpk(S[i][8 * s + 6], S[i][8 * s + 7]);
                    const bf16x8 pf = __builtin_bit_cast(bf16x8, pw);
#pragma unroll
                    for (int dt = 0; dt < 2; ++dt) { const LAS unsigned short* vp = VT + (32 * dt + lq) * VT_ROW + 32 * kt + 16 * s + 4 * hi;
                        const s16x4 lo = *(const LAS s16x4*)vp, h8 = *(const LAS s16x4*)(vp + 8);
                        const bf16x8 vf = __builtin_shufflevector(lo, h8, 0, 1, 2, 3, 4, 5, 6, 7);
                        O[dt] = __builtin_amdgcn_mfma_f32_32x32x16_bf16(vf, pf, O[dt], 0, 0, 0); } } }
            __builtin_amdgcn_sched_barrier(0); }
        bf16* op = AG + (T0 + 32 * wq + lq) * 1024 + hq * 64 + 4 * hi;
#pragma unroll
        for (int dt = 0; dt < 2; ++dt)
#pragma unroll
            for (int j = 0; j < 4; ++j) { v2u w; w.x = cvtpk(O[dt][4 * j] * inv, O[dt][4 * j + 1] * inv); w.y = cvtpk(O[dt][4 * j + 2] * inv, O[dt][4 * j + 3] * inv);
                *(GAS v2u*)(op + 32 * dt + 8 * j) = w; }
    }
    __syncthreads();
}
constexpr int GV_ROW = 132;
__device__ __forceinline__ void gmlp_unit(Frame& F, const bf16* PROJ, bf16* AG, const float* ln_g, const float* ln_b, const bf16* WSP, const float* b_s, int unit) {
    const int lane = F.lane, wave = F.wave, lq = lane & 31, hi = lane >> 5;
    const int n = unit & 15, b = unit >> 4; const long T0 = (long)b * SEQ + n * 128;
    LAS unsigned short* VT = (LAS unsigned short*)F.lds;
    float gch[8], bch[8];
#pragma unroll
    for (int i = 0; i < 8; ++i) { gch[i] = ln_g[lane + 64 * i]; bch[i] = ln_b[lane + 64 * i]; }
#pragma unroll 2
    for (int tk = 0; tk < 16; ++tk) { const int s = 16 * wave + tk; const bf16* vp = PROJ + (T0 + s) * INW + C_VG + lane;
        float x[8]; float sm = 0.f;
#pragma unroll
        for (int i = 0; i < 8; ++i) { x[i] = bf2f(vp[64 * i]); sm += x[i]; }
        const float mean = wave_sum(sm) * (1.f / 512.f); float q = 0.f;
#pragma unroll
        for (int i = 0; i < 8; ++i) { x[i] -= mean; q += x[i] * x[i]; }
        const float rstd = 1.0f / sqrtf(wave_sum(q) * (1.f / 512.f) + LN_EPS);
#pragma unroll
        for (int i = 0; i < 8; ++i) VT[(lane + 64 * i) * GV_ROW + s] = f2bf(x[i] * rstd * gch[i] + bch[i]); }
    __syncthreads();
    const int g = wave >> 1, cb = g * 128 + 64 * (wave & 1);
    f32x16 acc[2][4];
#pragma unroll
    for (int mt = 0; mt < 2; ++mt)
#pragma unroll
        for (int nt = 0; nt < 4; ++nt)
#pragma unroll
            for (int r = 0; r < 16; ++r) acc[mt][nt][r] = 0.f;
    const bf16* wg = WSP + (size_t)g * 128 * 128 + (size_t)lq * 128 + 8 * hi;
#pragma unroll 1
    for (int ks = 0; ks < 8; ++ks) {
        bf16x8 af[2];
#pragma unroll
        for (int mt = 0; mt < 2; ++mt) { const LAS unsigned short* ap = VT + (cb + 32 * mt + lq) * GV_ROW + 16 * ks + 8 * hi;
            const s16x4 lo = *(const LAS s16x4*)ap, h8 = *(const LAS s16x4*)(ap + 4); af[mt] = __builtin_shufflevector(lo, h8, 0, 1, 2, 3, 4, 5, 6, 7); }
#pragma unroll
        for (int nt = 0; nt < 4; ++nt) if (ks < 2 * (nt + 1)) { const bf16x8 bfr = *(const GAS bf16x8*)(wg + (size_t)(32 * nt) * 128 + 16 * ks);
#pragma unroll
            for (int mt = 0; mt < 2; ++mt) acc[mt][nt] = __builtin_amdgcn_mfma_f32_32x32x16_bf16(af[mt], bfr, acc[mt][nt], 0, 0, 0); }
    }
#pragma unroll
    for (int nt = 0; nt < 4; ++nt) { const int t = 32 * nt + lq; const float bias = b_s[g * 128 + t];
        const bf16* up = PROJ + (T0 + t) * INW + C_U + cb + 4 * hi; bf16* op = AG + (T0 + t) * 1024 + 512 + cb + 4 * hi;
#pragma unroll
        for (int mt = 0; mt < 2; ++mt)
#pragma unroll
            for (int j = 0; j < 4; ++j) { const v2u uu = *(const GAS v2u*)(up + 32 * mt + 8 * j);
                v2u w; w.x = cvtpk(bflo(uu.x) * (acc[mt][nt][4 * j] + bias), bfhi(uu.x) * (acc[mt][nt][4 * j + 1] + bias));
                w.y = cvtpk(bflo(uu.y) * (acc[mt][nt][4 * j + 2] + bias), bfhi(uu.y) * (acc[mt][nt][4 * j + 3] + bias));
                *(GAS v2u*)(op + 32 * mt + 8 * j) = w; } }
    __syncthreads();
}
__device__ __forceinline__ void unpack8(const v4u mv, f32x4& a, f32x4& b) { a = (f32x4){bflo(mv.x), bfhi(mv.x), bflo(mv.y), bfhi(mv.y)}; b = (f32x4){bflo(mv.z), bfhi(mv.z), bflo(mv.w), bfhi(mv.w)}; }
__device__ __forceinline__ void e1_row(int lane, bf16* xbrow, float rstd_x, const bf16* mixrow, const float* ssq, const float* gpost, const float* gpre, bf16* hrow) {
    float t = (lane < 16) ? ssq[lane] : 0.f; t = wave_sum(t);
    const float rstd = 1.0f / sqrtf(t * (1.f / D) + EPS), rx = 1.0f / rstd_x;
    f32x4 h[2][2]; float s = 0.f;
#pragma unroll
    for (int j = 0; j < 2; ++j) { const int c = 8 * lane + 512 * j; const v4u mv = *(const GAS v4u*)(mixrow + c), xv = *(const GAS v4u*)(xbrow + c);
        const f32x4 g0 = *(const GAS f32x4*)(gpost + c), g1 = *(const GAS f32x4*)(gpost + c + 4);
        f32x4 m0, m1, x0, x1; unpack8(mv, m0, m1); unpack8(xv, x0, x1);
        h[j][0] = x0 * rx + m0 * rstd * g0; h[j][1] = x1 * rx + m1 * rstd * g1;
        *(GAS v4u*)(hrow + c) = pg8::pack8(h[j][0], h[j][1]);
#pragma unroll
        for (int e = 0; e < 4; ++e) s += h[j][0][e] * h[j][0][e] + h[j][1][e] * h[j][1][e]; }
    const float r2 = 1.0f / sqrtf(wave_sum(s) * (1.f / D) + EPS);
#pragma unroll
    for (int j = 0; j < 2; ++j) { const int c = 8 * lane + 512 * j; const f32x4 g0 = *(const GAS f32x4*)(gpre + c), g1 = *(const GAS f32x4*)(gpre + c + 4);
        *(GAS v4u*)(xbrow + c) = pg8::pack8(h[j][0] * r2 * g0, h[j][1] * r2 * g1); }
}
__device__ __forceinline__ void e2_row(int lane, const bf16* ffrow, const float* ssq, const float* gpost, const bf16* hrow, float* orow) {
    float t = (lane < 16) ? ssq[lane] : 0.f; t = wave_sum(t);
    const float rstd = 1.0f / sqrtf(t * (1.f / D) + EPS);
#pragma unroll
    for (int j = 0; j < 2; ++j) { const int c = 8 * lane + 512 * j; const v4u mv = *(const GAS v4u*)(ffrow + c), hv = *(const GAS v4u*)(hrow + c);
        const f32x4 g0 = *(const GAS f32x4*)(gpost + c), g1 = *(const GAS f32x4*)(gpost + c + 4);
        f32x4 m0, m1, x0, x1; unpack8(mv, m0, m1); unpack8(hv, x0, x1);
        *(GAS f32x4*)(orow + c) = x0 + m0 * rstd * g0; *(GAS f32x4*)(orow + c + 4) = x1 + m1 * rstd * g1; }
}
constexpr int N_PHASES = 9;
struct Args { const float* in[17]; float* out; unsigned char* ws; int ph_lo, ph_hi; };
__global__ void __launch_bounds__(NTHR, 2) fwd_megakernel(Args args) {
    extern __shared__ __attribute__((aligned(16))) unsigned char lds[];
    cg::grid_group grid = cg::this_grid();
    Frame F;
    F.lds = (LAS unsigned char*)lds;
    F.tid = threadIdx.x; F.lane = F.tid & 63; F.wave = __builtin_amdgcn_readfirstlane(F.tid >> 6);
    F.G = gridDim.x; F.bid = blockIdx.x;
#pragma unroll
    for (int i = 0; i < 17; ++i) F.in[i] = args.in[i];
    F.out = args.out; F.ws = args.ws;
    unsigned char* ws = args.ws;
    const int lo = args.ph_lo, hi = args.ph_hi;
    bf16* W_IN = (bf16*)(ws + WS_WIN); bf16* W_AB = (bf16*)(ws + WS_WAB); bf16* W_OUT = (bf16*)(ws + WS_WOUT); bf16* W_GU = (bf16*)(ws + WS_WGU); bf16* W_D = (bf16*)(ws + WS_WD); bf16* W_SP = (bf16*)(ws + WS_WSP);
    float* SSQA = (float*)(ws + WS_SSQA); float* SSQB = (float*)(ws + WS_SSQB);
    bf16* XN = (bf16*)(ws + WS_XN); bf16* AG = (bf16*)(ws + WS_AG); bf16* MG = (bf16*)(ws + WS_MG); bf16* PROJ = (bf16*)(ws + WS_PROJ);
    bf16* MIX = AG; bf16* FFO = MG; bf16* HB = PROJ; bf16* HN = XN; bf16* HB16 = (bf16*)(ws + WS_HB16);
#define IN(k) (lo <= (k) && (k) < hi)
#define SEAM(k) do { if (IN(k) && IN((k) + 1)) grid.sync(); else __syncthreads(); } while (0)

    if (IN(0)) { p0_prologue(F); }
    SEAM(0);
    if (IN(1)) { pg8::Gemm g{XN, W_IN, M, INW, D}; pg8::StaticOrder S; S.init(M, INW, F.G, F.bid); pg8::EpiProj E{PROJ};
        pg8::gemm_phase<pg8::EpiProj, pg8::StaticOrder, true, true>(F.lds, g, S, E); }
    SEAM(1);
    if (IN(2)) {
        for (int u = F.bid; u < BATCH * 16 * 2; u += F.G) attn_unit(F, PROJ, AG, F.in[3], u);
        for (int u = F.bid; u < BATCH * 16; u += F.G) gmlp_unit(F, PROJ, AG, F.in[4], F.in[5], W_SP, F.in[7], u);
    }
    SEAM(2);
    if (IN(3)) { pg8::Gemm g{AG, W_AB, M, D, D}; pg8::StaticOrder S; S.init(M, D, F.G, F.bid); pg8::EpiMerge E{PROJ, MG};
        pg8::gemm_phase<pg8::EpiMerge, pg8::StaticOrder, true, true>(F.lds, g, S, E); }
    SEAM(3);
    if (IN(4)) { pg8::Gemm g{MG, W_OUT, M, D, D}; pg8::StaticOrder S; S.init(M, D, F.G, F.bid); pg8::EpiSsq E{MIX, SSQA};
        pg8::gemm_phase<pg8::EpiSsq, pg8::StaticOrder, true, true>(F.lds, g, S, E); }
    SEAM(4);
    if (IN(5)) { const int gw = F.bid * NWAVES + F.wave, NGW = F.G * NWAVES;
        const float* RSTD = (const float*)(ws + WS_RSTD);
        for (int m = gw; m < M; m += NGW) e1_row(F.lane, HN + (size_t)m * D, RSTD[m], MIX + (size_t)m * D, SSQA + (size_t)m * 16, F.in[11], F.in[12], HB16 + (size_t)m * D); }
    SEAM(5);
    if (IN(6)) { pg8::Gemm g{HN, W_GU, M, 2 * FF, D}; pg8::StaticOrder S; S.init(M, 2 * FF, F.G, F.bid); pg8::EpiSwiglu E{HB};
        pg8::gemm_phase<pg8::EpiSwiglu, pg8::StaticOrder, true, true>(F.lds, g, S, E); }
    SEAM(6);
    if (IN(7)) { pg8::Gemm g{HB, W_D, M, D, FF}; pg8::StaticOrder S; S.init(M, D, F.G, F.bid); pg8::EpiSsq E{FFO, SSQB};
        pg8::gemm_phase<pg8::EpiSsq, pg8::StaticOrder, true, true>(F.lds, g, S, E); }
    SEAM(7);
    if (IN(8)) { const int gw = F.bid * NWAVES + F.wave, NGW = F.G * NWAVES;
        for (int m = gw; m < M; m += NGW) e2_row(F.lane, FFO + (size_t)m * D, SSQB + (size_t)m * 16, F.in[16], HB16 + (size_t)m * D, F.out + (size_t)m * D); }
#undef IN
#undef SEAM
}

extern "C" void kernel_launch(void* const* d_in, const int* in_sizes, int n_in, void* d_out, int out_size, void* d_ws, size_t ws_size, hipStream_t stream) {
    static int grid = 0;
    if (grid == 0) {
        if (n_in != 17 || out_size != M * D || ws_size < WS_END) { fprintf(stderr, "kernel_launch: unexpected problem: n_in %d out %d ws %zu\n", n_in, out_size, ws_size); grid = -1; return; }
        int dev = 0, cus = 0, per_cu = 0;
        (void)hipGetDevice(&dev); (void)hipDeviceGetAttribute(&cus, hipDeviceAttributeMultiprocessorCount, dev);
        if (hipFuncSetAttribute((const void*)fwd_megakernel, hipFuncAttributeMaxDynamicSharedMemorySize, LDS_BYTES) != hipSuccess) fprintf(stderr, "kernel_launch: hipFuncSetAttribute failed\n");
        if (hipOccupancyMaxActiveBlocksPerMultiprocessor(&per_cu, (const void*)fwd_megakernel, NTHR, LDS_BYTES) != hipSuccess || per_cu < 1) { fprintf(stderr, "kernel_launch: occupancy query says %d\n", per_cu); per_cu = 1; }
        (void)hipGetLastError();
        grid = cus * per_cu;
        fprintf(stderr, "kernel_launch: grid %d (cus %d x %d)\n", grid, cus, per_cu);
    }
    if (grid < 0) return;
    Args a{};
    for (int i = 0; i < 17; ++i) a.in[i] = (const float*)d_in[i];
    a.out = (float*)d_out; a.ws = (unsigned char*)d_ws;
#if MK_N_LAUNCHES == 1
    a.ph_lo = 0; a.ph_hi = N_PHASES;
    void* kargs[] = {&a};
    hipError_t e = hipLaunchCooperativeKernel((const void*)fwd_megakernel, dim3(grid), dim3(NTHR), kargs, LDS_BYTES, stream);
    if (e != hipSuccess) fprintf(stderr, "kernel_launch: cooperative launch failed: %s (grid %d)\n", hipGetErrorString(e), grid);
#else
    for (int k = 0; k < N_PHASES; ++k) { a.ph_lo = k; a.ph_hi = k + 1;
        hipLaunchKernelGGL(fwd_megakernel, dim3(grid), dim3(NTHR), LDS_BYTES, stream, a);
        const hipError_t le = hipPeekAtLastError(); if (le != hipSuccess) { fprintf(stderr, "kernel_launch: launch %d failed: %s\n", k, hipGetErrorName(le)); break; } }
#endif
}
```

```cpp
#include <hip/hip_runtime.h>
#include <hip/hip_cooperative_groups.h>
#include <cstdio>
#include <cstdint>
namespace cg = cooperative_groups;
#ifndef MK_N_LAUNCHES
#define MK_N_LAUNCHES 1
#endif
namespace pg8 {
#define PG8_LAS __attribute__((address_space(3)))
typedef unsigned short bf16_t;
typedef short bf16x8 __attribute__((ext_vector_type(8)));
typedef float f32x4 __attribute__((ext_vector_type(4)));
typedef unsigned u32x4 __attribute__((ext_vector_type(4)));
constexpr int BM = 256, BK = 64, HALF = 128, HTB = HALF * BK * 2  , STAGE_BYTES = 8 * HTB, NXCD = 8, WGM = 8;

__host__ __device__ __forceinline__ int lds_byte(int r, int c) { const int st = (r >> 4) * 2 + (c >> 5), rr = r & 15, cc = c & 31, ob = rr * 64 + cc * 2; return st * 1024 + (ob ^ (((ob >> 9) & 1) << 5)); }
__host__ __device__ __forceinline__ void stage_rc(int b, int& R, int& C) { const int st = b / 1024, sb = b % 1024, swz = sb ^ (((sb >> 9) & 1) << 5); R = (st >> 1) * 16 + swz / 64; C = (st & 1) * 32 + (swz % 64) / 2; }
__host__ __device__ __forceinline__ int perm32(int rho) { const int n = rho >> 4, i = rho & 15; return 8 * (i >> 2) + 4 * n + (i & 3); }

struct Unit { int pm, pn; };
struct Gemm { const bf16_t* A; const bf16_t* Bt; int M, N, K; };

struct StaticOrder {
    int nM, nN, nwg, G, c;
    __host__ __device__ void init(int M, int N, int G_, int c_) { nM = M / BM; nN = N / BM; nwg = nM * nN; G = G_; c = c_; }
    __host__ __device__ bool next(int i, Unit& u) const {
        const long L = (long)i * G + c; if (L >= nwg) return false;
        int wgid = (int)L; { const int q = nwg / NXCD, r = nwg % NXCD, xcd = wgid % NXCD, off = wgid / NXCD; wgid = (xcd < r ? xcd * (q + 1) : r * (q + 1) + (xcd - r) * q) + off; }
        const int nig = WGM * nN, gid = wgid / nig, fm = gid * WGM, gsz = (nM - fm) < WGM ? (nM - fm) : WGM;
        u.pm = fm + ((wgid % nig) % gsz); u.pn = (wgid % nig) / gsz; return true;
    }
    __device__ __forceinline__ void a_ready(const Unit&) const {}
    __device__ __forceinline__ void done(const Unit&) const {}
};

__device__ __forceinline__ unsigned cvt_pk_bf16(float lo, float hi) { unsigned r; asm volatile("v_cvt_pk_bf16_f32 %0, %1, %2" : "=v"(r) : "v"(lo), "v"(hi)); return r; }
typedef float f32x2 __attribute__((ext_vector_type(2)));
__device__ __forceinline__ f32x2 gelu_pk(f32x2 v) {
    const f32x2 av = __builtin_elementwise_abs(v), d = av * 0.2316418882f + 1.0f;
    f32x2 t; t.x = __builtin_amdgcn_rcpf(d.x); t.y = __builtin_amdgcn_rcpf(d.y);
    f32x2 q = t * 0.5307027145f + (-0.7265760135f); q = q * t + 0.7107068705f; q = q * t + (-0.142248368f); q = q * t + 0.127414796f; q = q * t;
    const f32x2 s = (v * v) * (-0.72134752044f);
    f32x2 e; e.x = __builtin_amdgcn_exp2f(s.x); e.y = __builtin_amdgcn_exp2f(s.y);
    const f32x2 m = v * (q * e), r = v - m;
    f32x2 o; o.x = v.x < 0.f ? m.x : r.x; o.y = v.y < 0.f ? m.y : r.y; return o;
}
typedef __bf16 bf16x2_t __attribute__((ext_vector_type(2)));
__device__ __forceinline__ unsigned cvtpk(float lo, float hi) { f32x2 v = {lo, hi}; bf16x2_t b = __builtin_convertvector(v, bf16x2_t); return __builtin_bit_cast(unsigned, b); }
__device__ __forceinline__ float bflo(unsigned u) { return __uint_as_float(u << 16); }
__device__ __forceinline__ float bfhi(unsigned u) { return __uint_as_float(u & 0xffff0000u); }
__device__ __forceinline__ float sigm(float x) { return __builtin_amdgcn_rcpf(1.0f + __builtin_amdgcn_exp2f(-1.4426950408889634f * x)); }
__device__ __forceinline__ u32x4 pack8(f32x4 v0, f32x4 v1) { u32x4 w; w.x = cvtpk(v0[0], v0[1]); w.y = cvtpk(v0[2], v0[3]); w.z = cvtpk(v1[0], v1[1]); w.w = cvtpk(v1[2], v1[3]); return w; }
constexpr int PROJ_LD = 3840;
constexpr float QSCALE = 0.125f * 1.4426950408889634f;

struct EpiProj {
    static constexpr bool PERM = true, AFTER_DRAIN = false, MID = false;
    bf16_t* O;
    __device__ __forceinline__ void mid(f32x4 (&)[2][2][4][2], const Unit&, int, int, int, int) const {}
    __device__ __forceinline__ void operator()(const f32x4 (&acc)[2][2][4][2], const Unit& u, int wr, int wc, int fr, int fq) const {
        const int row0 = u.pm * BM + wr * 64 + fr, col0 = u.pn * BM + wc * 32 + 8 * fq;
        const int mode = u.pn < 3 ? 0 : (u.pn < 7 ? 1 : 2); const float sc = u.pn < 2 ? QSCALE : 1.0f;
#pragma unroll
        for (int ai = 0; ai < 2; ++ai)
#pragma unroll
            for (int m = 0; m < 4; ++m) { bf16_t* rowp = O + (size_t)(row0 + ai * HALF + m * 16) * PROJ_LD + col0;
#pragma unroll
                for (int bj = 0; bj < 2; ++bj) { f32x4 v0 = acc[ai][bj][m][0], v1 = acc[ai][bj][m][1];
                    if (mode == 1) { f32x2 a = gelu_pk((f32x2){v0[0], v0[1]}), b = gelu_pk((f32x2){v0[2], v0[3]}), c = gelu_pk((f32x2){v1[0], v1[1]}), d = gelu_pk((f32x2){v1[2], v1[3]});
                        v0 = (f32x4){a.x, a.y, b.x, b.y}; v1 = (f32x4){c.x, c.y, d.x, d.y}; }
                    else if (mode == 2) { v0 = (f32x4){sigm(v0[0]), sigm(v0[1]), sigm(v0[2]), sigm(v0[3])}; v1 = (f32x4){sigm(v1[0]), sigm(v1[1]), sigm(v1[2]), sigm(v1[3])}; }
                    else { v0 = v0 * sc; v1 = v1 * sc; }
                    *(u32x4*)(rowp + bj * HALF) = pack8(v0, v1); } }
    }
};
struct EpiMerge {
    static constexpr bool PERM = true, AFTER_DRAIN = false, MID = true;
    const bf16_t* P; bf16_t* O;
    __device__ __forceinline__ void mid(f32x4 (&acc)[2][2][4][2], const Unit& u, int wr, int wc, int fr, int fq) const {
        asm volatile("" : "+v"(fr), "+v"(fq));
        const int row0 = u.pm * BM + wr * 64 + fr, col0 = u.pn * BM + wc * 32 + 8 * fq;
#pragma unroll
        for (int ai = 0; ai < 2; ++ai)
#pragma unroll
            for (int m = 0; m < 4; ++m) { const bf16_t* rowp = P + (size_t)(row0 + ai * HALF + m * 16) * PROJ_LD + col0;
#pragma unroll
                for (int bj = 0; bj < 2; ++bj) { const u32x4 a = *(const u32x4*)(rowp + 1792 + bj * HALF), b = *(const u32x4*)(rowp + 2816 + bj * HALF);
                    f32x4 r0, r1;
                    r0[0] = bflo(a.x) * __builtin_amdgcn_rcpf(bflo(b.x)); r0[1] = bfhi(a.x) * __builtin_amdgcn_rcpf(bfhi(b.x)); r0[2] = bflo(a.y) * __builtin_amdgcn_rcpf(bflo(b.y)); r0[3] = bfhi(a.y) * __builtin_amdgcn_rcpf(bfhi(b.y));
                    r1[0] = bflo(a.z) * __builtin_amdgcn_rcpf(bflo(b.z)); r1[1] = bfhi(a.z) * __builtin_amdgcn_rcpf(bfhi(b.z)); r1[2] = bflo(a.w) * __builtin_amdgcn_rcpf(bflo(b.w)); r1[3] = bfhi(a.w) * __builtin_amdgcn_rcpf(bfhi(b.w));
                    acc[ai][bj][m][0] *= r0; acc[ai][bj][m][1] *= r1; }
                if (m & 1) asm volatile("" ::: "memory"); }
    }
    __device__ __forceinline__ void operator()(const f32x4 (&acc)[2][2][4][2], const Unit& u, int wr, int wc, int fr, int fq) const {
        const int row0 = u.pm * BM + wr * 64 + fr, col0 = u.pn * BM + wc * 32 + 8 * fq;
#pragma unroll
        for (int ai = 0; ai < 2; ++ai)
#pragma unroll
            for (int m = 0; m < 4; ++m) { const size_t row = (size_t)(row0 + ai * HALF + m * 16); const bf16_t* rowp = P + row * PROJ_LD + col0;
#pragma unroll
                for (int bj = 0; bj < 2; ++bj) { const u32x4 b = *(const u32x4*)(rowp + 2816 + bj * HALF);
                    const f32x4 s0 = {bflo(b.x), bfhi(b.x), bflo(b.y), bfhi(b.y)}, s1 = {bflo(b.z), bfhi(b.z), bflo(b.w), bfhi(b.w)};
                    *(u32x4*)(O + row * 1024 + col0 + bj * HALF) = pack8(acc[ai][bj][m][0] * s0, acc[ai][bj][m][1] * s1); }
                asm volatile("" ::: "memory"); }
    }
};
struct EpiSsq {
    static constexpr bool PERM = true, AFTER_DRAIN = false, MID = false;
    bf16_t* O; float* ssq;
    __device__ __forceinline__ void mid(f32x4 (&)[2][2][4][2], const Unit&, int, int, int, int) const {}
    __device__ __forceinline__ void operator()(const f32x4 (&acc)[2][2][4][2], const Unit& u, int wr, int wc, int fr, int fq) const {
        const int row0 = u.pm * BM + wr * 64 + fr, col0 = u.pn * BM + wc * 32 + 8 * fq;
#pragma unroll
        for (int ai = 0; ai < 2; ++ai)
#pragma unroll
            for (int m = 0; m < 4; ++m) { const size_t row = (size_t)(row0 + ai * HALF + m * 16); float s = 0.f;
#pragma unroll
                for (int bj = 0; bj < 2; ++bj) { const f32x4 v0 = acc[ai][bj][m][0], v1 = acc[ai][bj][m][1];
                    s += (v0[0] * v0[0] + v0[1] * v0[1]) + (v0[2] * v0[2] + v0[3] * v0[3]) + (v1[0] * v1[0] + v1[1] * v1[1]) + (v1[2] * v1[2] + v1[3] * v1[3]);
                    *(u32x4*)(O + row * 1024 + col0 + bj * HALF) = pack8(v0, v1); }
                s += __shfl_xor(s, 16); s += __shfl_xor(s, 32);
                if (fq == 0) ssq[row * 16 + u.pn * 4 + wc] = s; }
    }
};
struct EpiSwiglu {
    static constexpr bool PERM = true, AFTER_DRAIN = false, MID = false;
    bf16_t* O;
    __device__ __forceinline__ void mid(f32x4 (&)[2][2][4][2], const Unit&, int, int, int, int) const {}
    __device__ __forceinline__ void operator()(const f32x4 (&acc)[2][2][4][2], const Unit& u, int wr, int wc, int fr, int fq) const {
        const int row0 = u.pm * BM + wr * 64 + fr, col0 = u.pn * HALF + wc * 32 + 8 * fq;
#pragma unroll
        for (int ai = 0; ai < 2; ++ai)
#pragma unroll
            for (int m = 0; m < 4; ++m) { const size_t row = (size_t)(row0 + ai * HALF + m * 16);
                const f32x4 g0 = acc[ai][0][m][0], g1 = acc[ai][0][m][1], u0 = acc[ai][1][m][0], u1 = acc[ai][1][m][1];
                f32x4 h0, h1;
#pragma unroll
                for (int e = 0; e < 4; ++e) { h0[e] = g0[e] * sigm(g0[e]) * u0[e]; h1[e] = g1[e] * sigm(g1[e]) * u1[e]; }
                *(u32x4*)(O + row * 2816 + col0) = pack8(h0, h1); }
    }
};
template <class Epi, class Sched, bool ALIGN_EPI = false, bool SP2 = false>
__device__ __forceinline__ void gemm_phase(PG8_LAS unsigned char* lds, const Gemm g, const Sched& S, const Epi& E) {
    const int tid = threadIdx.x, wid = __builtin_amdgcn_readfirstlane(tid >> 6), lane = tid & 63, wr = wid >> 2, wc = wid & 3, fr = lane & 15, fq = lane >> 4;
    const int K = g.K, nt = K / BK;
    unsigned voffA[2], voffB[2];
#pragma unroll
    for (int i = 0; i < 2; ++i) { int R, C; stage_rc(tid * 16 + i * 8192, R, C); const int Rb = Epi::PERM ? ((R & ~31) + perm32(R & 31)) : R;
        voffA[i] = (unsigned)(R * K + C) * 2u; voffB[i] = (unsigned)(Rb * K + C) * 2u; }
    const size_t kstep = (size_t)(BK * 2);
    const size_t hstep = (size_t)HALF * K * 2;
    const size_t tstep = 2 * hstep;
    const unsigned ldsw = (unsigned)wid * 1024u;
    const int aoff = lds_byte(wr * 64 + fr, fq * 8), boff = lds_byte(wc * 32 + fr, fq * 8);
#define PG8_SA(b, h) (((b) * 2 + (h)) * HTB)
#define PG8_SB(b, h) ((4 + (b) * 2 + (h)) * HTB)
#define PG8_STAGE(bufoff, gbase, voff) do { _Pragma("unroll") for (int _i = 0; _i < 2; ++_i) \
        __builtin_amdgcn_global_load_lds((const unsigned*)((const char*)(gbase) + (voff)[_i]), (PG8_LAS unsigned*)(lds + (bufoff) + ldsw + _i * 8192), 16, 0, 0); } while (0)
#define PG8_LDA(dst, b, h) do { _Pragma("unroll") for (int m = 0; m < 4; ++m) _Pragma("unroll") for (int k = 0; k < 2; ++k) dst[m][k] = *(const PG8_LAS bf16x8*)(lds + PG8_SA(b, h) + aoff + m * 2048 + k * 1024); } while (0)
#define PG8_LDB(dst, b, h) do { _Pragma("unroll") for (int n = 0; n < 2; ++n) _Pragma("unroll") for (int k = 0; k < 2; ++k) dst[n][k] = *(const PG8_LAS bf16x8*)(lds + PG8_SB(b, h) + boff + n * 2048 + k * 1024); } while (0)
#define PG8_MMA(ai, bj, At, Bt) do { __builtin_amdgcn_s_setprio(1); _Pragma("unroll") for (int m = 0; m < 4; ++m) _Pragma("unroll") for (int n = 0; n < 2; ++n) _Pragma("unroll") for (int k = 0; k < 2; ++k) \
        acc[ai][bj][m][n] = __builtin_amdgcn_mfma_f32_16x16x32_bf16(Bt[n][k], At[m][k], acc[ai][bj][m][n], 0, 0, 0); __builtin_amdgcn_s_setprio(0); } while (0)
#define PG8_WAIT_V(n) asm volatile("s_waitcnt vmcnt(" #n ")" ::: "memory")
#define PG8_WAIT_L(n) asm volatile("s_waitcnt lgkmcnt(" #n ")" ::: "memory")
#define PG8_BAR __builtin_amdgcn_s_barrier()
#define PG8_SCHED __builtin_amdgcn_sched_barrier(0)
    Unit cur, nxt; int ui = 0;
    if (!S.next(0, cur)) return;
    f32x4 acc[2][2][4][2];
#pragma unroll
    for (int a = 0; a < 2; ++a)
#pragma unroll
        for (int b = 0; b < 2; ++b)
#pragma unroll
            for (int m = 0; m < 4; ++m)
#pragma unroll
                for (int n = 0; n < 2; ++n) acc[a][b][m][n] = (f32x4){0.f, 0.f, 0.f, 0.f};
    bf16x8 At[4][2], B0[2][2], B1[2][2];
    const char* cA = (const char*)g.A + (size_t)cur.pm * tstep; const char* cB = (const char*)g.Bt + (size_t)cur.pn * tstep;
    S.a_ready(cur);
    if constexpr (SP2) {
        PG8_STAGE(PG8_SB(0, 0), cB, voffB); PG8_STAGE(PG8_SB(0, 1), cB + hstep, voffB); PG8_STAGE(PG8_SA(0, 0), cA, voffA); PG8_STAGE(PG8_SA(0, 1), cA + hstep, voffA);
        if (wr == 1) PG8_BAR;
        PG8_WAIT_V(2); PG8_BAR;
        PG8_STAGE(PG8_SB(1, 0), cB + kstep, voffB); PG8_STAGE(PG8_SA(1, 0), cA + kstep, voffA); PG8_STAGE(PG8_SB(1, 1), cB + hstep + kstep, voffB);
        PG8_WAIT_V(6); PG8_BAR;
    } else {
        PG8_STAGE(PG8_SB(0, 0), cB, voffB); PG8_STAGE(PG8_SA(0, 0), cA, voffA); PG8_STAGE(PG8_SB(0, 1), cB + hstep, voffB); PG8_STAGE(PG8_SA(0, 1), cA + hstep, voffA);
        if (wr == 1) PG8_BAR;
        PG8_WAIT_V(4); PG8_BAR;
        PG8_STAGE(PG8_SB(1, 0), cB + kstep, voffB); PG8_STAGE(PG8_SA(1, 0), cA + kstep, voffA); PG8_STAGE(PG8_SB(1, 1), cB + hstep + kstep, voffB);
        PG8_WAIT_V(6); PG8_BAR;
    }
    for (;;) {
        const bool has_next = S.next(ui + 1, nxt);
        const char* nA = has_next ? (const char*)g.A + (size_t)nxt.pm * tstep : cA; const char* nB = has_next ? (const char*)g.Bt + (size_t)nxt.pn * tstep : cB;
        for (int t = 0; t < nt; t += 2) {
            const bool last = (t == nt - 2);
            if constexpr (Epi::MID) { if (t == (nt >> 1)) E.mid(acc, cur, wr, wc, fr, fq); }
            const char* a1 = cA + (size_t)(t + 1) * kstep;
            const char* a2 = last ? nA : cA + (size_t)(t + 2) * kstep; const char* b2 = last ? nB : cB + (size_t)(t + 2) * kstep;
            const char* a3 = a2 + kstep; const char* b3 = b2 + kstep;
            if (last && has_next) S.a_ready(nxt);
            if constexpr (SP2) {
            PG8_LDB(B0, 0, 0); PG8_LDB(B1, 0, 1); PG8_SCHED; PG8_LDA(At, 0, 0); PG8_STAGE(PG8_SA(1, 1), a1 + hstep, voffA);
            PG8_WAIT_V(8); PG8_WAIT_L(0); PG8_BAR; PG8_MMA(0, 0, At, B0); PG8_MMA(0, 1, At, B1); PG8_BAR; PG8_SCHED;
            PG8_LDA(At, 0, 1); PG8_STAGE(PG8_SB(0, 0), b2, voffB); PG8_STAGE(PG8_SB(0, 1), b2 + hstep, voffB); PG8_STAGE(PG8_SA(0, 0), a2, voffA);
            PG8_WAIT_V(8); PG8_WAIT_L(0); PG8_BAR; PG8_MMA(1, 0, At, B0); PG8_MMA(1, 1, At, B1); PG8_BAR; PG8_SCHED;
            PG8_LDB(B0, 1, 0); PG8_LDB(B1, 1, 1); PG8_SCHED; PG8_LDA(At, 1, 0); PG8_STAGE(PG8_SA(0, 1), a2 + hstep, voffA);
            PG8_WAIT_V(8); PG8_WAIT_L(0); PG8_BAR; PG8_MMA(0, 0, At, B0); PG8_MMA(0, 1, At, B1); PG8_BAR; PG8_SCHED;
            PG8_LDA(At, 1, 1); PG8_STAGE(PG8_SB(1, 0), b3, voffB); PG8_STAGE(PG8_SB(1, 1), b3 + hstep, voffB); PG8_STAGE(PG8_SA(1, 0), a3, voffA);
            PG8_WAIT_V(8); PG8_WAIT_L(0); PG8_BAR; PG8_MMA(1, 0, At, B0); PG8_MMA(1, 1, At, B1); PG8_BAR; PG8_SCHED;
            } else {
            PG8_LDB(B0, 0, 0); PG8_SCHED; PG8_LDA(At, 0, 0); PG8_STAGE(PG8_SA(1, 1), a1 + hstep, voffA);
            PG8_WAIT_L(8); PG8_BAR; PG8_WAIT_L(0); PG8_MMA(0, 0, At, B0); PG8_BAR; PG8_SCHED;
            PG8_LDB(B1, 0, 1); PG8_STAGE(PG8_SB(0, 0), b2, voffB);
            PG8_BAR; PG8_WAIT_L(0); PG8_MMA(0, 1, At, B1); PG8_BAR;
            PG8_LDA(At, 0, 1); PG8_STAGE(PG8_SA(0, 0), a2, voffA);
            PG8_BAR; PG8_WAIT_L(0); PG8_MMA(1, 0, At, B0); PG8_BAR; PG8_SCHED;
            PG8_STAGE(PG8_SB(0, 1), b2 + hstep, voffB);
            PG8_WAIT_V(6); PG8_BAR; PG8_MMA(1, 1, At, B1); PG8_BAR;
            PG8_LDB(B0, 1, 0); PG8_SCHED; PG8_LDA(At, 1, 0); PG8_STAGE(PG8_SA(0, 1), a2 + hstep, voffA);
            PG8_WAIT_L(8); PG8_BAR; PG8_WAIT_L(0); PG8_MMA(0, 0, At, B0); PG8_BAR; PG8_SCHED;
            PG8_LDB(B1, 1, 1); PG8_STAGE(PG8_SB(1, 0), b3, voffB);
            PG8_BAR; PG8_WAIT_L(0); PG8_MMA(0, 1, At, B1); PG8_BAR;
            PG8_LDA(At, 1, 1); PG8_STAGE(PG8_SA(1, 0), a3, voffA);
            PG8_BAR; PG8_WAIT_L(0); PG8_MMA(1, 0, At, B0); PG8_BAR; PG8_SCHED;
            PG8_STAGE(PG8_SB(1, 1), b3 + hstep, voffB);
            PG8_WAIT_V(6); PG8_BAR; PG8_MMA(1, 1, At, B1); PG8_BAR;
            }
        }
        if constexpr (ALIGN_EPI) { if (wr == 0) PG8_BAR; }
        if constexpr (!Epi::AFTER_DRAIN) { E(acc, cur, wr, wc, fr, fq); S.done(cur); }
        if (!has_next) break;
#pragma unroll
        for (int a = 0; a < 2; ++a)
#pragma unroll
            for (int b = 0; b < 2; ++b)
#pragma unroll
                for (int m = 0; m < 4; ++m)
#pragma unroll
                    for (int n = 0; n < 2; ++n) acc[a][b][m][n] = (f32x4){0.f, 0.f, 0.f, 0.f};
        cur = nxt; cA = nA; cB = nB; ++ui;
        if constexpr (ALIGN_EPI) { if (wr == 1) PG8_BAR; }
    }
    PG8_WAIT_V(0);
    if constexpr (!ALIGN_EPI) { if (wr == 0) PG8_BAR; }
    PG8_BAR;
    if constexpr (Epi::AFTER_DRAIN) { E.fused(acc, cur, wr, wc, fr, fq, lds, wid, lane); S.done(cur); }
#undef PG8_SA
#undef PG8_SB
#undef PG8_STAGE
#undef PG8_LDA
#undef PG8_LDB
#undef PG8_MMA
#undef PG8_WAIT_V
#undef PG8_WAIT_L
#undef PG8_BAR
#undef PG8_SCHED
}
}

constexpr int NWAVES = 8, NTHR = 512;
constexpr int BATCH = 32, SEQ = 2048, D = 1024, M = BATCH * SEQ;
constexpr int INW = 3840, FF = 2816;
constexpr int C_K = 512, C_V = 640, C_U = 768, C_VG = 1280;
constexpr float EPS = 1e-6f, LN_EPS = 1e-5f, LOG2E = 1.4426950408889634f;
constexpr size_t MiB = 1u << 20;
constexpr size_t WS_WIN = 0;
constexpr size_t WS_WAB = 8 * MiB;
constexpr size_t WS_WOUT = 10 * MiB;
constexpr size_t WS_WGU = 12 * MiB;
constexpr size_t WS_WD = 24 * MiB;
constexpr size_t WS_WSP = 30 * MiB;
constexpr size_t WS_CTL = 31 * MiB + 512 * 1024;
constexpr int CTL_BYTES = 16384, MISC_OFF = 147456 - 64;
constexpr size_t WS_RSTD = 31 * MiB;
constexpr size_t WS_SSQA = 32 * MiB;
constexpr size_t WS_SSQB = 36 * MiB;
constexpr size_t WS_XN = 40 * MiB;
constexpr size_t WS_AG = 168 * MiB;
constexpr size_t WS_MG = 296 * MiB;
constexpr size_t WS_PROJ = 424 * MiB;
constexpr size_t WS_HB16 = WS_PROJ + 352 * MiB;
constexpr size_t WS_END = 904 * MiB;
constexpr int LDS_BYTES = 147456;

#define GAS __attribute__((address_space(1)))
#define LAS __attribute__((address_space(3)))
typedef unsigned short bf16;
typedef unsigned v4u __attribute__((ext_vector_type(4)));
typedef unsigned v2u __attribute__((ext_vector_type(2)));
typedef float f32x4 __attribute__((ext_vector_type(4)));
typedef float f32x16 __attribute__((ext_vector_type(16)));
typedef short bf16x8 __attribute__((ext_vector_type(8)));
typedef short s16x4 __attribute__((ext_vector_type(4)));
using pg8::cvtpk; using pg8::bflo; using pg8::bfhi;
#define LDS_WAIT() asm volatile("s_waitcnt lgkmcnt(0)" ::: "memory")
__device__ __forceinline__ unsigned short f2bf(float f) { return (unsigned short)(cvtpk(f, 0.f) & 0xffffu); }
__device__ __forceinline__ float bf2f(unsigned short h) { return __uint_as_float((unsigned)h << 16); }
__device__ __forceinline__ float wave_sum(float v) {
#pragma unroll
    for (int o = 1; o < 64; o <<= 1) v += __shfl_xor(v, o);
    return v;
}
__device__ __forceinline__ int crow(int r, int hi) { return (r & 3) + 8 * (r >> 2) + 4 * hi; }

struct Frame {
    LAS unsigned char* lds;
    int tid, lane, wave, G, bid;
    const float* in[17]; float* out; unsigned char* ws;
};
__device__ __forceinline__ int rowmap(int mode, int n) { return mode == 0 ? n : (((n >> 7) << 8) + (n & 127) + (mode == 2 ? 128 : 0)); }
__device__ __forceinline__ void p0_transpose_item(const float* W, int N, bf16* WT, int ldk, int koff, int mode, LAS float* scr, int item, int lane, const float* kscale = nullptr) {
    const int nblk = N / 32, kb = item / nblk, nb = item % nblk, k0 = 64 * kb, n0 = 32 * nb;
#pragma unroll 8
    for (int i = 0; i < 32; ++i) { const int kk = 2 * i + (lane >> 5); float w = W[(size_t)(k0 + kk) * N + n0 + (lane & 31)]; if (kscale) w *= kscale[k0 + kk]; scr[kk * 33 + (lane & 31)] = w; }
    LDS_WAIT(); asm volatile("" ::: "memory");
    const int c = lane & 7;
#pragma unroll
    for (int j = 0; j < 4; ++j) { const int n = (lane >> 3) + 8 * j; const LAS float* s = scr + (8 * c) * 33 + n;
        v4u o; o.x = cvtpk(s[0 * 33], s[1 * 33]); o.y = cvtpk(s[2 * 33], s[3 * 33]); o.z = cvtpk(s[4 * 33], s[5 * 33]); o.w = cvtpk(s[6 * 33], s[7 * 33]);
        *(GAS v4u*)(WT + (size_t)rowmap(mode, n0 + n) * ldk + koff + k0 + 8 * c) = o; }
    LDS_WAIT(); asm volatile("" ::: "memory");
}
__device__ __forceinline__ void rms_row_to_bf16(int lane, const float* xrow, float* rstd_out, bf16* orow) {
    const GAS f32x4* xr = (const GAS f32x4*)xrow + lane;
    f32x4 v[4]; float s = 0.f;
#pragma unroll
    for (int j = 0; j < 4; ++j) { v[j] = xr[64 * j]; s += (v[j].x * v[j].x + v[j].y * v[j].y) + (v[j].z * v[j].z + v[j].w * v[j].w); }
    const float rstd = 1.0f / sqrtf(wave_sum(s) * (1.f / D) + EPS);
    if (lane == 0) *rstd_out = rstd;
    GAS v2u* o8 = (GAS v2u*)orow + lane;
#pragma unroll
    for (int j = 0; j < 4; ++j) { v2u w; w.x = cvtpk(v[j].x * rstd, v[j].y * rstd); w.y = cvtpk(v[j].z * rstd, v[j].w * rstd); o8[64 * j] = w; }
}
__device__ __forceinline__ void p0_prologue(Frame& F) {
    LAS float* scr = (LAS float*)(F.lds + F.wave * 16384);
    const int gw = F.bid * NWAVES + F.wave, NGW = F.G * NWAVES;
    unsigned char* ws = F.ws;
    constexpr int I_IN = (1024 / 64) * (INW / 32), I_A = (512 / 64) * (1024 / 32), I_O = (1024 / 64) * (1024 / 32), I_G = (1024 / 64) * (FF / 32), I_D = (FF / 64) * (1024 / 32);
    constexpr int NITEMS = I_IN + 2 * I_A + I_O + 2 * I_G + I_D;
    for (int it = gw; it < NITEMS; it += NGW) {
        int r = it;
        if (r < I_IN) { p0_transpose_item(F.in[2], INW, (bf16*)(ws + WS_WIN), 1024, 0, 0, scr, r, F.lane, F.in[1]); continue; } r -= I_IN;
        if (r < I_A) { p0_transpose_item(F.in[8], 1024, (bf16*)(ws + WS_WAB), 1024, 0, 0, scr, r, F.lane); continue; } r -= I_A;
        if (r < I_A) { p0_transpose_item(F.in[9], 1024, (bf16*)(ws + WS_WAB), 1024, 512, 0, scr, r, F.lane); continue; } r -= I_A;
        if (r < I_O) { p0_transpose_item(F.in[10], 1024, (bf16*)(ws + WS_WOUT), 1024, 0, 0, scr, r, F.lane); continue; } r -= I_O;
        if (r < I_G) { p0_transpose_item(F.in[13], FF, (bf16*)(ws + WS_WGU), 1024, 0, 1, scr, r, F.lane); continue; } r -= I_G;
        if (r < I_G) { p0_transpose_item(F.in[14], FF, (bf16*)(ws + WS_WGU), 1024, 0, 2, scr, r, F.lane); continue; } r -= I_G;
        p0_transpose_item(F.in[15], 1024, (bf16*)(ws + WS_WD), FF, 0, 0, scr, r, F.lane);
    }
    { const float* wsrc = F.in[6]; bf16* wdst = (bf16*)(ws + WS_WSP);
      for (int i = gw * 64 + F.lane; i < 4 * 128 * 128; i += NGW * 64) { const int t = (i >> 7) & 127, s = i & 127; wdst[i] = f2bf(s <= t ? wsrc[i] : 0.f); } }
    bf16* XN = (bf16*)(ws + WS_XN);
    float* RSTD = (float*)(ws + WS_RSTD);
    for (int m = gw; m < M; m += NGW) rms_row_to_bf16(F.lane, F.in[0] + (size_t)m * D, RSTD + m, XN + (size_t)m * D);
}
constexpr int KS_ROW = 144, VT_ROW = 260  , KS_BYTES = 256 * KS_ROW;
__device__ __forceinline__ void attn_unit(Frame& F, const bf16* PROJ, bf16* AG, const float* sinks, int unit) {
    const int tid = F.tid, lane = F.lane, wave = F.wave, lq = lane & 31, hi = lane >> 5;
    const int kvh = unit & 1, n = (unit >> 1) & 15, b = unit >> 5;
    const long T0 = (long)b * SEQ + n * 128;
    LAS unsigned char* Ks = F.lds; LAS unsigned short* VT = (LAS unsigned short*)(F.lds + KS_BYTES);
    const int jstart = (n == 0) ? 128 : 0;
#pragma unroll
    for (int it = 0; it < 4; ++it) { const int id = it * NTHR + tid, key = id >> 3, ch = id & 7;
        if (key >= jstart) { const bf16* src = PROJ + (T0 - 128 + key) * INW + C_K + kvh * 64 + ch * 8;
            const v4u kv = *(const GAS v4u*)src, vv = *(const GAS v4u*)(src + 128);
            *(LAS v4u*)(Ks + key * KS_ROW + ch * 16) = kv;
            LAS unsigned short* vt = VT + (ch * 8) * VT_ROW + key;
            vt[0 * VT_ROW] = (unsigned short)(vv.x & 0xffffu); vt[1 * VT_ROW] = (unsigned short)(vv.x >> 16);
            vt[2 * VT_ROW] = (unsigned short)(vv.y & 0xffffu); vt[3 * VT_ROW] = (unsigned short)(vv.y >> 16);
            vt[4 * VT_ROW] = (unsigned short)(vv.z & 0xffffu); vt[5 * VT_ROW] = (unsigned short)(vv.z >> 16);
            vt[6 * VT_ROW] = (unsigned short)(vv.w & 0xffffu); vt[7 * VT_ROW] = (unsigned short)(vv.w >> 16); } }
    __syncthreads();
#pragma unroll 1
    for (int pass = 0; pass < 2; ++pass) {
        int lqo = lq; asm volatile("" : "+v"(lqo));
        const int g = pass * 2 + (wave >> 2), wq = wave & 3, hq = kvh * 4 + g;
        const float slope2 = __builtin_amdgcn_exp2f(-(float)(hq + 1)) * LOG2E, sink2 = sinks[hq] * LOG2E;
        const bf16* qp = PROJ + (T0 + 32 * wq + lq) * INW + hq * 64 + 8 * hi;
        bf16x8 qf[4];
#pragma unroll
        for (int ds = 0; ds < 4; ++ds) qf[ds] = *(const GAS bf16x8*)(qp + 16 * ds);
        f32x16 S[5];
#pragma unroll
        for (int i = 0; i < 5; ++i) { const int kt = wq + i; const bool skip = (n == 0 && kt < 4);
#pragma unroll
            for (int r = 0; r < 16; ++r) S[i][r] = 0.f;
            if (!skip) {
#pragma unroll
                for (int ds = 0; ds < 4; ++ds) { const bf16x8 kf = *(const LAS bf16x8*)(Ks + (32 * kt + lq) * KS_ROW + (16 * ds + 8 * hi) * 2);
                    S[i] = __builtin_amdgcn_mfma_f32_32x32x16_bf16(kf, qf[ds], S[i], 0, 0, 0); } }
            __builtin_amdgcn_sched_barrier(0); }
        float mx = sink2;
#pragma unroll
        for (int i = 0; i < 5; ++i) { const bool skip = (n == 0 && wq + i < 4);
#pragma unroll
            for (int r = 0; r < 16; ++r) { const int rel = 128 - 32 * i + lqo - crow(r, hi);
                const bool valid = !skip && (i == 0 ? rel <= 127 : (i == 4 ? rel >= 0 : true));
                const float lg = valid ? S[i][r] - slope2 * (float)rel : -1e30f; S[i][r] = lg; mx = fmaxf(mx, lg); } }
        mx = fmaxf(mx, __shfl_xor(mx, 32));
        float sum = 0.f;
#pragma unroll
        for (int i = 0; i < 5; ++i)
#pragma unroll
            for (int r = 0; r < 16; ++r) { const float p = __builtin_amdgcn_exp2f(S[i][r] - mx); S[i][r] = p; sum += p; }
        sum += __shfl_xor(sum, 32); sum += __builtin_amdgcn_exp2f(sink2 - mx);
        const float inv = 1.0f / sum;
        f32x16 O[2];
#pragma unroll
        for (int r = 0; r < 16; ++r) { O[0][r] = 0.f; O[1][r] = 0.f; }
#pragma unroll
        for (int i = 0; i < 5; ++i) { const int kt = wq + i; const bool skip = (n == 0 && kt < 4);
            if (!skip) {
#pragma unroll
                for (int s = 0; s < 2; ++s) {
                    v4u pw; pw.x = cvtpk(S[i][8 * s + 0], S[i][8 * s + 1]); pw.y = cvtpk(S[i][8 * s + 2], S[i][8 * s + 3]); pw.z = cvtpk(S[i][8 * s + 4], S[i][8 * s + 5]); pw.w = cvtpk(S[i][8 * s + 6], S[i][8 * s + 7]);
                    const bf16x8 pf = __builtin_bit_cast(bf16x8, pw);
#pragma unroll
                    for (int dt = 0; dt < 2; ++dt) { const LAS unsigned short* vp = VT + (32 * dt + lq) * VT_ROW + 32 * kt + 16 * s + 4 * hi;
                        const s16x4 lo = *(const LAS s16x4*)vp, h8 = *(const LAS s16x4*)(vp + 8);
                        const bf16x8 vf = __builtin_shufflevector(lo, h8, 0, 1, 2, 3, 4, 5, 6, 7);
                        O[dt] = __builtin_amdgcn_mfma_f32_32x32x16_bf16(vf, pf, O[dt], 0, 0, 0); } } }
            __builtin_amdgcn_sched_barrier(0); }
        bf16* op = AG + (T0 + 32 * wq + lq) * 1024 + hq * 64 + 4 * hi;
#pragma unroll
        for (int dt = 0; dt < 2; ++dt)
#pragma unroll
            for (int j = 0; j < 4; ++j) { v2u w; w.x = cvtpk(O[dt][4 * j] * inv, O[dt][4 * j + 1] * inv); w.y = cvtpk(O[dt][4 * j + 2] * inv, O[dt][4 * j + 3] * inv);
                *(GAS v2u*)(op + 32 * dt + 8 * j) = w; }
    }
    __syncthreads();
}
constexpr int GV_ROW = 132;
__device__ __forceinline__ void gmlp_unit(Frame& F, const bf16* PROJ, bf16* AG, const float* ln_g, const float* ln_b, const bf16* WSP, const float* b_s, int unit) {
    const int lane = F.lane, wave = F.wave, lq = lane & 31, hi = lane >> 5;
    const int n = unit & 15, b = unit >> 4; const long T0 = (long)b * SEQ + n * 128;
    LAS unsigned short* VT = (LAS unsigned short*)F.lds;
    float gch[8], bch[8];
#pragma unroll
    for (int i = 0; i < 8; ++i) { gch[i] = ln_g[lane + 64 * i]; bch[i] = ln_b[lane + 64 * i]; }
#pragma unroll 2
    for (int tk = 0; tk < 16; ++tk) { const int s = 16 * wave + tk; const bf16* vp = PROJ + (T0 + s) * INW + C_VG + lane;
        float x[8]; float sm = 0.f;
#pragma unroll
        for (int i = 0; i < 8; ++i) { x[i] = bf2f(vp[64 * i]); sm += x[i]; }
        const float mean = wave_sum(sm) * (1.f / 512.f); float q = 0.f;
#pragma unroll
        for (int i = 0; i < 8; ++i) { x[i] -= mean; q += x[i] * x[i]; }
        const float rstd = 1.0f / sqrtf(wave_sum(q) * (1.f / 512.f) + LN_EPS);
#pragma unroll
        for (int i = 0; i < 8; ++i) VT[(lane + 64 * i) * GV_ROW + s] = f2bf(x[i] * rstd * gch[i] + bch[i]); }
    __syncthreads();
    const int g = wave >> 1, cb = g * 128 + 64 * (wave & 1);
    f32x16 acc[2][4];
#pragma unroll
    for (int mt = 0; mt < 2; ++mt)
#pragma unroll
        for (int nt = 0; nt < 4; ++nt)
#pragma unroll
            for (int r = 0; r < 16; ++r) acc[mt][nt][r] = 0.f;
    const bf16* wg = WSP + (size_t)g * 128 * 128 + (size_t)lq * 128 + 8 * hi;
#pragma unroll 1
    for (int ks = 0; ks < 8; ++ks) {
        bf16x8 af[2];
#pragma unroll
        for (int mt = 0; mt < 2; ++mt) { const LAS unsigned short* ap = VT + (cb + 32 * mt + lq) * GV_ROW + 16 * ks + 8 * hi;
            const s16x4 lo = *(const LAS s16x4*)ap, h8 = *(const LAS s16x4*)(ap + 4); af[mt] = __builtin_shufflevector(lo, h8, 0, 1, 2, 3, 4, 5, 6, 7); }
#pragma unroll
        for (int nt = 0; nt < 4; ++nt) if (ks < 2 * (nt + 1)) { const bf16x8 bfr = *(const GAS bf16x8*)(wg + (size_t)(32 * nt) * 128 + 16 * ks);
#pragma unroll
            for (int mt = 0; mt < 2; ++mt) acc[mt][nt] = __builtin_amdgcn_mfma_f32_32x32x16_bf16(af[mt], bfr, acc[mt][nt], 0, 0, 0); }
    }
#pragma unroll
    for (int nt = 0; nt < 4; ++nt) { const int t = 32 * nt + lq; const float bias = b_s[g * 128 + t];
        const bf16* up = PROJ + (T0 + t) * INW + C_U + cb + 4 * hi; bf16* op = AG + (T0 + t) * 1024 + 512 + cb + 4 * hi;
#pragma unroll
        for (int mt = 0; mt < 2; ++mt)
#pragma unroll
            for (int j = 0; j < 4; ++j) { const v2u uu = *(const GAS v2u*)(up + 32 * mt + 8 * j);
                v2u w; w.x = cvtpk(bflo(uu.x) * (acc[mt][nt][4 * j] + bias), bfhi(uu.x) * (acc[mt][nt][4 * j + 1] + bias));
                w.y = cvtpk(bflo(uu.y) * (acc[mt][nt][4 * j + 2] + bias), bfhi(uu.y) * (acc[mt][nt][4 * j + 3] + bias));
                *(GAS v2u*)(op + 32 * mt + 8 * j) = w; } }
    __syncthreads();
}
__device__ __forceinline__ void unpack8(const v4u mv, f32x4& a, f32x4& b) { a = (f32x4){bflo(mv.x), bfhi(mv.x), bflo(mv.y), bfhi(mv.y)}; b = (f32x4){bflo(mv.z), bfhi(mv.z), bflo(mv.w), bfhi(mv.w)}; }
__device__ __forceinline__ void e1_row(int lane, bf16* xbrow, float rstd_x, const bf16* mixrow, const float* ssq, const float* gpost, const float* gpre, bf16* hrow) {
    float t = (lane < 16) ? ssq[lane] : 0.f; t = wave_sum(t);
    const float rstd = 1.0f / sqrtf(t * (1.f / D) + EPS), rx = 1.0f / rstd_x;
    f32x4 h[2][2]; float s = 0.f;
#pragma unroll
    for (int j = 0; j < 2; ++j) { const int c = 8 * lane + 512 * j; const v4u mv = *(const GAS v4u*)(mixrow + c), xv = *(const GAS v4u*)(xbrow + c);
        const f32x4 g0 = *(const GAS f32x4*)(gpost + c), g1 = *(const GAS f32x4*)(gpost + c + 4);
        f32x4 m0, m1, x0, x1; unpack8(mv, m0, m1); unpack8(xv, x0, x1);
        h[j][0] = x0 * rx + m0 * rstd * g0; h[j][1] = x1 * rx + m1 * rstd * g1;
        *(GAS v4u*)(hrow + c) = pg8::pack8(h[j][0], h[j][1]);
#pragma unroll
        for (int e = 0; e < 4; ++e) s += h[j][0][e] * h[j][0][e] + h[j][1][e] * h[j][1][e]; }
    const float r2 = 1.0f / sqrtf(wave_sum(s) * (1.f / D) + EPS);
#pragma unroll
    for (int j = 0; j < 2; ++j) { const int c = 8 * lane + 512 * j; const f32x4 g0 = *(const GAS f32x4*)(gpre + c), g1 = *(const GAS f32x4*)(gpre + c + 4);
        *(GAS v4u*)(xbrow + c) = pg8::pack8(h[j][0] * r2 * g0, h[j][1] * r2 * g1); }
}
__device__ __forceinline__ void e2_row(int lane, const bf16* ffrow, const float* ssq, const float* gpost, const bf16* hrow, float* orow) {
    float t = (lane < 16) ? ssq[lane] : 0.f; t = wave_sum(t);
    const float rstd = 1.0f / sqrtf(t * (1.f / D) + EPS);
#pragma unroll
    for (int j = 0; j < 2; ++j) { const int c = 8 * lane + 512 * j; const v4u mv = *(const GAS v4u*)(ffrow + c), hv = *(const GAS v4u*)(hrow + c);
        const f32x4 g0 = *(const GAS f32x4*)(gpost + c), g1 = *(const GAS f32x4*)(gpost + c + 4);
        f32x4 m0, m1, x0, x1; unpack8(mv, m0, m1); unpack8(hv, x0, x1);
        *(GAS f32x4*)(orow + c) = x0 + m0 * rstd * g0; *(GAS f32x4*)(orow + c + 4) = x1 + m1 * rstd * g1; }
}
#define XB_TMO      128
#define XB_XCNT(j)  (256  + 64 * (j))
#define XB_XSUB(j)  (1280 + 64 * (j))
#define XB_XGEN(j)  (2304 + 64 * (j))
#define XB_TOP      3328
#define XB_TOPGEN   3392
#define XCD_BAR_WORDS 3456
#define XB_SPIN_CAP (1u << 18)

__device__ __forceinline__ unsigned xb_ld(unsigned* p)              { return __hip_atomic_load(p, __ATOMIC_RELAXED, __HIP_MEMORY_SCOPE_AGENT); }
__device__ __forceinline__ unsigned xb_add(unsigned* p, unsigned v) { return __hip_atomic_fetch_add(p, v, __ATOMIC_RELAXED, __HIP_MEMORY_SCOPE_AGENT); }
__device__ __forceinline__ unsigned xb_xcc_id() { return (unsigned)__builtin_amdgcn_s_getreg((3 << 11) | 20) & 0xFu; }
#define XB_SPIN(cond, bar) do { unsigned _sp = 0; while (cond) { __builtin_amdgcn_s_sleep(1); \
    if ((++_sp & 255u) == 0u) { if (xb_ld(&(bar)[XB_TMO])) break; if (_sp > XB_SPIN_CAP) { atomicAdd(&(bar)[XB_TMO], 1u); break; } } } } while (0)

struct XcdBarrier {
    unsigned* bar; unsigned x;
    volatile LAS unsigned* st;
};

__device__ __forceinline__ XcdBarrier xcd_barrier_post(unsigned* bar, volatile LAS unsigned* st) {
    XcdBarrier b; b.bar = bar; b.x = xb_xcc_id(); b.st = st;
    if (threadIdx.x == 0) (void)xb_add(&bar[XB_XCNT(b.x)], 1u);
    return b;
}
__device__ __forceinline__ void xcd_barrier_complete(unsigned* bar, unsigned x, unsigned& nloc, unsigned& nx) {
    const unsigned G = gridDim.x * gridDim.y * gridDim.z;
    unsigned sum, cnt, mine, sp = 0u;
    for (;;) {
        sum = 0u; cnt = 0u; mine = 0u;
#pragma unroll
        for (unsigned j = 0; j < 16; ++j) { const unsigned c = xb_ld(&bar[XB_XCNT(j)]); sum += c; cnt += (c > 0u) ? 1u : 0u; mine = (j == x) ? c : mine; }
        if (sum == G) break;
        __builtin_amdgcn_s_sleep(1);
        if ((++sp & 255u) == 0u) { if (xb_ld(&bar[XB_TMO])) break; if (sp > XB_SPIN_CAP) { atomicAdd(&bar[XB_TMO], 1u); break; } }
    }
    nloc = mine > 0u ? mine : 1u; nx = cnt > 0u ? cnt : 1u;
}

__device__ __forceinline__ void xcd_barrier(const XcdBarrier& b) {
    asm volatile("s_waitcnt vmcnt(0)" ::: "memory");
    __syncthreads();
    if (threadIdx.x == 0) {
        unsigned* bar = b.bar;
        __builtin_amdgcn_s_waitcnt(0);
        unsigned nloc = b.st[0], nx = b.st[1];
        if (nloc == 0u) { xcd_barrier_complete(bar, b.x, nloc, nx); b.st[0] = nloc; b.st[1] = nx; }
        const unsigned old = xb_add(&bar[XB_XSUB(b.x)], 1u);
        const unsigned gen = old / nloc;
        if (old + 1u == (gen + 1u) * nloc) {
            __builtin_amdgcn_fence(__ATOMIC_RELEASE, "agent");
            asm volatile("s_waitcnt vmcnt(0)" ::: "memory");
            const unsigned og = xb_add(&bar[XB_TOP], 1u);
            const unsigned tg = og / nx;
            if (og + 1u == (tg + 1u) * nx) xb_add(&bar[XB_TOPGEN], 1u);
            else XB_SPIN(xb_ld(&bar[XB_TOPGEN]) == tg, bar);
            __builtin_amdgcn_fence(__ATOMIC_ACQUIRE, "agent");
            xb_add(&bar[XB_XGEN(b.x)], 1u);
            asm volatile("s_waitcnt vmcnt(0)" ::: "memory");
        } else {
            XB_SPIN(xb_ld(&bar[XB_XGEN(b.x)]) == gen, bar);
            __builtin_amdgcn_fence(__ATOMIC_ACQUIRE, "agent");
            asm volatile("s_waitcnt vmcnt(0)" ::: "memory");
        }
    }
    __syncthreads();
}

constexpr int N_PHASES = 9;
struct Args { const float* in[17]; float* out; unsigned char* ws; int ph_lo, ph_hi; };
__global__ void __launch_bounds__(NTHR, 2) fwd_megakernel(Args args) {
    extern __shared__ __attribute__((aligned(16))) unsigned char lds[];
    cg::grid_group grid = cg::this_grid();
    Frame F;
    F.lds = (LAS unsigned char*)lds;
    F.tid = threadIdx.x; F.lane = F.tid & 63; F.wave = __builtin_amdgcn_readfirstlane(F.tid >> 6);
    F.G = gridDim.x; F.bid = blockIdx.x;
#pragma unroll
    for (int i = 0; i < 17; ++i) F.in[i] = args.in[i];
    F.out = args.out; F.ws = args.ws;
    unsigned char* ws = args.ws;
    const int lo = args.ph_lo, hi = args.ph_hi;
    volatile LAS unsigned* MISC = (volatile LAS unsigned*)(F.lds + MISC_OFF);
    if (F.tid < 16) MISC[F.tid] = 0u;
    __syncthreads();
    XcdBarrier bar = xcd_barrier_post((unsigned*)(ws + WS_CTL), MISC);
    bf16* W_IN = (bf16*)(ws + WS_WIN); bf16* W_AB = (bf16*)(ws + WS_WAB); bf16* W_OUT = (bf16*)(ws + WS_WOUT); bf16* W_GU = (bf16*)(ws + WS_WGU); bf16* W_D = (bf16*)(ws + WS_WD); bf16* W_SP = (bf16*)(ws + WS_WSP);
    float* SSQA = (float*)(ws + WS_SSQA); float* SSQB = (float*)(ws + WS_SSQB);
    bf16* XN = (bf16*)(ws + WS_XN); bf16* AG = (bf16*)(ws + WS_AG); bf16* MG = (bf16*)(ws + WS_MG); bf16* PROJ = (bf16*)(ws + WS_PROJ);
    bf16* MIX = AG; bf16* FFO = MG; bf16* HB = PROJ; bf16* HN = XN; bf16* HB16 = (bf16*)(ws + WS_HB16);
#define IN(k) (lo <= (k) && (k) < hi)
#define SEAM(k) do { if (IN(k) && IN((k) + 1)) { if ((k) == 0) grid.sync(); else xcd_barrier(bar); } else __syncthreads(); } while (0)

    if (IN(0)) { p0_prologue(F); }
    SEAM(0);
    if (IN(1)) { pg8::Gemm g{XN, W_IN, M, INW, D}; pg8::StaticOrder S; S.init(M, INW, F.G, F.bid); pg8::EpiProj E{PROJ};
        pg8::gemm_phase<pg8::EpiProj, pg8::StaticOrder, true, true>(F.lds, g, S, E); }
    SEAM(1);
    if (IN(2)) {
        for (int u = F.bid; u < BATCH * 16 * 2; u += F.G) attn_unit(F, PROJ, AG, F.in[3], u);
        for (int u = F.bid; u < BATCH * 16; u += F.G) gmlp_unit(F, PROJ, AG, F.in[4], F.in[5], W_SP, F.in[7], u);
    }
    SEAM(2);
    if (IN(3)) { pg8::Gemm g{AG, W_AB, M, D, D}; pg8::StaticOrder S; S.init(M, D, F.G, F.bid); pg8::EpiMerge E{PROJ, MG};
        pg8::gemm_phase<pg8::EpiMerge, pg8::StaticOrder, true, true>(F.lds, g, S, E); }
    SEAM(3);
    if (IN(4)) { pg8::Gemm g{MG, W_OUT, M, D, D}; pg8::StaticOrder S; S.init(M, D, F.G, F.bid); pg8::EpiSsq E{MIX, SSQA};
        pg8::gemm_phase<pg8::EpiSsq, pg8::StaticOrder, true, true>(F.lds, g, S, E); }
    SEAM(4);
    if (IN(5)) { const int gw = F.bid * NWAVES + F.wave, NGW = F.G * NWAVES;
        const float* RSTD = (const float*)(ws + WS_RSTD);
        for (int m = gw; m < M; m += NGW) e1_row(F.lane, HN + (size_t)m * D, RSTD[m], MIX + (size_t)m * D, SSQA + (size_t)m * 16, F.in[11], F.in[12], HB16 + (size_t)m * D); }
    SEAM(5);
    if (IN(6)) { pg8::Gemm g{HN, W_GU, M, 2 * FF, D}; pg8::StaticOrder S; S.init(M, 2 * FF, F.G, F.bid); pg8::EpiSwiglu E{HB};
        pg8::gemm_phase<pg8::EpiSwiglu, pg8::StaticOrder, true, true>(F.lds, g, S, E); }
    SEAM(6);
    if (IN(7)) { pg8::Gemm g{HB, W_D, M, D, FF}; pg8::StaticOrder S; S.init(M, D, F.G, F.bid); pg8::EpiSsq E{FFO, SSQB};
        pg8::gemm_phase<pg8::EpiSsq, pg8::StaticOrder, true, true>(F.lds, g, S, E); }
    SEAM(7);
    if (IN(8)) { const int gw = F.bid * NWAVES + F.wave, NGW = F.G * NWAVES;
        for (int m = gw; m < M; m += NGW) e2_row(F.lane, FFO + (size_t)m * D, SSQB + (size_t)m * 16, F.in[16], HB16 + (size_t)m * D, F.out + (size_t)m * D); }
#undef IN
#undef SEAM
}

extern "C" void kernel_launch(void* const* d_in, const int* in_sizes, int n_in, void* d_out, int out_size, void* d_ws, size_t ws_size, hipStream_t stream) {
    static int grid = 0;
    if (grid == 0) {
        if (n_in != 17 || out_size != M * D || ws_size < WS_END) { fprintf(stderr, "kernel_launch: unexpected problem: n_in %d out %d ws %zu\n", n_in, out_size, ws_size); grid = -1; return; }
        int dev = 0, cus = 0, per_cu = 0;
        (void)hipGetDevice(&dev); (void)hipDeviceGetAttribute(&cus, hipDeviceAttributeMultiprocessorCount, dev);
        if (hipFuncSetAttribute((const void*)fwd_megakernel, hipFuncAttributeMaxDynamicSharedMemorySize, LDS_BYTES) != hipSuccess) fprintf(stderr, "kernel_launch: hipFuncSetAttribute failed\n");
        if (hipOccupancyMaxActiveBlocksPerMultiprocessor(&per_cu, (const void*)fwd_megakernel, NTHR, LDS_BYTES) != hipSuccess || per_cu < 1) { fprintf(stderr, "kernel_launch: occupancy query says %d\n", per_cu); per_cu = 1; }
        (void)hipGetLastError();
        grid = cus * per_cu;
        fprintf(stderr, "kernel_launch: grid %d (cus %d x %d)\n", grid, cus, per_cu);
    }
    if (grid < 0) return;
    if (hipMemsetAsync((char*)d_ws + WS_CTL, 0, CTL_BYTES, stream) != hipSuccess) { fprintf(stderr, "kernel_launch: hipMemsetAsync failed\n"); return; }
    Args a{};
    for (int i = 0; i < 17; ++i) a.in[i] = (const float*)d_in[i];
    a.out = (float*)d_out; a.ws = (unsigned char*)d_ws;
#if MK_N_LAUNCHES == 1
    a.ph_lo = 0; a.ph_hi = N_PHASES;
    void* kargs[] = {&a};
    hipError_t e = hipLaunchCooperativeKernel((const void*)fwd_megakernel, dim3(grid), dim3(NTHR), kargs, LDS_BYTES, stream);
    if (e != hipSuccess) fprintf(stderr, "kernel_launch: cooperative launch failed: %s (grid %d)\n", hipGetErrorString(e), grid);
#else
    for (int k = 0; k < N_PHASES; ++k) { a.ph_lo = k; a.ph_hi = k + 1;
        hipLaunchKernelGGL(fwd_megakernel, dim3(grid), dim3(NTHR), LDS_BYTES, stream, a);
        const hipError_t le = hipPeekAtLastError(); if (le != hipSuccess) { fprintf(stderr, "kernel_launch: launch %d failed: %s\n", k, hipGetErrorName(le)); break; } }
#endif
}
```

```cpp
#include <hip/hip_runtime.h>
#include <hip/hip_cooperative_groups.h>
#include <cstdio>
#include <cstdint>
namespace cg = cooperative_groups;
#ifndef MK_N_LAUNCHES
#define MK_N_LAUNCHES 1
#endif
namespace pg8 {
#define PG8_LAS __attribute__((address_space(3)))
typedef unsigned short bf16_t;
typedef short bf16x8 __attribute__((ext_vector_type(8)));
typedef float f32x4 __attribute__((ext_vector_type(4)));
typedef unsigned u32x4 __attribute__((ext_vector_type(4)));
constexpr int BM = 256, BK = 64, HALF = 128, HTB = HALF * BK * 2  , STAGE_BYTES = 8 * HTB, NXCD = 8, WGM = 8;

__host__ __device__ __forceinline__ int lds_byte(int r, int c) { const int st = (r >> 4) * 2 + (c >> 5), rr = r & 15, cc = c & 31, ob = rr * 64 + cc * 2; return st * 1024 + (ob ^ (((ob >> 9) & 1) << 5)); }
__host__ __device__ __forceinline__ void stage_rc(int b, int& R, int& C) { const int st = b / 1024, sb = b % 1024, swz = sb ^ (((sb >> 9) & 1) << 5); R = (st >> 1) * 16 + swz / 64; C = (st & 1) * 32 + (swz % 64) / 2; }
__host__ __device__ __forceinline__ int perm32(int rho) { const int n = rho >> 4, i = rho & 15; return 8 * (i >> 2) + 4 * n + (i & 3); }

struct Unit { int pm, pn; };
struct Gemm { const bf16_t* A; const bf16_t* Bt; int M, N, K; };

struct StaticOrder {
    int nM, nN, nwg, G, c;
    __host__ __device__ void init(int M, int N, int G_, int c_) { nM = M / BM; nN = N / BM; nwg = nM * nN; G = G_; c = c_; }
    __host__ __device__ bool next(int i, Unit& u) const {
        const long L = (long)i * G + c; if (L >= nwg) return false;
        int wgid = (int)L; { const int q = nwg / NXCD, r = nwg % NXCD, xcd = wgid % NXCD, off = wgid / NXCD; wgid = (xcd < r ? xcd * (q + 1) : r * (q + 1) + (xcd - r) * q) + off; }
        const int nig = WGM * nN, gid = wgid / nig, fm = gid * WGM, gsz = (nM - fm) < WGM ? (nM - fm) : WGM;
        u.pm = fm + ((wgid % nig) % gsz); u.pn = (wgid % nig) / gsz; return true;
    }
    __device__ __forceinline__ void a_ready(const Unit&) const {}
    __device__ __forceinline__ void done(const Unit&) const {}
};

__device__ __forceinline__ unsigned cvt_pk_bf16(float lo, float hi) { unsigned r; asm volatile("v_cvt_pk_bf16_f32 %0, %1, %2" : "=v"(r) : "v"(lo), "v"(hi)); return r; }
typedef float f32x2 __attribute__((ext_vector_type(2)));
__device__ __forceinline__ f32x2 gelu_pk(f32x2 v) {
    const f32x2 av = __builtin_elementwise_abs(v), d = av * 0.2316418882f + 1.0f;
    f32x2 t; t.x = __builtin_amdgcn_rcpf(d.x); t.y = __builtin_amdgcn_rcpf(d.y);
    f32x2 q = t * 0.5307027145f + (-0.7265760135f); q = q * t + 0.7107068705f; q = q * t + (-0.142248368f); q = q * t + 0.127414796f; q = q * t;
    const f32x2 s = (v * v) * (-0.72134752044f);
    f32x2 e; e.x = __builtin_amdgcn_exp2f(s.x); e.y = __builtin_amdgcn_exp2f(s.y);
    const f32x2 m = v * (q * e), r = v - m;
    f32x2 o; o.x = v.x < 0.f ? m.x : r.x; o.y = v.y < 0.f ? m.y : r.y; return o;
}
typedef __bf16 bf16x2_t __attribute__((ext_vector_type(2)));
__device__ __forceinline__ unsigned cvtpk(float lo, float hi) { f32x2 v = {lo, hi}; bf16x2_t b = __builtin_convertvector(v, bf16x2_t); return __builtin_bit_cast(unsigned, b); }
__device__ __forceinline__ float bflo(unsigned u) { return __uint_as_float(u << 16); }
__device__ __forceinline__ float bfhi(unsigned u) { return __uint_as_float(u & 0xffff0000u); }
__device__ __forceinline__ float sigm(float x) { return __builtin_amdgcn_rcpf(1.0f + __builtin_amdgcn_exp2f(-1.4426950408889634f * x)); }
__device__ __forceinline__ u32x4 pack8(f32x4 v0, f32x4 v1) { u32x4 w; w.x = cvtpk(v0[0], v0[1]); w.y = cvtpk(v0[2], v0[3]); w.z = cvtpk(v1[0], v1[1]); w.w = cvtpk(v1[2], v1[3]); return w; }
constexpr int PROJ_LD = 3840;
constexpr float QSCALE = 0.125f * 1.4426950408889634f;

struct EpiProj {
    static constexpr bool PERM = true, AFTER_DRAIN = false, MID = false;
    bf16_t* O;
    __device__ __forceinline__ void mid(f32x4 (&)[2][2][4][2], const Unit&, int, int, int, int) const {}
    __device__ __forceinline__ void operator()(const f32x4 (&acc)[2][2][4][2], const Unit& u, int wr, int wc, int fr, int fq) const {
        const int row0 = u.pm * BM + wr * 64 + fr, col0 = u.pn * BM + wc * 32 + 8 * fq;
        const int mode = u.pn < 3 ? 0 : (u.pn < 7 ? 1 : 2); const float sc = u.pn < 2 ? QSCALE : 1.0f;
#pragma unroll
        for (int ai = 0; ai < 2; ++ai)
#pragma unroll
            for (int m = 0; m < 4; ++m) { bf16_t* rowp = O + (size_t)(row0 + ai * HALF + m * 16) * PROJ_LD + col0;
#pragma unroll
                for (int bj = 0; bj < 2; ++bj) { f32x4 v0 = acc[ai][bj][m][0], v1 = acc[ai][bj][m][1];
                    if (mode == 1) { f32x2 a = gelu_pk((f32x2){v0[0], v0[1]}), b = gelu_pk((f32x2){v0[2], v0[3]}), c = gelu_pk((f32x2){v1[0], v1[1]}), d = gelu_pk((f32x2){v1[2], v1[3]});
                        v0 = (f32x4){a.x, a.y, b.x, b.y}; v1 = (f32x4){c.x, c.y, d.x, d.y}; }
                    else if (mode == 2) { v0 = (f32x4){sigm(v0[0]), sigm(v0[1]), sigm(v0[2]), sigm(v0[3])}; v1 = (f32x4){sigm(v1[0]), sigm(v1[1]), sigm(v1[2]), sigm(v1[3])}; }
                    else { v0 = v0 * sc; v1 = v1 * sc; }
                    *(u32x4*)(rowp + bj * HALF) = pack8(v0, v1); } }
    }
};
struct EpiMerge {
    static constexpr bool PERM = true, AFTER_DRAIN = false, MID = true;
    const bf16_t* P; bf16_t* O;
    __device__ __forceinline__ void mid(f32x4 (&acc)[2][2][4][2], const Unit& u, int wr, int wc, int fr, int fq) const {
        asm volatile("" : "+v"(fr), "+v"(fq));
        const int row0 = u.pm * BM + wr * 64 + fr, col0 = u.pn * BM + wc * 32 + 8 * fq;
#pragma unroll
        for (int ai = 0; ai < 2; ++ai)
#pragma unroll
            for (int m = 0; m < 4; ++m) { const bf16_t* rowp = P + (size_t)(row0 + ai * HALF + m * 16) * PROJ_LD + col0;
#pragma unroll
                for (int bj = 0; bj < 2; ++bj) { const u32x4 a = *(const u32x4*)(rowp + 1792 + bj * HALF), b = *(const u32x4*)(rowp + 2816 + bj * HALF);
                    f32x4 r0, r1;
                    r0[0] = bflo(a.x) * __builtin_amdgcn_rcpf(bflo(b.x)); r0[1] = bfhi(a.x) * __builtin_amdgcn_rcpf(bfhi(b.x)); r0[2] = bflo(a.y) * __builtin_amdgcn_rcpf(bflo(b.y)); r0[3] = bfhi(a.y) * __builtin_amdgcn_rcpf(bfhi(b.y));
                    r1[0] = bflo(a.z) * __builtin_amdgcn_rcpf(bflo(b.z)); r1[1] = bfhi(a.z) * __builtin_amdgcn_rcpf(bfhi(b.z)); r1[2] = bflo(a.w) * __builtin_amdgcn_rcpf(bflo(b.w)); r1[3] = bfhi(a.w) * __builtin_amdgcn_rcpf(bfhi(b.w));
                    acc[ai][bj][m][0] *= r0; acc[ai][bj][m][1] *= r1; }
                if (m & 1) asm volatile("" ::: "memory"); }
    }
    __device__ __forceinline__ void operator()(const f32x4 (&acc)[2][2][4][2], const Unit& u, int wr, int wc, int fr, int fq) const {
        const int row0 = u.pm * BM + wr * 64 + fr, col0 = u.pn * BM + wc * 32 + 8 * fq;
#pragma unroll
        for (int ai = 0; ai < 2; ++ai)
#pragma unroll
            for (int m = 0; m < 4; ++m) { const size_t row = (size_t)(row0 + ai * HALF + m * 16); const bf16_t* rowp = P + row * PROJ_LD + col0;
#pragma unroll
                for (int bj = 0; bj < 2; ++bj) { const u32x4 b = *(const u32x4*)(rowp + 2816 + bj * HALF);
                    const f32x4 s0 = {bflo(b.x), bfhi(b.x), bflo(b.y), bfhi(b.y)}, s1 = {bflo(b.z), bfhi(b.z), bflo(b.w), bfhi(b.w)};
                    *(u32x4*)(O + row * 1024 + col0 + bj * HALF) = pack8(acc[ai][bj][m][0] * s0, acc[ai][bj][m][1] * s1); }
                asm volatile("" ::: "memory"); }
    }
};
struct EpiSsq {
    static constexpr bool PERM = true, AFTER_DRAIN = false, MID = false;
    bf16_t* O; float* ssq;
    __device__ __forceinline__ void mid(f32x4 (&)[2][2][4][2], const Unit&, int, int, int, int) const {}
    __device__ __forceinline__ void operator()(const f32x4 (&acc)[2][2][4][2], const Unit& u, int wr, int wc, int fr, int fq) const {
        const int row0 = u.pm * BM + wr * 64 + fr, col0 = u.pn * BM + wc * 32 + 8 * fq;
#pragma unroll
        for (int ai = 0; ai < 2; ++ai)
#pragma unroll
            for (int m = 0; m < 4; ++m) { const size_t row = (size_t)(row0 + ai * HALF + m * 16); float s = 0.f;
#pragma unroll
                for (int bj = 0; bj < 2; ++bj) { const f32x4 v0 = acc[ai][bj][m][0], v1 = acc[ai][bj][m][1];
                    s += (v0[0] * v0[0] + v0[1] * v0[1]) + (v0[2] * v0[2] + v0[3] * v0[3]) + (v1[0] * v1[0] + v1[1] * v1[1]) + (v1[2] * v1[2] + v1[3] * v1[3]);
                    *(u32x4*)(O + row * 1024 + col0 + bj * HALF) = pack8(v0, v1); }
                s += __shfl_xor(s, 16); s += __shfl_xor(s, 32);
                if (fq == 0) ssq[row * 16 + u.pn * 4 + wc] = s; }
    }
};
struct EpiSwiglu {
    static constexpr bool PERM = true, AFTER_DRAIN = false, MID = false;
    bf16_t* O;
    __device__ __forceinline__ void mid(f32x4 (&)[2][2][4][2], const Unit&, int, int, int, int) const {}
    __device__ __forceinline__ void operator()(const f32x4 (&acc)[2][2][4][2], const Unit& u, int wr, int wc, int fr, int fq) const {
        const int row0 = u.pm * BM + wr * 64 + fr, col0 = u.pn * HALF + wc * 32 + 8 * fq;
#pragma unroll
        for (int ai = 0; ai < 2; ++ai)
#pragma unroll
            for (int m = 0; m < 4; ++m) { const size_t row = (size_t)(row0 + ai * HALF + m * 16);
                const f32x4 g0 = acc[ai][0][m][0], g1 = acc[ai][0][m][1], u0 = acc[ai][1][m][0], u1 = acc[ai][1][m][1];
                f32x4 h0, h1;
#pragma unroll
                for (int e = 0; e < 4; ++e) { h0[e] = g0[e] * sigm(g0[e]) * u0[e]; h1[e] = g1[e] * sigm(g1[e]) * u1[e]; }
                *(u32x4*)(O + row * 2816 + col0) = pack8(h0, h1); }
    }
};
template <class Epi, class Sched, bool ALIGN_EPI = false, bool SP2 = false>
__device__ __forceinline__ void gemm_phase(PG8_LAS unsigned char* lds, const Gemm g, const Sched& S, const Epi& E) {
    const int tid = threadIdx.x, wid = __builtin_amdgcn_readfirstlane(tid >> 6), lane = tid & 63, wr = wid >> 2, wc = wid & 3, fr = lane & 15, fq = lane >> 4;
    const int K = g.K, nt = K / BK;
    unsigned voffA[2], voffB[2];
#pragma unroll
    for (int i = 0; i < 2; ++i) { int R, C; stage_rc(tid * 16 + i * 8192, R, C); const int Rb = Epi::PERM ? ((R & ~31) + perm32(R & 31)) : R;
        voffA[i] = (unsigned)(R * K + C) * 2u; voffB[i] = (unsigned)(Rb * K + C) * 2u; }
    const size_t kstep = (size_t)(BK * 2);
    const size_t hstep = (size_t)HALF * K * 2;
    const size_t tstep = 2 * hstep;
    const unsigned ldsw = (unsigned)wid * 1024u;
    const int aoff = lds_byte(wr * 64 + fr, fq * 8), boff = lds_byte(wc * 32 + fr, fq * 8);
#define PG8_SA(b, h) (((b) * 2 + (h)) * HTB)
#define PG8_SB(b, h) ((4 + (b) * 2 + (h)) * HTB)
#define PG8_STAGE(bufoff, gbase, voff) do { _Pragma("unroll") for (int _i = 0; _i < 2; ++_i) \
        __builtin_amdgcn_global_load_lds((const unsigned*)((const char*)(gbase) + (voff)[_i]), (PG8_LAS unsigned*)(lds + (bufoff) + ldsw + _i * 8192), 16, 0, 0); } while (0)
#define PG8_LDA(dst, b, h) do { _Pragma("unroll") for (int m = 0; m < 4; ++m) _Pragma("unroll") for (int k = 0; k < 2; ++k) dst[m][k] = *(const PG8_LAS bf16x8*)(lds + PG8_SA(b, h) + aoff + m * 2048 + k * 1024); } while (0)
#define PG8_LDB(dst, b, h) do { _Pragma("unroll") for (int n = 0; n < 2; ++n) _Pragma("unroll") for (int k = 0; k < 2; ++k) dst[n][k] = *(const PG8_LAS bf16x8*)(lds + PG8_SB(b, h) + boff + n * 2048 + k * 1024); } while (0)
#define PG8_MMA(ai, bj, At, Bt) do { __builtin_amdgcn_s_setprio(1); _Pragma("unroll") for (int m = 0; m < 4; ++m) _Pragma("unroll") for (int n = 0; n < 2; ++n) _Pragma("unroll") for (int k = 0; k < 2; ++k) \
        acc[ai][bj][m][n] = __builtin_amdgcn_mfma_f32_16x16x32_bf16(Bt[n][k], At[m][k], acc[ai][bj][m][n], 0, 0, 0); __builtin_amdgcn_s_setprio(0); } while (0)
#define PG8_WAIT_V(n) asm volatile("s_waitcnt vmcnt(" #n ")" ::: "memory")
#define PG8_WAIT_L(n) asm volatile("s_waitcnt lgkmcnt(" #n ")" ::: "memory")
#define PG8_BAR __builtin_amdgcn_s_barrier()
#define PG8_SCHED __builtin_amdgcn_sched_barrier(0)
    Unit cur, nxt; int ui = 0;
    if (!S.next(0, cur)) return;
    f32x4 acc[2][2][4][2];
#pragma unroll
    for (int a = 0; a < 2; ++a)
#pragma unroll
        for (int b = 0; b < 2; ++b)
#pragma unroll
            for (int m = 0; m < 4; ++m)
#pragma unroll
                for (int n = 0; n < 2; ++n) acc[a][b][m][n] = (f32x4){0.f, 0.f, 0.f, 0.f};
    bf16x8 At[4][2], B0[2][2], B1[2][2];
    const char* cA = (const char*)g.A + (size_t)cur.pm * tstep; const char* cB = (const char*)g.Bt + (size_t)cur.pn * tstep;
    S.a_ready(cur);
    if constexpr (SP2) {
        PG8_STAGE(PG8_SB(0, 0), cB, voffB); PG8_STAGE(PG8_SB(0, 1), cB + hstep, voffB); PG8_STAGE(PG8_SA(0, 0), cA, voffA); PG8_STAGE(PG8_SA(0, 1), cA + hstep, voffA);
        if (wr == 1) PG8_BAR;
        PG8_WAIT_V(2); PG8_BAR;
        PG8_STAGE(PG8_SB(1, 0), cB + kstep, voffB); PG8_STAGE(PG8_SA(1, 0), cA + kstep, voffA); PG8_STAGE(PG8_SB(1, 1), cB + hstep + kstep, voffB);
        PG8_WAIT_V(6); PG8_BAR;
    } else {
        PG8_STAGE(PG8_SB(0, 0), cB, voffB); PG8_STAGE(PG8_SA(0, 0), cA, voffA); PG8_STAGE(PG8_SB(0, 1), cB + hstep, voffB); PG8_STAGE(PG8_SA(0, 1), cA + hstep, voffA);
        if (wr == 1) PG8_BAR;
        PG8_WAIT_V(4); PG8_BAR;
        PG8_STAGE(PG8_SB(1, 0), cB + kstep, voffB); PG8_STAGE(PG8_SA(1, 0), cA + kstep, voffA); PG8_STAGE(PG8_SB(1, 1), cB + hstep + kstep, voffB);
        PG8_WAIT_V(6); PG8_BAR;
    }
    for (;;) {
        const bool has_next = S.next(ui + 1, nxt);
        const char* nA = has_next ? (const char*)g.A + (size_t)nxt.pm * tstep : cA; const char* nB = has_next ? (const char*)g.Bt + (size_t)nxt.pn * tstep : cB;
        for (int t = 0; t < nt; t += 2) {
            const bool last = (t == nt - 2);
            if constexpr (Epi::MID) { if (t == (nt >> 1)) E.mid(acc, cur, wr, wc, fr, fq); }
            const char* a1 = cA + (size_t)(t + 1) * kstep;
            const char* a2 = last ? nA : cA + (size_t)(t + 2) * kstep; const char* b2 = last ? nB : cB + (size_t)(t + 2) * kstep;
            const char* a3 = a2 + kstep; const char* b3 = b2 + kstep;
            if (last && has_next) S.a_ready(nxt);
            if constexpr (SP2) {
            PG8_LDB(B0, 0, 0); PG8_LDB(B1, 0, 1); PG8_SCHED; PG8_LDA(At, 0, 0); PG8_STAGE(PG8_SA(1, 1), a1 + hstep, voffA);
            PG8_WAIT_V(8); PG8_WAIT_L(0); PG8_BAR; PG8_MMA(0, 0, At, B0); PG8_MMA(0, 1, At, B1); PG8_BAR; PG8_SCHED;
            PG8_LDA(At, 0, 1); PG8_STAGE(PG8_SB(0, 0), b2, voffB); PG8_STAGE(PG8_SB(0, 1), b2 + hstep, voffB); PG8_STAGE(PG8_SA(0, 0), a2, voffA);
            PG8_WAIT_V(8); PG8_WAIT_L(0); PG8_BAR; PG8_MMA(1, 0, At, B0); PG8_MMA(1, 1, At, B1); PG8_BAR; PG8_SCHED;
            PG8_LDB(B0, 1, 0); PG8_LDB(B1, 1, 1); PG8_SCHED; PG8_LDA(At, 1, 0); PG8_STAGE(PG8_SA(0, 1), a2 + hstep, voffA);
            PG8_WAIT_V(8); PG8_WAIT_L(0); PG8_BAR; PG8_MMA(0, 0, At, B0); PG8_MMA(0, 1, At, B1); PG8_BAR; PG8_SCHED;
            PG8_LDA(At, 1, 1); PG8_STAGE(PG8_SB(1, 0), b3, voffB); PG8_STAGE(PG8_SB(1, 1), b3 + hstep, voffB); PG8_STAGE(PG8_SA(1, 0), a3, voffA);
            PG8_WAIT_V(8); PG8_WAIT_L(0); PG8_BAR; PG8_MMA(1, 0, At, B0); PG8_MMA(1, 1, At, B1); PG8_BAR; PG8_SCHED;
            } else {
            PG8_LDB(B0, 0, 0); PG8_SCHED; PG8_LDA(At, 0, 0); PG8_STAGE(PG8_SA(1, 1), a1 + hstep, voffA);
            PG8_WAIT_L(8); PG8_BAR; PG8_WAIT_L(0); PG8_MMA(0, 0, At, B0); PG8_BAR; PG8_SCHED;
            PG8_LDB(B1, 0, 1); PG8_STAGE(PG8_SB(0, 0), b2, voffB);
            PG8_BAR; PG8_WAIT_L(0); PG8_MMA(0, 1, At, B1); PG8_BAR;
            PG8_LDA(At, 0, 1); PG8_STAGE(PG8_SA(0, 0), a2, voffA);
            PG8_BAR; PG8_WAIT_L(0); PG8_MMA(1, 0, At, B0); PG8_BAR; PG8_SCHED;
            PG8_STAGE(PG8_SB(0, 1), b2 + hstep, voffB);
            PG8_WAIT_V(6); PG8_BAR; PG8_MMA(1, 1, At, B1); PG8_BAR;
            PG8_LDB(B0, 1, 0); PG8_SCHED; PG8_LDA(At, 1, 0); PG8_STAGE(PG8_SA(0, 1), a2 + hstep, voffA);
            PG8_WAIT_L(8); PG8_BAR; PG8_WAIT_L(0); PG8_MMA(0, 0, At, B0); PG8_BAR; PG8_SCHED;
            PG8_LDB(B1, 1, 1); PG8_STAGE(PG8_SB(1, 0), b3, voffB);
            PG8_BAR; PG8_WAIT_L(0); PG8_MMA(0, 1, At, B1); PG8_BAR;
            PG8_LDA(At, 1, 1); PG8_STAGE(PG8_SA(1, 0), a3, voffA);
            PG8_BAR; PG8_WAIT_L(0); PG8_MMA(1, 0, At, B0); PG8_BAR; PG8_SCHED;
            PG8_STAGE(PG8_SB(1, 1), b3 + hstep, voffB);
            PG8_WAIT_V(6); PG8_BAR; PG8_MMA(1, 1, At, B1); PG8_BAR;
            }
        }
        if constexpr (ALIGN_EPI) { if (wr == 0) PG8_BAR; }
        if constexpr (!Epi::AFTER_DRAIN) { E(acc, cur, wr, wc, fr, fq); S.done(cur); }
        if (!has_next) break;
#pragma unroll
        for (int a = 0; a < 2; ++a)
#pragma unroll
            for (int b = 0; b < 2; ++b)
#pragma unroll
                for (int m = 0; m < 4; ++m)
#pragma unroll
                    for (int n = 0; n < 2; ++n) acc[a][b][m][n] = (f32x4){0.f, 0.f, 0.f, 0.f};
        cur = nxt; cA = nA; cB = nB; ++ui;
        if constexpr (ALIGN_EPI) { if (wr == 1) PG8_BAR; }
    }
    PG8_WAIT_V(0);
    if constexpr (!ALIGN_EPI) { if (wr == 0) PG8_BAR; }
    PG8_BAR;
    if constexpr (Epi::AFTER_DRAIN) { E.fused(acc, cur, wr, wc, fr, fq, lds, wid, lane); S.done(cur); }
#undef PG8_SA
#undef PG8_SB
#undef PG8_STAGE
#undef PG8_LDA
#undef PG8_LDB
#undef PG8_MMA
#undef PG8_WAIT_V
#undef PG8_WAIT_L
#undef PG8_BAR
#undef PG8_SCHED
}
}

constexpr int NWAVES = 8, NTHR = 512;
constexpr int BATCH = 32, SEQ = 2048, D = 1024, M = BATCH * SEQ;
constexpr int INW = 3840, FF = 2816;
constexpr int C_K = 512, C_V = 640, C_U = 768, C_VG = 1280;
constexpr float EPS = 1e-6f, LN_EPS = 1e-5f, LOG2E = 1.4426950408889634f;
constexpr size_t MiB = 1u << 20;
constexpr size_t WS_WIN = 0;
constexpr size_t WS_WAB = 8 * MiB;
constexpr size_t WS_WOUT = 10 * MiB;
constexpr size_t WS_WGU = 12 * MiB;
constexpr size_t WS_WD = 24 * MiB;
constexpr size_t WS_WSP = 30 * MiB;
constexpr size_t WS_CTL = 31 * MiB + 512 * 1024;
constexpr int CTL_BYTES = 16384, MISC_OFF = 147456 - 64;
constexpr size_t WS_RSTD = 31 * MiB;
constexpr size_t WS_SSQA = 32 * MiB;
constexpr size_t WS_SSQB = 36 * MiB;
constexpr size_t WS_XN = 40 * MiB;
constexpr size_t WS_AG = 168 * MiB;
constexpr size_t WS_MG = 296 * MiB;
constexpr size_t WS_PROJ = 424 * MiB;
constexpr size_t WS_HB16 = WS_PROJ + 352 * MiB;
constexpr size_t WS_END = 904 * MiB;
constexpr int LDS_BYTES = 147456;

#define GAS __attribute__((address_space(1)))
#define LAS __attribute__((address_space(3)))
typedef unsigned short bf16;
typedef unsigned v4u __attribute__((ext_vector_type(4)));
typedef unsigned v2u __attribute__((ext_vector_type(2)));
typedef float f32x4 __attribute__((ext_vector_type(4)));
typedef float f32x16 __attribute__((ext_vector_type(16)));
typedef short bf16x8 __attribute__((ext_vector_type(8)));
typedef short s16x4 __attribute__((ext_vector_type(4)));
using pg8::cvtpk; using pg8::bflo; using pg8::bfhi;
#define LDS_WAIT() asm volatile("s_waitcnt lgkmcnt(0)" ::: "memory")
__device__ __forceinline__ unsigned short f2bf(float f) { return (unsigned short)(cvtpk(f, 0.f) & 0xffffu); }
__device__ __forceinline__ float bf2f(unsigned short h) { return __uint_as_float((unsigned)h << 16); }
__device__ __forceinline__ float wave_sum(float v) {
#pragma unroll
    for (int o = 1; o < 64; o <<= 1) v += __shfl_xor(v, o);
    return v;
}
__device__ __forceinline__ int crow(int r, int hi) { return (r & 3) + 8 * (r >> 2) + 4 * hi; }

struct Frame {
    LAS unsigned char* lds;
    int tid, lane, wave, G, bid;
    const float* in[17]; float* out; unsigned char* ws;
};
__device__ __forceinline__ int rowmap(int mode, int n) { return mode == 0 ? n : (((n >> 7) << 8) + (n & 127) + (mode == 2 ? 128 : 0)); }
__device__ __forceinline__ void p0_transpose_item(const float* W, int N, bf16* WT, int ldk, int koff, int mode, LAS float* scr, int item, int lane, const float* kscale = nullptr) {
    const int nblk = N / 32, kb = item / nblk, nb = item % nblk, k0 = 64 * kb, n0 = 32 * nb;
#pragma unroll 8
    for (int i = 0; i < 32; ++i) { const int kk = 2 * i + (lane >> 5); float w = W[(size_t)(k0 + kk) * N + n0 + (lane & 31)]; if (kscale) w *= kscale[k0 + kk]; scr[kk * 33 + (lane & 31)] = w; }
    LDS_WAIT(); asm volatile("" ::: "memory");
    const int c = lane & 7;
#pragma unroll
    for (int j = 0; j < 4; ++j) { const int n = (lane >> 3) + 8 * j; const LAS float* s = scr + (8 * c) * 33 + n;
        v4u o; o.x = cvtpk(s[0 * 33], s[1 * 33]); o.y = cvtpk(s[2 * 33], s[3 * 33]); o.z = cvtpk(s[4 * 33], s[5 * 33]); o.w = cvtpk(s[6 * 33], s[7 * 33]);
        *(GAS v4u*)(WT + (size_t)rowmap(mode, n0 + n) * ldk + koff + k0 + 8 * c) = o; }
    LDS_WAIT(); asm volatile("" ::: "memory");
}
__device__ __forceinline__ void rms_row_to_bf16(int lane, const float* xrow, float* rstd_out, bf16* orow) {
    const GAS f32x4* xr = (const GAS f32x4*)xrow + lane;
    f32x4 v[4]; float s = 0.f;
#pragma unroll
    for (int j = 0; j < 4; ++j) { v[j] = xr[64 * j]; s += (v[j].x * v[j].x + v[j].y * v[j].y) + (v[j].z * v[j].z + v[j].w * v[j].w); }
    const float rstd = 1.0f / sqrtf(wave_sum(s) * (1.f / D) + EPS);
    if (lane == 0) *rstd_out = rstd;
    GAS v2u* o8 = (GAS v2u*)orow + lane;
#pragma unroll
    for (int j = 0; j < 4; ++j) { v2u w; w.x = cvtpk(v[j].x * rstd, v[j].y * rstd); w.y = cvtpk(v[j].z * rstd, v[j].w * rstd); o8[64 * j] = w; }
}
__device__ __forceinline__ void p0_prologue(Frame& F) {
    LAS float* scr = (LAS float*)(F.lds + F.wave * 16384);
    const int gw = F.bid * NWAVES + F.wave, NGW = F.G * NWAVES;
    unsigned char* ws = F.ws;
    constexpr int I_IN = (1024 / 64) * (INW / 32), I_A = (512 / 64) * (1024 / 32), I_O = (1024 / 64) * (1024 / 32), I_G = (1024 / 64) * (FF / 32), I_D = (FF / 64) * (1024 / 32);
    constexpr int NITEMS = I_IN + 2 * I_A + I_O + 2 * I_G + I_D;
    for (int it = gw; it < NITEMS; it += NGW) {
        int r = it;
        if (r < I_IN) { p0_transpose_item(F.in[2], INW, (bf16*)(ws + WS_WIN), 1024, 0, 0, scr, r, F.lane, F.in[1]); continue; } r -= I_IN;
        if (r < I_A) { p0_transpose_item(F.in[8], 1024, (bf16*)(ws + WS_WAB), 1024, 0, 0, scr, r, F.lane); continue; } r -= I_A;
        if (r < I_A) { p0_transpose_item(F.in[9], 1024, (bf16*)(ws + WS_WAB), 1024, 512, 0, scr, r, F.lane); continue; } r -= I_A;
        if (r < I_O) { p0_transpose_item(F.in[10], 1024, (bf16*)(ws + WS_WOUT), 1024, 0, 0, scr, r, F.lane); continue; } r -= I_O;
        if (r < I_G) { p0_transpose_item(F.in[13], FF, (bf16*)(ws + WS_WGU), 1024, 0, 1, scr, r, F.lane); continue; } r -= I_G;
        if (r < I_G) { p0_transpose_item(F.in[14], FF, (bf16*)(ws + WS_WGU), 1024, 0, 2, scr, r, F.lane); continue; } r -= I_G;
        p0_transpose_item(F.in[15], 1024, (bf16*)(ws + WS_WD), FF, 0, 0, scr, r, F.lane);
    }
    { const float* wsrc = F.in[6]; bf16* wdst = (bf16*)(ws + WS_WSP);
      for (int i = gw * 64 + F.lane; i < 4 * 128 * 128; i += NGW * 64) { const int t = (i >> 7) & 127, s = i & 127; wdst[i] = f2bf(s <= t ? wsrc[i] : 0.f); } }
    bf16* XN = (bf16*)(ws + WS_XN);
    float* RSTD = (float*)(ws + WS_RSTD);
    for (int m = gw; m < M; m += NGW) rms_row_to_bf16(F.lane, F.in[0] + (size_t)m * D, RSTD + m, XN + (size_t)m * D);
}
constexpr int KS_ROW = 144, VT_ROW = 260  , KS_BYTES = 256 * KS_ROW;
__device__ __forceinline__ void attn_unit(Frame& F, const bf16* PROJ, bf16* AG, const float* sinks, int unit) {
    const int tid = F.tid, lane = F.lane, wave = F.wave, lq = lane & 31, hi = lane >> 5;
    const int kvh = unit & 1, n = (unit >> 1) & 15, b = unit >> 5;
    const long T0 = (long)b * SEQ + n * 128;
    LAS unsigned char* Ks = F.lds; LAS unsigned short* VT = (LAS unsigned short*)(F.lds + KS_BYTES);
    const int jstart = (n == 0) ? 128 : 0;
#pragma unroll
    for (int it = 0; it < 4; ++it) { const int id = it * NTHR + tid, key = id >> 3, ch = id & 7;
        if (key >= jstart) { const bf16* src = PROJ + (T0 - 128 + key) * INW + C_K + kvh * 64 + ch * 8;
            const v4u kv = *(const GAS v4u*)src, vv = *(const GAS v4u*)(src + 128);
            *(LAS v4u*)(Ks + key * KS_ROW + ch * 16) = kv;
            LAS unsigned short* vt = VT + (ch * 8) * VT_ROW + key;
            vt[0 * VT_ROW] = (unsigned short)(vv.x & 0xffffu); vt[1 * VT_ROW] = (unsigned short)(vv.x >> 16);
            vt[2 * VT_ROW] = (unsigned short)(vv.y & 0xffffu); vt[3 * VT_ROW] = (unsigned short)(vv.y >> 16);
            vt[4 * VT_ROW] = (unsigned short)(vv.z & 0xffffu); vt[5 * VT_ROW] = (unsigned short)(vv.z >> 16);
            vt[6 * VT_ROW] = (unsigned short)(vv.w & 0xffffu); vt[7 * VT_ROW] = (unsigned short)(vv.w >> 16); } }
    __syncthreads();
#pragma unroll 1
    for (int pass = 0; pass < 2; ++pass) {
        int lqo = lq; asm volatile("" : "+v"(lqo));
        const int g = pass * 2 + (wave >> 2), wq = wave & 3, hq = kvh * 4 + g;
        const float slope2 = __builtin_amdgcn_exp2f(-(float)(hq + 1)) * LOG2E, sink2 = sinks[hq] * LOG2E;
        const bf16* qp = PROJ + (T0 + 32 * wq + lq) * INW + hq * 64 + 8 * hi;
        bf16x8 qf[4];
#pragma unroll
        for (int ds = 0; ds < 4; ++ds) qf[ds] = *(const GAS bf16x8*)(qp + 16 * ds);
        f32x16 S[5];
#pragma unroll
        for (int i = 0; i < 5; ++i) { const int kt = wq + i; const bool skip = (n == 0 && kt < 4);
#pragma unroll
            for (int r = 0; r < 16; ++r) S[i][r] = 0.f;
            if (!skip) {
#pragma unroll
                for (int ds = 0; ds < 4; ++ds) { const bf16x8 kf = *(const LAS bf16x8*)(Ks + (32 * kt + lq) * KS_ROW + (16 * ds + 8 * hi) * 2);
                    S[i] = __builtin_amdgcn_mfma_f32_32x32x16_bf16(kf, qf[ds], S[i], 0, 0, 0); } }
            __builtin_amdgcn_sched_barrier(0); }
        float mx = sink2;
#pragma unroll
        for (int i = 0; i < 5; ++i) { const bool skip = (n == 0 && wq + i < 4);
#pragma unroll
            for (int r = 0; r < 16; ++r) { const int rel = 128 - 32 * i + lqo - crow(r, hi);
                const bool valid = !skip && (i == 0 ? rel <= 127 : (i == 4 ? rel >= 0 : true));
                const float lg = valid ? S[i][r] - slope2 * (float)rel : -1e30f; S[i][r] = lg; mx = fmaxf(mx, lg); } }
        mx = fmaxf(mx, __shfl_xor(mx, 32));
        float sum = 0.f;
#pragma unroll
        for (int i = 0; i < 5; ++i)
#pragma unroll
            for (int r = 0; r < 16; ++r) { const float p = __builtin_amdgcn_exp2f(S[i][r] - mx); S[i][r] = p; sum += p; }
        sum += __shfl_xor(sum, 32); sum += __builtin_amdgcn_exp2f(sink2 - mx);
        const float inv = 1.0f / sum;
        f32x16 O[2];
#pragma unroll
        for (int r = 0; r < 16; ++r) { O[0][r] = 0.f; O[1][r] = 0.f; }
#pragma unroll
        for (int i = 0; i < 5; ++i) { const int kt = wq + i; const bool skip = (n == 0 && kt < 4);
            if (!skip) {
#pragma unroll
                for (int s = 0; s < 2; ++s) {
                    v4u pw; pw.x = cvtpk(S[i][8 * s + 0], S[i][8 * s + 1]); pw.y = cvtpk(S[i][8 * s + 2], S[i][8 * s + 3]); pw.z = cvtpk(S[i][8 * s + 4], S[i][8 * s + 5]); pw.w = cvtpk(S[i][8 * s + 6], S[i][8 * s + 7]);
                    const bf16x8 pf = __builtin_bit_cast(bf16x8, pw);
#pragma unroll
                    for (int dt = 0; dt < 2; ++dt) { const LAS unsigned short* vp = VT + (32 * dt + lq) * VT_ROW + 32 * kt + 16 * s + 4 * hi;
                        const s16x4 lo = *(const LAS s16x4*)vp, h8 = *(const LAS s16x4*)(vp + 8);
                        const bf16x8 vf = __builtin_shufflevector(lo, h8, 0, 1, 2, 3, 4, 5, 6, 7);
                        O[dt] = __builtin_amdgcn_mfma_f32_32x32x16_bf16(vf, pf, O[dt], 0, 0, 0); } } }
            __builtin_amdgcn_sched_barrier(0); }
        bf16* op = AG + (T0 + 32 * wq + lq) * 1024 + hq * 64 + 4 * hi;
#pragma unroll
        for (int dt = 0; dt < 2; ++dt)
#pragma unroll
            for (int j = 0; j < 4; ++j) { v2u w; w.x = cvtpk(O[dt][4 * j] * inv, O[dt][4 * j + 1] * inv); w.y = cvtpk(O[dt][4 * j + 2] * inv, O[dt][4 * j + 3] * inv);
                *(GAS v2u*)(op + 32 * dt + 8 * j) = w; }
    }
    __syncthreads();
}
constexpr int GV_ROW = 132;
__device__ __forceinline__ void gmlp_unit(Frame& F, const bf16* PROJ, bf16* AG, const float* ln_g, const float* ln_b, const bf16* WSP, const float* b_s, int unit) {
    const int lane = F.lane, wave = F.wave, lq = lane & 31, hi = lane >> 5;
    const int n = unit & 15, b = unit >> 4; const long T0 = (long)b * SEQ + n * 128;
    LAS unsigned short* VT = (LAS unsigned short*)F.lds;
    float gch[8], bch[8];
#pragma unroll
    for (int i = 0; i < 8; ++i) { gch[i] = ln_g[lane + 64 * i]; bch[i] = ln_b[lane + 64 * i]; }
#pragma unroll 2
    for (int tk = 0; tk < 16; ++tk) { const int s = 16 * wave + tk; const bf16* vp = PROJ + (T0 + s) * INW + C_VG + lane;
        float x[8]; float sm = 0.f;
#pragma unroll
        for (int i = 0; i < 8; ++i) { x[i] = bf2f(vp[64 * i]); sm += x[i]; }
        const float mean = wave_sum(sm) * (1.f / 512.f); float q = 0.f;
#pragma unroll
        for (int i = 0; i < 8; ++i) { x[i] -= mean; q += x[i] * x[i]; }
        const float rstd = 1.0f / sqrtf(wave_sum(q) * (1.f / 512.f) + LN_EPS);
#pragma unroll
        for (int i = 0; i < 8; ++i) VT[(lane + 64 * i) * GV_ROW + s] = f2bf(x[i] * rstd * gch[i] + bch[i]); }
    __syncthreads();
    const int g = wave >> 1, cb = g * 128 + 64 * (wave & 1);
    f32x16 acc[2][4];
#pragma unroll
    for (int mt = 0; mt < 2; ++mt)
#pragma unroll
        for (int nt = 0; nt < 4; ++nt)
#pragma unroll
            for (int r = 0; r < 16; ++r) acc[mt][nt][r] = 0.f;
    const bf16* wg = WSP + (size_t)g * 128 * 128 + (size_t)lq * 128 + 8 * hi;
#pragma unroll 1
    for (int ks = 0; ks < 8; ++ks) {
        bf16x8 af[2];
#pragma unroll
        for (int mt = 0; mt < 2; ++mt) { const LAS unsigned short* ap = VT + (cb + 32 * mt + lq) * GV_ROW + 16 * ks + 8 * hi;
            const s16x4 lo = *(const LAS s16x4*)ap, h8 = *(const LAS s16x4*)(ap + 4); af[mt] = __builtin_shufflevector(lo, h8, 0, 1, 2, 3, 4, 5, 6, 7); }
#pragma unroll
        for (int nt = 0; nt < 4; ++nt) if (ks < 2 * (nt + 1)) { const bf16x8 bfr = *(const GAS bf16x8*)(wg + (size_t)(32 * nt) * 128 + 16 * ks);
#pragma unroll
            for (int mt = 0; mt < 2; ++mt) acc[mt][nt] = __builtin_amdgcn_mfma_f32_32x32x16_bf16(af[mt], bfr, acc[mt][nt], 0, 0, 0); }
    }
#pragma unroll
    for (int nt = 0; nt < 4; ++nt) { const int t = 32 * nt + lq; const float bias = b_s[g * 128 + t];
        const bf16* up = PROJ + (T0 + t) * INW + C_U + cb + 4 * hi; bf16* op = AG + (T0 + t) * 1024 + 512 + cb + 4 * hi;
#pragma unroll
        for (int mt = 0; mt < 2; ++mt)
#pragma unroll
            for (int j = 0; j < 4; ++j) { const v2u uu = *(const GAS v2u*)(up + 32 * mt + 8 * j);
                v2u w; w.x = cvtpk(bflo(uu.x) * (acc[mt][nt][4 * j] + bias), bfhi(uu.x) * (acc[mt][nt][4 * j + 1] + bias));
                w.y = cvtpk(bflo(uu.y) * (acc[mt][nt][4 * j + 2] + bias), bfhi(uu.y) * (acc[mt][nt][4 * j + 3] + bias));
                *(GAS v2u*)(op + 32 * mt + 8 * j) = w; } }
    __syncthreads();
}
__device__ __forceinline__ void unpack8(const v4u mv, f32x4& a, f32x4& b) { a = (f32x4){bflo(mv.x), bfhi(mv.x), bflo(mv.y), bfhi(mv.y)}; b = (f32x4){bflo(mv.z), bfhi(mv.z), bflo(mv.w), bfhi(mv.w)}; }
__device__ __forceinline__ void e1_row(int lane, bf16* xbrow, float rstd_x, const bf16* mixrow, const float* ssq, const float* gpost, const float* gpre, bf16* hrow) {
    float t = (lane < 16) ? ssq[lane] : 0.f; t = wave_sum(t);
    const float rstd = 1.0f / sqrtf(t * (1.f / D) + EPS), rx = 1.0f / rstd_x;
    f32x4 h[2][2]; float s = 0.f;
#pragma unroll
    for (int j = 0; j < 2; ++j) { const int c = 8 * lane + 512 * j; const v4u mv = *(const GAS v4u*)(mixrow + c), xv = *(const GAS v4u*)(xbrow + c);
        const f32x4 g0 = *(const GAS f32x4*)(gpost + c), g1 = *(const GAS f32x4*)(gpost + c + 4);
        f32x4 m0, m1, x0, x1; unpack8(mv, m0, m1); unpack8(xv, x0, x1);
        h[j][0] = x0 * rx + m0 * rstd * g0; h[j][1] = x1 * rx + m1 * rstd * g1;
        *(GAS v4u*)(hrow + c) = pg8::pack8(h[j][0], h[j][1]);
#pragma unroll
        for (int e = 0; e < 4; ++e) s += h[j][0][e] * h[j][0][e] + h[j][1][e] * h[j][1][e]; }
    const float r2 = 1.0f / sqrtf(wave_sum(s) * (1.f / D) + EPS);
#pragma unroll
    for (int j = 0; j < 2; ++j) { const int c = 8 * lane + 512 * j; const f32x4 g0 = *(const GAS f32x4*)(gpre + c), g1 = *(const GAS f32x4*)(gpre + c + 4);
        *(GAS v4u*)(xbrow + c) = pg8::pack8(h[j][0] * r2 * g0, h[j][1] * r2 * g1); }
}
__device__ __forceinline__ void e2_row(int lane, const bf16* ffrow, const float* ssq, const float* gpost, const bf16* hrow, float* orow) {
    float t = (lane < 16) ? ssq[lane] : 0.f; t = wave_sum(t);
    const float rstd = 1.0f / sqrtf(t * (1.f / D) + EPS);
#pragma unroll
    for (int j = 0; j < 2; ++j) { const int c = 8 * lane + 512 * j; const v4u mv = *(const GAS v4u*)(ffrow + c), hv = *(const GAS v4u*)(hrow + c);
        const f32x4 g0 = *(const GAS f32x4*)(gpost + c), g1 = *(const GAS f32x4*)(gpost + c + 4);
        f32x4 m0, m1, x0, x1; unpack8(mv, m0, m1); unpack8(hv, x0, x1);
        *(GAS f32x4*)(orow + c) = x0 + m0 * rstd * g0; *(GAS f32x4*)(orow + c + 4) = x1 + m1 * rstd * g1; }
}
#define XB_TMO      128
#define XB_XCNT(j)  (256  + 64 * (j))
#define XB_XSUB(j)  (1280 + 64 * (j))
#define XB_XGEN(j)  (2304 + 64 * (j))
#define XB_TOP      3328
#define XB_TOPGEN   3392
#define XCD_BAR_WORDS 3456
#define XB_SPIN_CAP (1u << 18)

__device__ __forceinline__ unsigned xb_ld(unsigned* p)              { return __hip_atomic_load(p, __ATOMIC_RELAXED, __HIP_MEMORY_SCOPE_AGENT); }
__device__ __forceinline__ unsigned xb_add(unsigned* p, unsigned v) { return __hip_atomic_fetch_add(p, v, __ATOMIC_RELAXED, __HIP_MEMORY_SCOPE_AGENT); }
__device__ __forceinline__ unsigned xb_xcc_id() { return (unsigned)__builtin_amdgcn_s_getreg((3 << 11) | 20) & 0xFu; }
#define XB_SPIN(cond, bar) do { unsigned _sp = 0; while (cond) { __builtin_amdgcn_s_sleep(1); \
    if ((++_sp & 255u) == 0u) { if (xb_ld(&(bar)[XB_TMO])) break; if (_sp > XB_SPIN_CAP) { atomicAdd(&(bar)[XB_TMO], 1u); break; } } } } while (0)

struct XcdBarrier {
    unsigned* bar; unsigned x;
    volatile LAS unsigned* st;
};

__device__ __forceinline__ XcdBarrier xcd_barrier_post(unsigned* bar, volatile LAS unsigned* st) {
    XcdBarrier b; b.bar = bar; b.x = xb_xcc_id(); b.st = st;
    if (threadIdx.x == 0) (void)xb_add(&bar[XB_XCNT(b.x)], 1u);
    return b;
}
__device__ __forceinline__ void xcd_barrier_complete(unsigned* bar, unsigned x, unsigned& nloc, unsigned& nx) {
    const unsigned G = gridDim.x * gridDim.y * gridDim.z;
    unsigned sum, cnt, mine, sp = 0u;
    for (;;) {
        sum = 0u; cnt = 0u; mine = 0u;
#pragma unroll
        for (unsigned j = 0; j < 16; ++j) { const unsigned c = xb_ld(&bar[XB_XCNT(j)]); sum += c; cnt += (c > 0u) ? 1u : 0u; mine = (j == x) ? c : mine; }
        if (sum == G) break;
        __builtin_amdgcn_s_sleep(1);
        if ((++sp & 255u) == 0u) { if (xb_ld(&bar[XB_TMO])) break; if (sp > XB_SPIN_CAP) { atomicAdd(&bar[XB_TMO], 1u); break; } }
    }
    nloc = mine > 0u ? mine : 1u; nx = cnt > 0u ? cnt : 1u;
}

__device__ __forceinline__ void xcd_barrier(const XcdBarrier& b) {
    asm volatile("s_waitcnt vmcnt(0)" ::: "memory");
    __syncthreads();
    if (threadIdx.x == 0) {
        unsigned* bar = b.bar;
        __builtin_amdgcn_s_waitcnt(0);
        unsigned nloc = b.st[0], nx = b.st[1];
        if (nloc == 0u) { xcd_barrier_complete(bar, b.x, nloc, nx); b.st[0] = nloc; b.st[1] = nx; }
        const unsigned old = xb_add(&bar[XB_XSUB(b.x)], 1u);
        const unsigned gen = old / nloc;
        if (old + 1u == (gen + 1u) * nloc) {
            __builtin_amdgcn_fence(__ATOMIC_RELEASE, "agent");
            asm volatile("s_waitcnt vmcnt(0)" ::: "memory");
            const unsigned og = xb_add(&bar[XB_TOP], 1u);
            const unsigned tg = og / nx;
            if (og + 1u == (tg + 1u) * nx) xb_add(&bar[XB_TOPGEN], 1u);
            else XB_SPIN(xb_ld(&bar[XB_TOPGEN]) == tg, bar);
            __builtin_amdgcn_fence(__ATOMIC_ACQUIRE, "agent");
            xb_add(&bar[XB_XGEN(b.x)], 1u);
            asm volatile("s_waitcnt vmcnt(0)" ::: "memory");
        } else {
            XB_SPIN(xb_ld(&bar[XB_XGEN(b.x)]) == gen, bar);
            __builtin_amdgcn_fence(__ATOMIC_ACQUIRE, "agent");
            asm volatile("s_waitcnt vmcnt(0)" ::: "memory");
        }
    }
    __syncthreads();
}

constexpr int N_PHASES = 9;
struct Args { const float* in[17]; float* out; unsigned char* ws; int ph_lo, ph_hi; };
__global__ void __launch_bounds__(NTHR, 2) fwd_megakernel(Args args) {
    extern __shared__ __attribute__((aligned(16))) unsigned char lds[];
    cg::grid_group grid = cg::this_grid();
    Frame F;
    F.lds = (LAS unsigned char*)lds;
    F.tid = threadIdx.x; F.lane = F.tid & 63; F.wave = __builtin_amdgcn_readfirstlane(F.tid >> 6);
    F.G = gridDim.x; F.bid = blockIdx.x;
#pragma unroll
    for (int i = 0; i < 17; ++i) F.in[i] = args.in[i];
    F.out = args.out; F.ws = args.ws;
    unsigned char* ws = args.ws;
    const int lo = args.ph_lo, hi = args.ph_hi;
    volatile LAS unsigned* MISC = (volatile LAS unsigned*)(F.lds + MISC_OFF);
    if (F.tid < 16) MISC[F.tid] = 0u;
    __syncthreads();
    XcdBarrier bar = xcd_barrier_post((unsigned*)(ws + WS_CTL), MISC);
    bf16* W_IN = (bf16*)(ws + WS_WIN); bf16* W_AB = (bf16*)(ws + WS_WAB); bf16* W_OUT = (bf16*)(ws + WS_WOUT); bf16* W_GU = (bf16*)(ws + WS_WGU); bf16* W_D = (bf16*)(ws + WS_WD); bf16* W_SP = (bf16*)(ws + WS_WSP);
    float* SSQA = (float*)(ws + WS_SSQA); float* SSQB = (float*)(ws + WS_SSQB);
    bf16* XN = (bf16*)(ws + WS_XN); bf16* AG = (bf16*)(ws + WS_AG); bf16* MG = (bf16*)(ws + WS_MG); bf16* PROJ = (bf16*)(ws + WS_PROJ);
    bf16* MIX = AG; bf16* FFO = MG; bf16* HB = PROJ; bf16* HN = XN; bf16* HB16 = (bf16*)(ws + WS_HB16);
#define IN(k) (lo <= (k) && (k) < hi)
    if (hi < 0) grid.sync();
#define SEAM(k) do { if (IN(k) && IN((k) + 1)) xcd_barrier(bar); else __syncthreads(); } while (0)

    if (IN(0)) { p0_prologue(F); }
    SEAM(0);
    if (IN(1)) { pg8::Gemm g{XN, W_IN, M, INW, D}; pg8::StaticOrder S; S.init(M, INW, F.G, F.bid); pg8::EpiProj E{PROJ};
        pg8::gemm_phase<pg8::EpiProj, pg8::StaticOrder, true, true>(F.lds, g, S, E); }
    SEAM(1);
    if (IN(2)) {
        for (int u = F.bid; u < BATCH * 16 * 2; u += F.G) attn_unit(F, PROJ, AG, F.in[3], u);
        for (int u = F.bid; u < BATCH * 16; u += F.G) gmlp_unit(F, PROJ, AG, F.in[4], F.in[5], W_SP, F.in[7], u);
    }
    SEAM(2);
    if (IN(3)) { pg8::Gemm g{AG, W_AB, M, D, D}; pg8::StaticOrder S; S.init(M, D, F.G, F.bid); pg8::EpiMerge E{PROJ, MG};
        pg8::gemm_phase<pg8::EpiMerge, pg8::StaticOrder, true, true>(F.lds, g, S, E); }
    SEAM(3);
    if (IN(4)) { pg8::Gemm g{MG, W_OUT, M, D, D}; pg8::StaticOrder S; S.init(M, D, F.G, F.bid); pg8::EpiSsq E{MIX, SSQA};
        pg8::gemm_phase<pg8::EpiSsq, pg8::StaticOrder, true, true>(F.lds, g, S, E); }
    SEAM(4);
    if (IN(5)) { const int gw = F.bid * NWAVES + F.wave, NGW = F.G * NWAVES;
        const float* RSTD = (const float*)(ws + WS_RSTD);
        for (int m = gw; m < M; m += NGW) e1_row(F.lane, HN + (size_t)m * D, RSTD[m], MIX + (size_t)m * D, SSQA + (size_t)m * 16, F.in[11], F.in[12], HB16 + (size_t)m * D); }
    SEAM(5);
    if (IN(6)) { pg8::Gemm g{HN, W_GU, M, 2 * FF, D}; pg8::StaticOrder S; S.init(M, 2 * FF, F.G, F.bid); pg8::EpiSwiglu E{HB};
        pg8::gemm_phase<pg8::EpiSwiglu, pg8::StaticOrder, true, true>(F.lds, g, S, E); }
    SEAM(6);
    if (IN(7)) { pg8::Gemm g{HB, W_D, M, D, FF}; pg8::StaticOrder S; S.init(M, D, F.G, F.bid); pg8::EpiSsq E{FFO, SSQB};
        pg8::gemm_phase<pg8::EpiSsq, pg8::StaticOrder, true, true>(F.lds, g, S, E); }
    SEAM(7);
    if (IN(8)) { const int gw = F.bid * NWAVES + F.wave, NGW = F.G * NWAVES;
        for (int m = gw; m < M; m += NGW) e2_row(F.lane, FFO + (size_t)m * D, SSQB + (size_t)m * 16, F.in[16], HB16 + (size_t)m * D, F.out + (size_t)m * D); }
#undef IN
#undef SEAM
}

extern "C" void kernel_launch(void* const* d_in, const int* in_sizes, int n_in, void* d_out, int out_size, void* d_ws, size_t ws_size, hipStream_t stream) {
    static int grid = 0;
    if (grid == 0) {
        if (n_in != 17 || out_size != M * D || ws_size < WS_END) { fprintf(stderr, "kernel_launch: unexpected problem: n_in %d out %d ws %zu\n", n_in, out_size, ws_size); grid = -1; return; }
        int dev = 0, cus = 0, per_cu = 0;
        (void)hipGetDevice(&dev); (void)hipDeviceGetAttribute(&cus, hipDeviceAttributeMultiprocessorCount, dev);
        if (hipFuncSetAttribute((const void*)fwd_megakernel, hipFuncAttributeMaxDynamicSharedMemorySize, LDS_BYTES) != hipSuccess) fprintf(stderr, "kernel_launch: hipFuncSetAttribute failed\n");
        if (hipOccupancyMaxActiveBlocksPerMultiprocessor(&per_cu, (const void*)fwd_megakernel, NTHR, LDS_BYTES) != hipSuccess || per_cu < 1) { fprintf(stderr, "kernel_launch: occupancy query says %d\n", per_cu); per_cu = 1; }
        (void)hipGetLastError();
        grid = cus * per_cu;
        fprintf(stderr, "kernel_launch: grid %d (cus %d x %d)\n", grid, cus, per_cu);
    }
    if (grid < 0) return;
    if (hipMemsetAsync((char*)d_ws + WS_CTL, 0, CTL_BYTES, stream) != hipSuccess) { fprintf(stderr, "kernel_launch: hipMemsetAsync failed\n"); return; }
    Args a{};
    for (int i = 0; i < 17; ++i) a.in[i] = (const float*)d_in[i];
    a.out = (float*)d_out; a.ws = (unsigned char*)d_ws;
#if MK_N_LAUNCHES == 1
    a.ph_lo = 0; a.ph_hi = N_PHASES;
    void* kargs[] = {&a};
    hipError_t e = hipLaunchCooperativeKernel((const void*)fwd_megakernel, dim3(grid), dim3(NTHR), kargs, LDS_BYTES, stream);
    if (e != hipSuccess) fprintf(stderr, "kernel_launch: cooperative launch failed: %s (grid %d)\n", hipGetErrorString(e), grid);
#else
    for (int k = 0; k < N_PHASES; ++k) { a.ph_lo = k; a.ph_hi = k + 1;
        hipLaunchKernelGGL(fwd_megakernel, dim3(grid), dim3(NTHR), LDS_BYTES, stream, a);
        const hipError_t le = hipPeekAtLastError(); if (le != hipSuccess) { fprintf(stderr, "kernel_launch: launch %d failed: %s\n", k, hipGetErrorName(le)); break; } }
#endif
}
```

```cpp
#include <hip/hip_runtime.h>
#include <hip/hip_cooperative_groups.h>
#include <cstdio>
#include <cstdint>
namespace cg = cooperative_groups;
#ifndef MK_N_LAUNCHES
#define MK_N_LAUNCHES 1
#endif
namespace pg8 {
#define PG8_LAS __attribute__((address_space(3)))
typedef unsigned short bf16_t;
typedef short bf16x8 __attribute__((ext_vector_type(8)));
typedef float f32x4 __attribute__((ext_vector_type(4)));
typedef unsigned u32x4 __attribute__((ext_vector_type(4)));
constexpr int BM = 256, BK = 64, HALF = 128, HTB = HALF * BK * 2  , STAGE_BYTES = 8 * HTB, NXCD = 8, WGM = 8;

__host__ __device__ __forceinline__ int lds_byte(int r, int c) { const int st = (r >> 4) * 2 + (c >> 5), rr = r & 15, cc = c & 31, ob = rr * 64 + cc * 2; return st * 1024 + (ob ^ (((ob >> 9) & 1) << 5)); }
__host__ __device__ __forceinline__ void stage_rc(int b, int& R, int& C) { const int st = b / 1024, sb = b % 1024, swz = sb ^ (((sb >> 9) & 1) << 5); R = (st >> 1) * 16 + swz / 64; C = (st & 1) * 32 + (swz % 64) / 2; }
__host__ __device__ __forceinline__ int perm32(int rho) { const int n = rho >> 4, i = rho & 15; return 8 * (i >> 2) + 4 * n + (i & 3); }

__device__ __forceinline__ int lane_id_opaque() { int l; asm volatile("v_mbcnt_lo_u32_b32 %0, -1, 0\n\tv_mbcnt_hi_u32_b32 %0, -1, %0" : "=v"(l)); return l; }
struct Unit { int pm, pn; };
struct Gemm { const bf16_t* A; const bf16_t* Bt; int M, N, K; };

struct StaticOrder {
    int nM, nN, nwg, G, c;
    __host__ __device__ void init(int M, int N, int G_, int c_) { nM = M / BM; nN = N / BM; nwg = nM * nN; G = G_; c = c_; }
    __host__ __device__ bool next(int i, Unit& u) const {
        const long L = (long)i * G + c; if (L >= nwg) return false;
        int wgid = (int)L; { const int q = nwg / NXCD, r = nwg % NXCD, xcd = wgid % NXCD, off = wgid / NXCD; wgid = (xcd < r ? xcd * (q + 1) : r * (q + 1) + (xcd - r) * q) + off; }
        const int nig = WGM * nN, gid = wgid / nig, fm = gid * WGM, gsz = (nM - fm) < WGM ? (nM - fm) : WGM;
        u.pm = fm + ((wgid % nig) % gsz); u.pn = (wgid % nig) / gsz; return true;
    }
    __device__ __forceinline__ void a_ready(const Unit&) const {}
    __device__ __forceinline__ void done(const Unit&) const {}
};

__device__ __forceinline__ unsigned cvt_pk_bf16(float lo, float hi) { unsigned r; asm volatile("v_cvt_pk_bf16_f32 %0, %1, %2" : "=v"(r) : "v"(lo), "v"(hi)); return r; }
typedef float f32x2 __attribute__((ext_vector_type(2)));
__device__ __forceinline__ f32x2 gelu_pk(f32x2 v) {
    const f32x2 av = __builtin_elementwise_abs(v), d = av * 0.2316418882f + 1.0f;
    f32x2 t; t.x = __builtin_amdgcn_rcpf(d.x); t.y = __builtin_amdgcn_rcpf(d.y);
    f32x2 q = t * 0.5307027145f + (-0.7265760135f); q = q * t + 0.7107068705f; q = q * t + (-0.142248368f); q = q * t + 0.127414796f; q = q * t;
    const f32x2 s = (v * v) * (-0.72134752044f);
    f32x2 e; e.x = __builtin_amdgcn_exp2f(s.x); e.y = __builtin_amdgcn_exp2f(s.y);
    const f32x2 m = v * (q * e), r = v - m;
    f32x2 o; o.x = v.x < 0.f ? m.x : r.x; o.y = v.y < 0.f ? m.y : r.y; return o;
}
typedef __bf16 bf16x2_t __attribute__((ext_vector_type(2)));
__device__ __forceinline__ unsigned cvtpk(float lo, float hi) { f32x2 v = {lo, hi}; bf16x2_t b = __builtin_convertvector(v, bf16x2_t); return __builtin_bit_cast(unsigned, b); }
__device__ __forceinline__ float bflo(unsigned u) { return __uint_as_float(u << 16); }
__device__ __forceinline__ float bfhi(unsigned u) { return __uint_as_float(u & 0xffff0000u); }
__device__ __forceinline__ float sigm(float x) { return __builtin_amdgcn_rcpf(1.0f + __builtin_amdgcn_exp2f(-1.4426950408889634f * x)); }
__device__ __forceinline__ u32x4 pack8(f32x4 v0, f32x4 v1) { u32x4 w; w.x = cvtpk(v0[0], v0[1]); w.y = cvtpk(v0[2], v0[3]); w.z = cvtpk(v1[0], v1[1]); w.w = cvtpk(v1[2], v1[3]); return w; }
constexpr int PROJ_LD = 3840;
constexpr float QSCALE = 0.125f * 1.4426950408889634f;

struct EpiProj {
    static constexpr bool PERM = true, AFTER_DRAIN = false, MID = false; static constexpr int NST = 14;
    bf16_t* O;
    __device__ __forceinline__ void mid(f32x4 (&)[2][2][4][2], const Unit&, int, int, int, int) const {}
    __device__ __forceinline__ void operator()(const f32x4 (&acc)[2][2][4][2], const Unit& u, int wr, int wc, int fr, int fq) const {
        { const int l_ = lane_id_opaque(); fr = l_ & 15; fq = l_ >> 4; }
        const int row0 = u.pm * BM + wr * 64 + fr, col0 = u.pn * BM + wc * 32 + 8 * fq;
        const int mode = u.pn < 3 ? 0 : (u.pn < 7 ? 1 : 2); const float sc = u.pn < 2 ? QSCALE : 1.0f;
#pragma unroll
        for (int ai = 0; ai < 2; ++ai)
#pragma unroll
            for (int m = 0; m < 4; ++m) { bf16_t* rowp = O + (size_t)(row0 + ai * HALF + m * 16) * PROJ_LD + col0;
#pragma unroll
                for (int bj = 0; bj < 2; ++bj) { f32x4 v0 = acc[ai][bj][m][0], v1 = acc[ai][bj][m][1];
                    if (mode == 1) { f32x2 a = gelu_pk((f32x2){v0[0], v0[1]}), b = gelu_pk((f32x2){v0[2], v0[3]}), c = gelu_pk((f32x2){v1[0], v1[1]}), d = gelu_pk((f32x2){v1[2], v1[3]});
                        v0 = (f32x4){a.x, a.y, b.x, b.y}; v1 = (f32x4){c.x, c.y, d.x, d.y}; }
                    else if (mode == 2) { v0 = (f32x4){sigm(v0[0]), sigm(v0[1]), sigm(v0[2]), sigm(v0[3])}; v1 = (f32x4){sigm(v1[0]), sigm(v1[1]), sigm(v1[2]), sigm(v1[3])}; }
                    else { v0 = v0 * sc; v1 = v1 * sc; }
                    *(u32x4*)(rowp + bj * HALF) = pack8(v0, v1); } }
    }
};
struct EpiMerge {
    static constexpr bool PERM = true, AFTER_DRAIN = false, MID = true; static constexpr int NST = 14;
    const bf16_t* P; bf16_t* O;
    __device__ __forceinline__ void mid(f32x4 (&acc)[2][2][4][2], const Unit& u, int wr, int wc, int fr, int fq) const {
        { const int l_ = lane_id_opaque(); fr = l_ & 15; fq = l_ >> 4; }
        const int row0 = u.pm * BM + wr * 64 + fr, col0 = u.pn * BM + wc * 32 + 8 * fq;
#pragma unroll
        for (int ai = 0; ai < 2; ++ai)
#pragma unroll
            for (int m = 0; m < 4; ++m) { const bf16_t* rowp = P + (size_t)(row0 + ai * HALF + m * 16) * PROJ_LD + col0;
#pragma unroll
                for (int bj = 0; bj < 2; ++bj) { const u32x4 a = *(const u32x4*)(rowp + 1792 + bj * HALF), b = *(const u32x4*)(rowp + 2816 + bj * HALF);
                    f32x4 r0, r1;
                    r0[0] = bflo(a.x) * __builtin_amdgcn_rcpf(bflo(b.x)); r0[1] = bfhi(a.x) * __builtin_amdgcn_rcpf(bfhi(b.x)); r0[2] = bflo(a.y) * __builtin_amdgcn_rcpf(bflo(b.y)); r0[3] = bfhi(a.y) * __builtin_amdgcn_rcpf(bfhi(b.y));
                    r1[0] = bflo(a.z) * __builtin_amdgcn_rcpf(bflo(b.z)); r1[1] = bfhi(a.z) * __builtin_amdgcn_rcpf(bfhi(b.z)); r1[2] = bflo(a.w) * __builtin_amdgcn_rcpf(bflo(b.w)); r1[3] = bfhi(a.w) * __builtin_amdgcn_rcpf(bfhi(b.w));
                    acc[ai][bj][m][0] *= r0; acc[ai][bj][m][1] *= r1; }
                if (m & 1) asm volatile("" ::: "memory"); }
    }
    __device__ __forceinline__ void operator()(const f32x4 (&acc)[2][2][4][2], const Unit& u, int wr, int wc, int fr, int fq) const {
        { const int l_ = lane_id_opaque(); fr = l_ & 15; fq = l_ >> 4; }
        const int row0 = u.pm * BM + wr * 64 + fr, col0 = u.pn * BM + wc * 32 + 8 * fq;
#pragma unroll
        for (int ai = 0; ai < 2; ++ai)
#pragma unroll
            for (int m = 0; m < 4; ++m) { const size_t row = (size_t)(row0 + ai * HALF + m * 16); const bf16_t* rowp = P + row * PROJ_LD + col0;
#pragma unroll
                for (int bj = 0; bj < 2; ++bj) { const u32x4 b = *(const u32x4*)(rowp + 2816 + bj * HALF);
                    const f32x4 s0 = {bflo(b.x), bfhi(b.x), bflo(b.y), bfhi(b.y)}, s1 = {bflo(b.z), bfhi(b.z), bflo(b.w), bfhi(b.w)};
                    *(u32x4*)(O + row * 1024 + col0 + bj * HALF) = pack8(acc[ai][bj][m][0] * s0, acc[ai][bj][m][1] * s1); }
                asm volatile("" ::: "memory"); }
    }
};
struct EpiSsq {
    static constexpr bool PERM = true, AFTER_DRAIN = false, MID = false; static constexpr int NST = 20;
    bf16_t* O; float* ssq;
    __device__ __forceinline__ void mid(f32x4 (&)[2][2][4][2], const Unit&, int, int, int, int) const {}
    __device__ __forceinline__ void operator()(const f32x4 (&acc)[2][2][4][2], const Unit& u, int wr, int wc, int fr, int fq) const {
        { const int l_ = lane_id_opaque(); fr = l_ & 15; fq = l_ >> 4; }
        const int row0 = u.pm * BM + wr * 64 + fr, col0 = u.pn * BM + wc * 32 + 8 * fq;
#pragma unroll
        for (int ai = 0; ai < 2; ++ai)
#pragma unroll
            for (int m = 0; m < 4; ++m) { const size_t row = (size_t)(row0 + ai * HALF + m * 16); float s = 0.f;
#pragma unroll
                for (int bj = 0; bj < 2; ++bj) { const f32x4 v0 = acc[ai][bj][m][0], v1 = acc[ai][bj][m][1];
                    s += (v0[0] * v0[0] + v0[1] * v0[1]) + (v0[2] * v0[2] + v0[3] * v0[3]) + (v1[0] * v1[0] + v1[1] * v1[1]) + (v1[2] * v1[2] + v1[3] * v1[3]);
                    *(u32x4*)(O + row * 1024 + col0 + bj * HALF) = pack8(v0, v1); }
                s += __shfl_xor(s, 16); s += __shfl_xor(s, 32);
                if (fq == 0) ssq[row * 16 + u.pn * 4 + wc] = s; }
    }
};
struct EpiSwiglu {
    static constexpr bool PERM = true, AFTER_DRAIN = false, MID = false; static constexpr int NST = 7;
    bf16_t* O;
    __device__ __forceinline__ void mid(f32x4 (&)[2][2][4][2], const Unit&, int, int, int, int) const {}
    __device__ __forceinline__ void operator()(const f32x4 (&acc)[2][2][4][2], const Unit& u, int wr, int wc, int fr, int fq) const {
        { const int l_ = lane_id_opaque(); fr = l_ & 15; fq = l_ >> 4; }
        const int row0 = u.pm * BM + wr * 64 + fr, col0 = u.pn * HALF + wc * 32 + 8 * fq;
#pragma unroll
        for (int ai = 0; ai < 2; ++ai)
#pragma unroll
            for (int m = 0; m < 4; ++m) { const size_t row = (size_t)(row0 + ai * HALF + m * 16);
                const f32x4 g0 = acc[ai][0][m][0], g1 = acc[ai][0][m][1], u0 = acc[ai][1][m][0], u1 = acc[ai][1][m][1];
                f32x4 h0, h1;
#pragma unroll
                for (int e = 0; e < 4; ++e) { h0[e] = g0[e] * sigm(g0[e]) * u0[e]; h1[e] = g1[e] * sigm(g1[e]) * u1[e]; }
                *(u32x4*)(O + row * 2816 + col0) = pack8(h0, h1); }
    }
};
template <class Epi, class Sched, bool ALIGN_EPI = false, bool SP2 = false>
__device__ __forceinline__ void gemm_phase(PG8_LAS unsigned char* lds, const Gemm g, const Sched& S, const Epi& E, int wid) {
    const int lane = lane_id_opaque(), tid = wid * 64 + lane, wr = wid >> 2, wc = wid & 3, fr = lane & 15, fq = lane >> 4;
    const int K = g.K, nt = K / BK;
    unsigned voffA[2], voffB[2];
#pragma unroll
    for (int i = 0; i < 2; ++i) { int R, C; stage_rc(tid * 16 + i * 8192, R, C); const int Rb = Epi::PERM ? ((R & ~31) + perm32(R & 31)) : R;
        voffA[i] = (unsigned)(R * K + C) * 2u; voffB[i] = (unsigned)(Rb * K + C) * 2u; }
    const size_t kstep = (size_t)(BK * 2);
    const size_t hstep = (size_t)HALF * K * 2;
    const size_t tstep = 2 * hstep;
    const unsigned ldsw = (unsigned)wid * 1024u;
    const int aoff = lds_byte(wr * 64 + fr, fq * 8), boff = lds_byte(wc * 32 + fr, fq * 8);
#define PG8_SA(b, h) (((b) * 2 + (h)) * HTB)
#define PG8_SB(b, h) ((4 + (b) * 2 + (h)) * HTB)
#define PG8_STAGE(bufoff, gbase, voff) do { _Pragma("unroll") for (int _i = 0; _i < 2; ++_i) \
        __builtin_amdgcn_global_load_lds((const unsigned*)((const char*)(gbase) + (voff)[_i]), (PG8_LAS unsigned*)(lds + (bufoff) + ldsw + _i * 8192), 16, 0, 0); } while (0)
#define PG8_LDA(dst, b, h) do { _Pragma("unroll") for (int m = 0; m < 4; ++m) _Pragma("unroll") for (int k = 0; k < 2; ++k) dst[m][k] = *(const PG8_LAS bf16x8*)(lds + PG8_SA(b, h) + aoff + m * 2048 + k * 1024); } while (0)
#define PG8_LDB(dst, b, h) do { _Pragma("unroll") for (int n = 0; n < 2; ++n) _Pragma("unroll") for (int k = 0; k < 2; ++k) dst[n][k] = *(const PG8_LAS bf16x8*)(lds + PG8_SB(b, h) + boff + n * 2048 + k * 1024); } while (0)
#define PG8_MMA(ai, bj, At, Bt) do { __builtin_amdgcn_s_setprio(1); _Pragma("unroll") for (int m = 0; m < 4; ++m) _Pragma("unroll") for (int n = 0; n < 2; ++n) _Pragma("unroll") for (int k = 0; k < 2; ++k) \
        acc[ai][bj][m][n] = __builtin_amdgcn_mfma_f32_16x16x32_bf16(Bt[n][k], At[m][k], acc[ai][bj][m][n], 0, 0, 0); __builtin_amdgcn_s_setprio(0); } while (0)
#define PG8_WAIT_V(n) asm volatile("s_waitcnt vmcnt(" #n ")" ::: "memory")
#define PG8_WAIT_L(n) asm volatile("s_waitcnt lgkmcnt(" #n ")" ::: "memory")
#define PG8_WAIT_RLXC() PG8_WAIT_V(8)
#define PG8_BAR __builtin_amdgcn_s_barrier()
#define PG8_SCHED __builtin_amdgcn_sched_barrier(0)
    Unit cur, nxt; int ui = 0;
    if (!S.next(0, cur)) return;
    f32x4 acc[2][2][4][2];
#pragma unroll
    for (int a = 0; a < 2; ++a)
#pragma unroll
        for (int b = 0; b < 2; ++b)
#pragma unroll
            for (int m = 0; m < 4; ++m)
#pragma unroll
                for (int n = 0; n < 2; ++n) acc[a][b][m][n] = (f32x4){0.f, 0.f, 0.f, 0.f};
    bf16x8 At[4][2], B0[2][2], B1[2][2];
    const char* cA = (const char*)g.A + (size_t)cur.pm * tstep; const char* cB = (const char*)g.Bt + (size_t)cur.pn * tstep;
    S.a_ready(cur);
    if constexpr (SP2) {
        PG8_STAGE(PG8_SB(0, 0), cB, voffB); PG8_STAGE(PG8_SB(0, 1), cB + hstep, voffB); PG8_STAGE(PG8_SA(0, 0), cA, voffA); PG8_STAGE(PG8_SA(0, 1), cA + hstep, voffA);
        if (wr == 1) PG8_BAR;
        PG8_WAIT_V(2); PG8_BAR;
        PG8_STAGE(PG8_SB(1, 0), cB + kstep, voffB); PG8_STAGE(PG8_SA(1, 0), cA + kstep, voffA); PG8_STAGE(PG8_SB(1, 1), cB + hstep + kstep, voffB);
        PG8_WAIT_V(0); PG8_BAR;
    } else {
        PG8_STAGE(PG8_SB(0, 0), cB, voffB); PG8_STAGE(PG8_SA(0, 0), cA, voffA); PG8_STAGE(PG8_SB(0, 1), cB + hstep, voffB); PG8_STAGE(PG8_SA(0, 1), cA + hstep, voffA);
        if (wr == 1) PG8_BAR;
        PG8_WAIT_V(4); PG8_BAR;
        PG8_STAGE(PG8_SB(1, 0), cB + kstep, voffB); PG8_STAGE(PG8_SA(1, 0), cA + kstep, voffA); PG8_STAGE(PG8_SB(1, 1), cB + hstep + kstep, voffB);
        PG8_WAIT_V(6); PG8_BAR;
    }
    for (;;) {
        const bool has_next = S.next(ui + 1, nxt);
        const char* nA = has_next ? (const char*)g.A + (size_t)nxt.pm * tstep : cA; const char* nB = has_next ? (const char*)g.Bt + (size_t)nxt.pn * tstep : cB;
#define PG8_ITER(T, WAITV) do { const int t = (T); \
            const bool last = (t == nt - 2); \
            if constexpr (Epi::MID) { if (t == (nt >> 1)) E.mid(acc, cur, wr, wc, fr, fq); } \
            const char* a1 = cA + (size_t)(t + 1) * kstep; \
            const char* a2 = last ? nA : cA + (size_t)(t + 2) * kstep; const char* b2 = last ? nB : cB + (size_t)(t + 2) * kstep; \
            const char* a3 = a2 + kstep; const char* b3 = b2 + kstep; \
            if (last && has_next) S.a_ready(nxt); \
              \
            PG8_LDB(B0, 0, 0); PG8_LDB(B1, 0, 1); PG8_SCHED; PG8_LDA(At, 0, 0); PG8_STAGE(PG8_SA(1, 1), a1 + hstep, voffA); \
            WAITV; PG8_WAIT_L(0); PG8_BAR; PG8_MMA(0, 0, At, B0); PG8_MMA(0, 1, At, B1); PG8_BAR; PG8_SCHED; \
              \
            PG8_LDA(At, 0, 1); PG8_STAGE(PG8_SB(0, 0), b2, voffB); PG8_STAGE(PG8_SB(0, 1), b2 + hstep, voffB); PG8_STAGE(PG8_SA(0, 0), a2, voffA); \
            WAITV; PG8_WAIT_L(0); PG8_BAR; PG8_MMA(1, 0, At, B0); PG8_MMA(1, 1, At, B1); PG8_BAR; PG8_SCHED; \
              \
            PG8_LDB(B0, 1, 0); PG8_LDB(B1, 1, 1); PG8_SCHED; PG8_LDA(At, 1, 0); PG8_STAGE(PG8_SA(0, 1), a2 + hstep, voffA); \
            PG8_WAIT_V(8); PG8_WAIT_L(0); PG8_BAR; PG8_MMA(0, 0, At, B0); PG8_MMA(0, 1, At, B1); PG8_BAR; PG8_SCHED; \
              \
            PG8_LDA(At, 1, 1); PG8_STAGE(PG8_SB(1, 0), b3, voffB); PG8_STAGE(PG8_SB(1, 1), b3 + hstep, voffB); PG8_STAGE(PG8_SA(1, 0), a3, voffA); \
            PG8_WAIT_V(8); PG8_WAIT_L(0); PG8_BAR; PG8_MMA(1, 0, At, B0); PG8_MMA(1, 1, At, B1); PG8_BAR; PG8_SCHED; } while (0)
        static_assert(SP2, "only the SP2 loop is kept");
        PG8_ITER(0, PG8_WAIT_RLXC());
        for (int tt = 2; tt < nt; tt += 2) { PG8_ITER(tt, PG8_WAIT_V(8)); }
        if constexpr (ALIGN_EPI) { if (wr == 0) PG8_BAR; }
        if constexpr (!Epi::AFTER_DRAIN) { E(acc, cur, wr, wc, fr, fq); S.done(cur); }
        if (!has_next) break;
#pragma unroll
        for (int a = 0; a < 2; ++a)
#pragma unroll
            for (int b = 0; b < 2; ++b)
#pragma unroll
                for (int m = 0; m < 4; ++m)
#pragma unroll
                    for (int n = 0; n < 2; ++n) acc[a][b][m][n] = (f32x4){0.f, 0.f, 0.f, 0.f};
        cur = nxt; cA = nA; cB = nB; ++ui;
        if constexpr (ALIGN_EPI) { if (wr == 1) PG8_BAR; }
    }
    PG8_WAIT_V(0);
    if constexpr (!ALIGN_EPI) { if (wr == 0) PG8_BAR; }
    PG8_BAR;
    if constexpr (Epi::AFTER_DRAIN) { E.fused(acc, cur, wr, wc, fr, fq, lds, wid, lane); S.done(cur); }
#undef PG8_SA
#undef PG8_SB
#undef PG8_STAGE
#undef PG8_LDA
#undef PG8_LDB
#undef PG8_MMA
#undef PG8_WAIT_V
#undef PG8_WAIT_L
#undef PG8_WAIT_RLXC
#undef PG8_ITER
#undef PG8_BAR
#undef PG8_SCHED
}
}

constexpr int NWAVES = 8, NTHR = 512;
constexpr int BATCH = 32, SEQ = 2048, D = 1024, M = BATCH * SEQ;
constexpr int INW = 3840, FF = 2816;
constexpr int C_K = 512, C_V = 640, C_U = 768, C_VG = 1280;
constexpr float EPS = 1e-6f, LN_EPS = 1e-5f, LOG2E = 1.4426950408889634f;
constexpr size_t MiB = 1u << 20;
constexpr size_t WS_WIN = 0;
constexpr size_t WS_WAB = 8 * MiB;
constexpr size_t WS_WOUT = 10 * MiB;
constexpr size_t WS_WGU = 12 * MiB;
constexpr size_t WS_WD = 24 * MiB;
constexpr size_t WS_WSP = 30 * MiB;
constexpr size_t WS_CTL = 31 * MiB + 512 * 1024;
constexpr int CTL_BYTES = 16384, MISC_OFF = 147456 - 64;
constexpr size_t WS_RSTD = 31 * MiB;
constexpr size_t WS_SSQA = 32 * MiB;
constexpr size_t WS_SSQB = 36 * MiB;
constexpr size_t WS_XN = 40 * MiB;
constexpr size_t WS_AG = 168 * MiB;
constexpr size_t WS_MG = 296 * MiB;
constexpr size_t WS_PROJ = 424 * MiB;
constexpr size_t WS_HB16 = WS_PROJ + 352 * MiB;
constexpr size_t WS_END = 904 * MiB;
constexpr int LDS_BYTES = 147456;

#define GAS __attribute__((address_space(1)))
#define LAS __attribute__((address_space(3)))
typedef unsigned short bf16;
typedef unsigned v4u __attribute__((ext_vector_type(4)));
typedef unsigned v2u __attribute__((ext_vector_type(2)));
typedef float f32x4 __attribute__((ext_vector_type(4)));
typedef float f32x16 __attribute__((ext_vector_type(16)));
typedef short bf16x8 __attribute__((ext_vector_type(8)));
typedef short s16x4 __attribute__((ext_vector_type(4)));
using pg8::cvtpk; using pg8::bflo; using pg8::bfhi;
#define LDS_WAIT() asm volatile("s_waitcnt lgkmcnt(0)" ::: "memory")
__device__ __forceinline__ unsigned short f2bf(float f) { return (unsigned short)(cvtpk(f, 0.f) & 0xffffu); }
__device__ __forceinline__ float bf2f(unsigned short h) { return __uint_as_float((unsigned)h << 16); }
__device__ __forceinline__ float wave_sum(float v) {
#pragma unroll
    for (int o = 1; o < 64; o <<= 1) v += __shfl_xor(v, o);
    return v;
}
__device__ __forceinline__ int crow(int r, int hi) { return (r & 3) + 8 * (r >> 2) + 4 * hi; }

struct Frame {
    LAS unsigned char* lds;
    int tid, lane, wave, G, bid;
    const float* in[17]; float* out; unsigned char* ws;
};
__device__ __forceinline__ int rowmap(int mode, int n) { return mode == 0 ? n : (((n >> 7) << 8) + (n & 127) + (mode == 2 ? 128 : 0)); }
__device__ __forceinline__ void p0_transpose_item(const float* W, int N, bf16* WT, int ldk, int koff, int mode, LAS float* scr, int item, int lane, const float* kscale = nullptr) {
    const int nblk = N / 32, kb = item / nblk, nb = item % nblk, k0 = 64 * kb, n0 = 32 * nb;
#pragma unroll 8
    for (int i = 0; i < 32; ++i) { const int kk = 2 * i + (lane >> 5); float w = W[(size_t)(k0 + kk) * N + n0 + (lane & 31)]; if (kscale) w *= kscale[k0 + kk]; scr[kk * 33 + (lane & 31)] = w; }
    LDS_WAIT(); asm volatile("" ::: "memory");
    const int c = lane & 7;
#pragma unroll
    for (int j = 0; j < 4; ++j) { const int n = (lane >> 3) + 8 * j; const LAS float* s = scr + (8 * c) * 33 + n;
        v4u o; o.x = cvtpk(s[0 * 33], s[1 * 33]); o.y = cvtpk(s[2 * 33], s[3 * 33]); o.z = cvtpk(s[4 * 33], s[5 * 33]); o.w = cvtpk(s[6 * 33], s[7 * 33]);
        *(GAS v4u*)(WT + (size_t)rowmap(mode, n0 + n) * ldk + koff + k0 + 8 * c) = o; }
    LDS_WAIT(); asm volatile("" ::: "memory");
}
__device__ __forceinline__ void rms_row_to_bf16(int lane, const float* xrow, float* rstd_out, bf16* orow) {
    const GAS f32x4* xr = (const GAS f32x4*)xrow + lane;
    f32x4 v[4]; float s = 0.f;
#pragma unroll
    for (int j = 0; j < 4; ++j) { v[j] = xr[64 * j]; s += (v[j].x * v[j].x + v[j].y * v[j].y) + (v[j].z * v[j].z + v[j].w * v[j].w); }
    const float rstd = 1.0f / sqrtf(wave_sum(s) * (1.f / D) + EPS);
    if (lane == 0) *rstd_out = rstd;
    GAS v2u* o8 = (GAS v2u*)orow + lane;
#pragma unroll
    for (int j = 0; j < 4; ++j) { v2u w; w.x = cvtpk(v[j].x * rstd, v[j].y * rstd); w.y = cvtpk(v[j].z * rstd, v[j].w * rstd); o8[64 * j] = w; }
}
__device__ __forceinline__ void p0_prologue(Frame& F) {
    LAS float* scr = (LAS float*)(F.lds + F.wave * 16384);
    const int gw = F.bid * NWAVES + F.wave, NGW = F.G * NWAVES;
    unsigned char* ws = F.ws;
    constexpr int I_IN = (1024 / 64) * (INW / 32), I_A = (512 / 64) * (1024 / 32), I_O = (1024 / 64) * (1024 / 32), I_G = (1024 / 64) * (FF / 32), I_D = (FF / 64) * (1024 / 32);
    constexpr int NITEMS = I_IN + 2 * I_A + I_O + 2 * I_G + I_D;
    for (int it = gw; it < NITEMS; it += NGW) {
        int r = it;
        if (r < I_IN) { p0_transpose_item(F.in[2], INW, (bf16*)(ws + WS_WIN), 1024, 0, 0, scr, r, F.lane, F.in[1]); continue; } r -= I_IN;
        if (r < I_A) { p0_transpose_item(F.in[8], 1024, (bf16*)(ws + WS_WAB), 1024, 0, 0, scr, r, F.lane); continue; } r -= I_A;
        if (r < I_A) { p0_transpose_item(F.in[9], 1024, (bf16*)(ws + WS_WAB), 1024, 512, 0, scr, r, F.lane); continue; } r -= I_A;
        if (r < I_O) { p0_transpose_item(F.in[10], 1024, (bf16*)(ws + WS_WOUT), 1024, 0, 0, scr, r, F.lane); continue; } r -= I_O;
        if (r < I_G) { p0_transpose_item(F.in[13], FF, (bf16*)(ws + WS_WGU), 1024, 0, 1, scr, r, F.lane); continue; } r -= I_G;
        if (r < I_G) { p0_transpose_item(F.in[14], FF, (bf16*)(ws + WS_WGU), 1024, 0, 2, scr, r, F.lane); continue; } r -= I_G;
        p0_transpose_item(F.in[15], 1024, (bf16*)(ws + WS_WD), FF, 0, 0, scr, r, F.lane);
    }
    { const float* wsrc = F.in[6]; bf16* wdst = (bf16*)(ws + WS_WSP);
      for (int i = gw * 64 + F.lane; i < 4 * 128 * 128; i += NGW * 64) { const int t = (i >> 7) & 127, s = i & 127; wdst[i] = f2bf(s <= t ? wsrc[i] : 0.f); } }
    bf16* XN = (bf16*)(ws + WS_XN);
    float* RSTD = (float*)(ws + WS_RSTD);
    for (int m = gw; m < M; m += NGW) rms_row_to_bf16(F.lane, F.in[0] + (size_t)m * D, RSTD + m, XN + (size_t)m * D);
}
constexpr int KS_ROW = 144, VT_ROW = 260  , KS_BYTES = 256 * KS_ROW;
__device__ __forceinline__ void attn_unit(Frame& F, const bf16* PROJ, bf16* AG, const float* sinks, int unit) {
    const int tid = F.tid, lane = F.lane, wave = F.wave, lq = lane & 31, hi = lane >> 5;
    const int kvh = unit & 1, n = (unit >> 1) & 15, b = unit >> 5;
    const long T0 = (long)b * SEQ + n * 128;
    LAS unsigned char* Ks = F.lds; LAS unsigned short* VT = (LAS unsigned short*)(F.lds + KS_BYTES);
    const int jstart = (n == 0) ? 128 : 0;
#pragma unroll
    for (int it = 0; it < 4; ++it) { const int id = it * NTHR + tid, key = id >> 3, ch = id & 7;
        if (key >= jstart) { const bf16* src = PROJ + (T0 - 128 + key) * INW + C_K + kvh * 64 + ch * 8;
            const v4u kv = *(const GAS v4u*)src, vv = *(const GAS v4u*)(src + 128);
            *(LAS v4u*)(Ks + key * KS_ROW + ch * 16) = kv;
            LAS unsigned short* vt = VT + (ch * 8) * VT_ROW + key;
            vt[0 * VT_ROW] = (unsigned short)(vv.x & 0xffffu); vt[1 * VT_ROW] = (unsigned short)(vv.x >> 16);
            vt[2 * VT_ROW] = (unsigned short)(vv.y & 0xffffu); vt[3 * VT_ROW] = (unsigned short)(vv.y >> 16);
            vt[4 * VT_ROW] = (unsigned short)(vv.z & 0xffffu); vt[5 * VT_ROW] = (unsigned short)(vv.z >> 16);
            vt[6 * VT_ROW] = (unsigned short)(vv.w & 0xffffu); vt[7 * VT_ROW] = (unsigned short)(vv.w >> 16); } }
    __syncthreads();
#pragma unroll 1
    for (int pass = 0; pass < 2; ++pass) {
        int lqo = lq; asm volatile("" : "+v"(lqo));
        const int g = pass * 2 + (wave >> 2), wq = wave & 3, hq = kvh * 4 + g;
        const float slope2 = __builtin_amdgcn_exp2f(-(float)(hq + 1)) * LOG2E, sink2 = sinks[hq] * LOG2E;
        const bf16* qp = PROJ + (T0 + 32 * wq + lq) * INW + hq * 64 + 8 * hi;
        bf16x8 qf[4];
#pragma unroll
        for (int ds = 0; ds < 4; ++ds) qf[ds] = *(const GAS bf16x8*)(qp + 16 * ds);
        f32x16 S[5];
#pragma unroll
        for (int i = 0; i < 5; ++i) { const int kt = wq + i; const bool skip = (n == 0 && kt < 4);
#pragma unroll
            for (int r = 0; r < 16; ++r) S[i][r] = 0.f;
            if (!skip) {
#pragma unroll
                for (int ds = 0; ds < 4; ++ds) { const bf16x8 kf = *(const LAS bf16x8*)(Ks + (32 * kt + lq) * KS_ROW + (16 * ds + 8 * hi) * 2);
                    S[i] = __builtin_amdgcn_mfma_f32_32x32x16_bf16(kf, qf[ds], S[i], 0, 0, 0); } }
            __builtin_amdgcn_sched_barrier(0); }
        float mx = sink2;
#pragma unroll
        for (int i = 0; i < 5; ++i) { const bool skip = (n == 0 && wq + i < 4);
#pragma unroll
            for (int r = 0; r < 16; ++r) { const int rel = 128 - 32 * i + lqo - crow(r, hi);
                const bool valid = !skip && (i == 0 ? rel <= 127 : (i == 4 ? rel >= 0 : true));
                const float lg = valid ? S[i][r] - slope2 * (float)rel : -1e30f; S[i][r] = lg; mx = fmaxf(mx, lg); } }
        mx = fmaxf(mx, __shfl_xor(mx, 32));
        float sum = 0.f;
#pragma unroll
        for (int i = 0; i < 5; ++i)
#pragma unroll
            for (int r = 0; r < 16; ++r) { const float p = __builtin_amdgcn_exp2f(S[i][r] - mx); S[i][r] = p; sum += p; }
        sum += __shfl_xor(sum, 32); sum += __builtin_amdgcn_exp2f(sink2 - mx);
        const float inv = 1.0f / sum;
        f32x16 O[2];
#pragma unroll
        for (int r = 0; r < 16; ++r) { O[0][r] = 0.f; O[1][r] = 0.f; }
#pragma unroll
        for (int i = 0; i < 5; ++i) { const int kt = wq + i; const bool skip = (n == 0 && kt < 4);
            if (!skip) {
#pragma unroll
                for (int s = 0; s < 2; ++s) {
                    v4u pw; pw.x = cvtpk(S[i][8 * s + 0], S[i][8 * s + 1]); pw.y = cvtpk(S[i][8 * s + 2], S[i][8 * s + 3]); pw.z = cvtpk(S[i][8 * s + 4], S[i][8 * s + 5]); pw.w = cvtpk(S[i][8 * s + 6], S[i][8 * s + 7]);
                    const bf16x8 pf = __builtin_bit_cast(bf16x8, pw);
#pragma unroll
                    for (int dt = 0; dt < 2; ++dt) { const LAS unsigned short* vp = VT + (32 * dt + lq) * VT_ROW + 32 * kt + 16 * s + 4 * hi;
                        const s16x4 lo = *(const LAS s16x4*)vp, h8 = *(const LAS s16x4*)(vp + 8);
                        const bf16x8 vf = __builtin_shufflevector(lo, h8, 0, 1, 2, 3, 4, 5, 6, 7);
                        O[dt] = __builtin_amdgcn_mfma_f32_32x32x16_bf16(vf, pf, O[dt], 0, 0, 0); } } }
            __builtin_amdgcn_sched_barrier(0); }
        bf16* op = AG + (T0 + 32 * wq + lq) * 1024 + hq * 64 + 4 * hi;
#pragma unroll
        for (int dt = 0; dt < 2; ++dt)
#pragma unroll
            for (int j = 0; j < 4; ++j) { v2u w; w.x = cvtpk(O[dt][4 * j] * inv, O[dt][4 * j + 1] * inv); w.y = cvtpk(O[dt][4 * j + 2] * inv, O[dt][4 * j + 3] * inv);
                *(GAS v2u*)(op + 32 * dt + 8 * j) = w; }
    }
    __syncthreads();
}
constexpr int GV_ROW = 132;
__device__ __forceinline__ void gmlp_unit(Frame& F, const bf16* PROJ, bf16* AG, const float* ln_g, const float* ln_b, const bf16* WSP, const float* b_s, int unit) {
    const int lane = F.lane, wave = F.wave, lq = lane & 31, hi = lane >> 5;
    const int n = unit & 15, b = unit >> 4; const long T0 = (long)b * SEQ + n * 128;
    LAS unsigned short* VT = (LAS unsigned short*)F.lds;
    float gch[8], bch[8];
#pragma unroll
    for (int i = 0; i < 8; ++i) { gch[i] = ln_g[lane + 64 * i]; bch[i] = ln_b[lane + 64 * i]; }
#pragma unroll 1
    for (int hb = 0; hb < 2; ++hb) {
        unsigned short raw[8][8];
#pragma unroll
        for (int tk = 0; tk < 8; ++tk) { const bf16* vp = PROJ + (T0 + 16 * wave + 8 * hb + tk) * INW + C_VG + lane;
#pragma unroll
            for (int i = 0; i < 8; ++i) raw[tk][i] = vp[64 * i]; }
#pragma unroll
        for (int tk = 0; tk < 8; ++tk) { const int s = 16 * wave + 8 * hb + tk;
            float x[8]; float sm = 0.f;
#pragma unroll
            for (int i = 0; i < 8; ++i) { x[i] = bf2f(raw[tk][i]); sm += x[i]; }
            const float mean = wave_sum(sm) * (1.f / 512.f); float q = 0.f;
#pragma unroll
            for (int i = 0; i < 8; ++i) { x[i] -= mean; q += x[i] * x[i]; }
            const float rstd = 1.0f / sqrtf(wave_sum(q) * (1.f / 512.f) + LN_EPS);
#pragma unroll
            for (int i = 0; i < 8; ++i) VT[(lane + 64 * i) * GV_ROW + s] = f2bf(x[i] * rstd * gch[i] + bch[i]); } }
    __syncthreads();
    const int g = wave >> 1, cb = g * 128 + 64 * (wave & 1);
    f32x16 acc[2][4];
#pragma unroll
    for (int mt = 0; mt < 2; ++mt)
#pragma unroll
        for (int nt = 0; nt < 4; ++nt)
#pragma unroll
            for (int r = 0; r < 16; ++r) acc[mt][nt][r] = 0.f;
    const bf16* wg = WSP + (size_t)g * 128 * 128 + (size_t)lq * 128 + 8 * hi;
    bf16x8 bcur[4], bnxt[4];
#pragma unroll
    for (int nt = 0; nt < 4; ++nt) { bcur[nt] = *(const GAS bf16x8*)(wg + (size_t)(32 * nt) * 128); bnxt[nt] = bcur[nt]; }
#pragma unroll 1
    for (int ks = 0; ks < 8; ++ks) {
        if (ks < 7) {
#pragma unroll
            for (int nt = 0; nt < 4; ++nt) if (ks + 1 < 2 * (nt + 1)) bnxt[nt] = *(const GAS bf16x8*)(wg + (size_t)(32 * nt) * 128 + 16 * (ks + 1)); }
        bf16x8 af[2];
#pragma unroll
        for (int mt = 0; mt < 2; ++mt) { const LAS unsigned short* ap = VT + (cb + 32 * mt + lq) * GV_ROW + 16 * ks + 8 * hi;
            const s16x4 lo = *(const LAS s16x4*)ap, h8 = *(const LAS s16x4*)(ap + 4); af[mt] = __builtin_shufflevector(lo, h8, 0, 1, 2, 3, 4, 5, 6, 7); }
#pragma unroll
        for (int nt = 0; nt < 4; ++nt) if (ks < 2 * (nt + 1)) {
#pragma unroll
            for (int mt = 0; mt < 2; ++mt) acc[mt][nt] = __builtin_amdgcn_mfma_f32_32x32x16_bf16(af[mt], bcur[nt], acc[mt][nt], 0, 0, 0); }
#pragma unroll
        for (int nt = 0; nt < 4; ++nt) bcur[nt] = bnxt[nt];
    }
#pragma unroll
    for (int nt = 0; nt < 4; ++nt) { const int t = 32 * nt + lq; const float bias = b_s[g * 128 + t];
        const bf16* up = PROJ + (T0 + t) * INW + C_U + cb + 4 * hi; bf16* op = AG + (T0 + t) * 1024 + 512 + cb + 4 * hi;
#pragma unroll
        for (int mt = 0; mt < 2; ++mt)
#pragma unroll
            for (int j = 0; j < 4; ++j) { const v2u uu = *(const GAS v2u*)(up + 32 * mt + 8 * j);
                v2u w; w.x = cvtpk(bflo(uu.x) * (acc[mt][nt][4 * j] + bias), bfhi(uu.x) * (acc[mt][nt][4 * j + 1] + bias));
                w.y = cvtpk(bflo(uu.y) * (acc[mt][nt][4 * j + 2] + bias), bfhi(uu.y) * (acc[mt][nt][4 * j + 3] + bias));
                *(GAS v2u*)(op + 32 * mt + 8 * j) = w; } }
    __syncthreads();
}
__device__ __forceinline__ void unpack8(const v4u mv, f32x4& a, f32x4& b) { a = (f32x4){bflo(mv.x), bfhi(mv.x), bflo(mv.y), bfhi(mv.y)}; b = (f32x4){bflo(mv.z), bfhi(mv.z), bflo(mv.w), bfhi(mv.w)}; }
__device__ __forceinline__ void e1_row(int lane, bf16* xbrow, float rstd_x, const bf16* mixrow, const float* ssq, const float* gpost, const float* gpre, bf16* hrow) {
    float t = (lane < 16) ? ssq[lane] : 0.f; t = wave_sum(t);
    const float rstd = 1.0f / sqrtf(t * (1.f / D) + EPS), rx = 1.0f / rstd_x;
    f32x4 h[2][2]; float s = 0.f;
#pragma unroll
    for (int j = 0; j < 2; ++j) { const int c = 8 * lane + 512 * j; const v4u mv = *(const GAS v4u*)(mixrow + c), xv = *(const GAS v4u*)(xbrow + c);
        const f32x4 g0 = *(const GAS f32x4*)(gpost + c), g1 = *(const GAS f32x4*)(gpost + c + 4);
        f32x4 m0, m1, x0, x1; unpack8(mv, m0, m1); unpack8(xv, x0, x1);
        h[j][0] = x0 * rx + m0 * rstd * g0; h[j][1] = x1 * rx + m1 * rstd * g1;
        *(GAS v4u*)(hrow + c) = pg8::pack8(h[j][0], h[j][1]);
#pragma unroll
        for (int e = 0; e < 4; ++e) s += h[j][0][e] * h[j][0][e] + h[j][1][e] * h[j][1][e]; }
    const float r2 = 1.0f / sqrtf(wave_sum(s) * (1.f / D) + EPS);
#pragma unroll
    for (int j = 0; j < 2; ++j) { const int c = 8 * lane + 512 * j; const f32x4 g0 = *(const GAS f32x4*)(gpre + c), g1 = *(const GAS f32x4*)(gpre + c + 4);
        *(GAS v4u*)(xbrow + c) = pg8::pack8(h[j][0] * r2 * g0, h[j][1] * r2 * g1); }
}
__device__ __forceinline__ void e2_row(int lane, const bf16* ffrow, const float* ssq, const float* gpost, const bf16* hrow, float* orow) {
    float t = (lane < 16) ? ssq[lane] : 0.f; t = wave_sum(t);
    const float rstd = 1.0f / sqrtf(t * (1.f / D) + EPS);
#pragma unroll
    for (int j = 0; j < 2; ++j) { const int c = 8 * lane + 512 * j; const v4u mv = *(const GAS v4u*)(ffrow + c), hv = *(const GAS v4u*)(hrow + c);
        const f32x4 g0 = *(const GAS f32x4*)(gpost + c), g1 = *(const GAS f32x4*)(gpost + c + 4);
        f32x4 m0, m1, x0, x1; unpack8(mv, m0, m1); unpack8(hv, x0, x1);
        *(GAS f32x4*)(orow + c) = x0 + m0 * rstd * g0; *(GAS f32x4*)(orow + c + 4) = x1 + m1 * rstd * g1; }
}
#define XB_TMO      128
#define XB_XCNT(j)  (256  + 64 * (j))
#define XB_XSUB(j)  (1280 + 64 * (j))
#define XB_XGEN(j)  (2304 + 64 * (j))
#define XB_TOP      3328
#define XB_TOPGEN   3392
#define XCD_BAR_WORDS 3456
#define XB_SPIN_CAP (1u << 18)

__device__ __forceinline__ unsigned xb_ld(unsigned* p)              { return __hip_atomic_load(p, __ATOMIC_RELAXED, __HIP_MEMORY_SCOPE_AGENT); }
__device__ __forceinline__ unsigned xb_add(unsigned* p, unsigned v) { return __hip_atomic_fetch_add(p, v, __ATOMIC_RELAXED, __HIP_MEMORY_SCOPE_AGENT); }
__device__ __forceinline__ unsigned xb_xcc_id() { return (unsigned)__builtin_amdgcn_s_getreg((3 << 11) | 20) & 0xFu; }
#define XB_SPIN(cond, bar) do { unsigned _sp = 0; while (cond) { __builtin_amdgcn_s_sleep(1); \
    if ((++_sp & 255u) == 0u) { if (xb_ld(&(bar)[XB_TMO])) break; if (_sp > XB_SPIN_CAP) { atomicAdd(&(bar)[XB_TMO], 1u); break; } } } } while (0)

struct XcdBarrier {
    unsigned* bar; unsigned x;
    volatile LAS unsigned* st;
};

__device__ __forceinline__ XcdBarrier xcd_barrier_post(unsigned* bar, volatile LAS unsigned* st, int wave) {
    XcdBarrier b; b.bar = bar; b.x = xb_xcc_id(); b.st = st;
    if (pg8::lane_id_opaque() == 0 && wave == 0) (void)xb_add(&bar[XB_XCNT(b.x)], 1u);
    return b;
}
__device__ __forceinline__ void xcd_barrier_complete(unsigned* bar, unsigned x, unsigned& nloc, unsigned& nx) {
    const unsigned G = gridDim.x * gridDim.y * gridDim.z;
    unsigned sum, cnt, mine, sp = 0u;
    for (;;) {
        sum = 0u; cnt = 0u; mine = 0u;
#pragma unroll
        for (unsigned j = 0; j < 16; ++j) { const unsigned c = xb_ld(&bar[XB_XCNT(j)]); sum += c; cnt += (c > 0u) ? 1u : 0u; mine = (j == x) ? c : mine; }
        if (sum == G) break;
        __builtin_amdgcn_s_sleep(1);
        if ((++sp & 255u) == 0u) { if (xb_ld(&bar[XB_TMO])) break; if (sp > XB_SPIN_CAP) { atomicAdd(&bar[XB_TMO], 1u); break; } }
    }
    nloc = mine > 0u ? mine : 1u; nx = cnt > 0u ? cnt : 1u;
}

__device__ __forceinline__ void xcd_barrier(const XcdBarrier& b, int wave) {
    asm volatile("s_waitcnt vmcnt(0)" ::: "memory");
    __syncthreads();
    if (pg8::lane_id_opaque() == 0 && wave == 0) {
        unsigned* bar = b.bar;
        __builtin_amdgcn_s_waitcnt(0);
        unsigned nloc = b.st[0], nx = b.st[1];
        if (nloc == 0u) { xcd_barrier_complete(bar, b.x, nloc, nx); b.st[0] = nloc; b.st[1] = nx; }
        const unsigned old = xb_add(&bar[XB_XSUB(b.x)], 1u);
        const unsigned gen = old / nloc;
        if (old + 1u == (gen + 1u) * nloc) {
            __builtin_amdgcn_fence(__ATOMIC_RELEASE, "agent");
            asm volatile("s_waitcnt vmcnt(0)" ::: "memory");
            const unsigned og = xb_add(&bar[XB_TOP], 1u);
            const unsigned tg = og / nx;
            if (og + 1u == (tg + 1u) * nx) xb_add(&bar[XB_TOPGEN], 1u);
            else XB_SPIN(xb_ld(&bar[XB_TOPGEN]) == tg, bar);
            __builtin_amdgcn_fence(__ATOMIC_ACQUIRE, "agent");
            xb_add(&bar[XB_XGEN(b.x)], 1u);
            asm volatile("s_waitcnt vmcnt(0)" ::: "memory");
        } else {
            XB_SPIN(xb_ld(&bar[XB_XGEN(b.x)]) == gen, bar);
            __builtin_amdgcn_fence(__ATOMIC_ACQUIRE, "agent");
            asm volatile("s_waitcnt vmcnt(0)" ::: "memory");
        }
    }
    __syncthreads();
}

constexpr int N_PHASES = 9;
struct Args { const float* in[17]; float* out; unsigned char* ws; int ph_lo, ph_hi; };
__global__ void __launch_bounds__(NTHR, 2) fwd_megakernel(Args args) {
    extern __shared__ __attribute__((aligned(16))) unsigned char lds[];
    cg::grid_group grid = cg::this_grid();
    Frame F;
    F.lds = (LAS unsigned char*)lds;
    F.wave = __builtin_amdgcn_readfirstlane(threadIdx.x >> 6);
#define RETID() do { F.lane = pg8::lane_id_opaque(); F.tid = F.wave * 64 + F.lane; } while (0)
    RETID();
    F.G = gridDim.x; F.bid = blockIdx.x;
    const __attribute__((address_space(4))) char* kargp = (const __attribute__((address_space(4))) char*)__builtin_amdgcn_kernarg_segment_ptr();
#define LAZY_IN(k) (F.in[k] = *(const float* const volatile __attribute__((address_space(4)))*)(kargp + 8 * (k)))
    F.out = args.out; F.ws = args.ws;
    unsigned char* ws = args.ws;
    const int lo = args.ph_lo, hi = args.ph_hi;
    volatile LAS unsigned* MISC = (volatile LAS unsigned*)(F.lds + MISC_OFF);
    if (F.tid < 16) MISC[F.tid] = 0u;
    __syncthreads();
    XcdBarrier bar = xcd_barrier_post((unsigned*)(ws + WS_CTL), MISC, F.wave);
    bf16* W_IN = (bf16*)(ws + WS_WIN); bf16* W_AB = (bf16*)(ws + WS_WAB); bf16* W_OUT = (bf16*)(ws + WS_WOUT); bf16* W_GU = (bf16*)(ws + WS_WGU); bf16* W_D = (bf16*)(ws + WS_WD); bf16* W_SP = (bf16*)(ws + WS_WSP);
    float* SSQA = (float*)(ws + WS_SSQA); float* SSQB = (float*)(ws + WS_SSQB);
    bf16* XN = (bf16*)(ws + WS_XN); bf16* AG = (bf16*)(ws + WS_AG); bf16* MG = (bf16*)(ws + WS_MG); bf16* PROJ = (bf16*)(ws + WS_PROJ);
    bf16* MIX = AG; bf16* FFO = MG; bf16* HB = PROJ; bf16* HN = XN; bf16* HB16 = (bf16*)(ws + WS_HB16);
#define IN(k) (lo <= (k) && (k) < hi)
    if (hi < 0) grid.sync();
#define SEAM(k) do { if (IN(k) && IN((k) + 1)) xcd_barrier(bar, F.wave); else __syncthreads(); RETID(); } while (0)

    if (IN(0)) { LAZY_IN(0); LAZY_IN(1); LAZY_IN(2); LAZY_IN(6); LAZY_IN(8); LAZY_IN(9); LAZY_IN(10); LAZY_IN(13); LAZY_IN(14); LAZY_IN(15); p0_prologue(F); }
    SEAM(0);
    if (IN(1)) { pg8::Gemm g{XN, W_IN, M, INW, D}; pg8::StaticOrder S; S.init(M, INW, F.G, F.bid); pg8::EpiProj E{PROJ};
        pg8::gemm_phase<pg8::EpiProj, pg8::StaticOrder, true, true>(F.lds, g, S, E, F.wave); }
    SEAM(1);
    if (IN(2)) { LAZY_IN(3); LAZY_IN(4); LAZY_IN(5); LAZY_IN(7);
        for (int u = F.bid; u < BATCH * 16 * 2; u += F.G) attn_unit(F, PROJ, AG, F.in[3], u);
        for (int u = F.bid; u < BATCH * 16; u += F.G) gmlp_unit(F, PROJ, AG, F.in[4], F.in[5], W_SP, F.in[7], u);
    }
    SEAM(2);
    if (IN(3)) { pg8::Gemm g{AG, W_AB, M, D, D}; pg8::StaticOrder S; S.init(M, D, F.G, F.bid); pg8::EpiMerge E{PROJ, MG};
        pg8::gemm_phase<pg8::EpiMerge, pg8::StaticOrder, true, true>(F.lds, g, S, E, F.wave); }
    SEAM(3);
    if (IN(4)) { pg8::Gemm g{MG, W_OUT, M, D, D}; pg8::StaticOrder S; S.init(M, D, F.G, F.bid); pg8::EpiSsq E{MIX, SSQA};
        pg8::gemm_phase<pg8::EpiSsq, pg8::StaticOrder, true, true>(F.lds, g, S, E, F.wave); }
    SEAM(4);
    if (IN(5)) { LAZY_IN(11); LAZY_IN(12); const int gw = F.bid * NWAVES + F.wave, NGW = F.G * NWAVES;
        const float* RSTD = (const float*)(ws + WS_RSTD);
        for (int m = gw; m < M; m += NGW) e1_row(F.lane, HN + (size_t)m * D, RSTD[m], MIX + (size_t)m * D, SSQA + (size_t)m * 16, F.in[11], F.in[12], HB16 + (size_t)m * D); }
    SEAM(5);
    if (IN(6)) { pg8::Gemm g{HN, W_GU, M, 2 * FF, D}; pg8::StaticOrder S; S.init(M, 2 * FF, F.G, F.bid); pg8::EpiSwiglu E{HB};
        pg8::gemm_phase<pg8::EpiSwiglu, pg8::StaticOrder, true, true>(F.lds, g, S, E, F.wave); }
    SEAM(6);
    if (IN(7)) { pg8::Gemm g{HB, W_D, M, D, FF}; pg8::StaticOrder S; S.init(M, D, F.G, F.bid); pg8::EpiSsq E{FFO, SSQB};
        pg8::gemm_phase<pg8::EpiSsq, pg8::StaticOrder, true, true>(F.lds, g, S, E, F.wave); }
    SEAM(7);
    if (IN(8)) { LAZY_IN(16); const int gw = F.bid * NWAVES + F.wave, NGW = F.G * NWAVES;
        for (int m = gw; m < M; m += NGW) e2_row(F.lane, FFO + (size_t)m * D, SSQB + (size_t)m * 16, F.in[16], HB16 + (size_t)m * D, F.out + (size_t)m * D); }
#undef IN
#undef SEAM
}

extern "C" void kernel_launch(void* const* d_in, const int* in_sizes, int n_in, void* d_out, int out_size, void* d_ws, size_t ws_size, hipStream_t stream) {
    static int grid = 0;
    if (grid == 0) {
        if (n_in != 17 || out_size != M * D || ws_size < WS_END) { fprintf(stderr, "kernel_launch: unexpected problem: n_in %d out %d ws %zu\n", n_in, out_size, ws_size); grid = -1; return; }
        int dev = 0, cus = 0, per_cu = 0;
        (void)hipGetDevice(&dev); (void)hipDeviceGetAttribute(&cus, hipDeviceAttributeMultiprocessorCount, dev);
        if (hipFuncSetAttribute((const void*)fwd_megakernel, hipFuncAttributeMaxDynamicSharedMemorySize, LDS_BYTES) != hipSuccess) fprintf(stderr, "kernel_launch: hipFuncSetAttribute failed\n");
        if (hipOccupancyMaxActiveBlocksPerMultiprocessor(&per_cu, (const void*)fwd_megakernel, NTHR, LDS_BYTES) != hipSuccess || per_cu < 1) { fprintf(stderr, "kernel_launch: occupancy query says %d\n", per_cu); per_cu = 1; }
        (void)hipGetLastError();
        grid = cus * per_cu;
        fprintf(stderr, "kernel_launch: grid %d (cus %d x %d)\n", grid, cus, per_cu);
    }
    if (grid < 0) return;
    if (hipMemsetAsync((char*)d_ws + WS_CTL, 0, CTL_BYTES, stream) != hipSuccess) { fprintf(stderr, "kernel_launch: hipMemsetAsync failed\n"); return; }
    Args a{};
    for (int i = 0; i < 17; ++i) a.in[i] = (const float*)d_in[i];
    a.out = (float*)d_out; a.ws = (unsigned char*)d_ws;
#if MK_N_LAUNCHES == 1
    a.ph_lo = 0; a.ph_hi = N_PHASES;
    void* kargs[] = {&a};
    hipError_t e = hipLaunchCooperativeKernel((const void*)fwd_megakernel, dim3(grid), dim3(NTHR), kargs, LDS_BYTES, stream);
    if (e != hipSuccess) fprintf(stderr, "kernel_launch: cooperative launch failed: %s (grid %d)\n", hipGetErrorString(e), grid);
#else
    for (int k = 0; k < N_PHASES; ++k) { a.ph_lo = k; a.ph_hi = k + 1;
        hipLaunchKernelGGL(fwd_megakernel, dim3(grid), dim3(NTHR), LDS_BYTES, stream, a);
        const hipError_t le = hipPeekAtLastError(); if (le != hipSuccess) { fprintf(stderr, "kernel_launch: launch %d failed: %s\n", k, hipGetErrorName(le)); break; } }
#endif
}
```

```cpp
#include <hip/hip_runtime.h>
#include <hip/hip_cooperative_groups.h>
#include <cstdio>
#include <cstdint>
namespace cg = cooperative_groups;
#ifndef MK_N_LAUNCHES
#define MK_N_LAUNCHES 1
#endif
namespace pg8 {
#define PG8_LAS __attribute__((address_space(3)))
typedef unsigned short bf16_t;
typedef short bf16x8 __attribute__((ext_vector_type(8)));
typedef float f32x4 __attribute__((ext_vector_type(4)));
typedef unsigned u32x4 __attribute__((ext_vector_type(4)));
constexpr int BM = 256, BK = 64, HALF = 128, HTB = HALF * BK * 2  , STAGE_BYTES = 8 * HTB, NXCD = 8, WGM = 8;

__host__ __device__ __forceinline__ int lds_byte(int r, int c) { const int st = (r >> 4) * 2 + (c >> 5), rr = r & 15, cc = c & 31, ob = rr * 64 + cc * 2; return st * 1024 + (ob ^ (((ob >> 9) & 1) << 5)); }
__host__ __device__ __forceinline__ void stage_rc(int b, int& R, int& C) { const int st = b / 1024, sb = b % 1024, swz = sb ^ (((sb >> 9) & 1) << 5); R = (st >> 1) * 16 + swz / 64; C = (st & 1) * 32 + (swz % 64) / 2; }
__host__ __device__ __forceinline__ int perm32(int rho) { const int n = rho >> 4, i = rho & 15; return 8 * (i >> 2) + 4 * n + (i & 3); }

__device__ __forceinline__ int lane_id_opaque() { int l; asm volatile("v_mbcnt_lo_u32_b32 %0, -1, 0\n\tv_mbcnt_hi_u32_b32 %0, -1, %0" : "=v"(l)); return l; }
struct Unit { int pm, pn; };
struct Gemm { const bf16_t* A; const bf16_t* Bt; int M, N, K; };

struct StaticOrder {
    int nM, nN, nwg, G, c;
    __host__ __device__ void init(int M, int N, int G_, int c_) { nM = M / BM; nN = N / BM; nwg = nM * nN; G = G_; c = c_; }
    __host__ __device__ bool next(int i, Unit& u) const {
        const long L = (long)i * G + c; if (L >= nwg) return false;
        int wgid = (int)L; { const int q = nwg / NXCD, r = nwg % NXCD, xcd = wgid % NXCD, off = wgid / NXCD; wgid = (xcd < r ? xcd * (q + 1) : r * (q + 1) + (xcd - r) * q) + off; }
        const int nig = WGM * nN, gid = wgid / nig, fm = gid * WGM, gsz = (nM - fm) < WGM ? (nM - fm) : WGM;
        u.pm = fm + ((wgid % nig) % gsz); u.pn = (wgid % nig) / gsz; return true;
    }
    __device__ __forceinline__ void a_ready(const Unit&) const {}
    __device__ __forceinline__ void done(const Unit&) const {}
};

__device__ __forceinline__ unsigned cvt_pk_bf16(float lo, float hi) { unsigned r; asm volatile("v_cvt_pk_bf16_f32 %0, %1, %2" : "=v"(r) : "v"(lo), "v"(hi)); return r; }
typedef float f32x2 __attribute__((ext_vector_type(2)));
__device__ __forceinline__ f32x2 gelu_pk(f32x2 v) {
    const f32x2 av = __builtin_elementwise_abs(v), d = av * 0.2316418882f + 1.0f;
    f32x2 t; t.x = __builtin_amdgcn_rcpf(d.x); t.y = __builtin_amdgcn_rcpf(d.y);
    f32x2 q = t * 0.5307027145f + (-0.7265760135f); q = q * t + 0.7107068705f; q = q * t + (-0.142248368f); q = q * t + 0.127414796f; q = q * t;
    const f32x2 s = (v * v) * (-0.72134752044f);
    f32x2 e; e.x = __builtin_amdgcn_exp2f(s.x); e.y = __builtin_amdgcn_exp2f(s.y);
    const f32x2 m = v * (q * e), r = v - m;
    f32x2 o; o.x = v.x < 0.f ? m.x : r.x; o.y = v.y < 0.f ? m.y : r.y; return o;
}
typedef __bf16 bf16x2_t __attribute__((ext_vector_type(2)));
__device__ __forceinline__ unsigned cvtpk(float lo, float hi) { f32x2 v = {lo, hi}; bf16x2_t b = __builtin_convertvector(v, bf16x2_t); return __builtin_bit_cast(unsigned, b); }
__device__ __forceinline__ float bflo(unsigned u) { return __uint_as_float(u << 16); }
__device__ __forceinline__ float bfhi(unsigned u) { return __uint_as_float(u & 0xffff0000u); }
__device__ __forceinline__ float sigm(float x) { return __builtin_amdgcn_rcpf(1.0f + __builtin_amdgcn_exp2f(-1.4426950408889634f * x)); }
__device__ __forceinline__ u32x4 pack8(f32x4 v0, f32x4 v1) { u32x4 w; w.x = cvtpk(v0[0], v0[1]); w.y = cvtpk(v0[2], v0[3]); w.z = cvtpk(v1[0], v1[1]); w.w = cvtpk(v1[2], v1[3]); return w; }
constexpr int PROJ_LD = 3840;
constexpr float QSCALE = 0.125f * 1.4426950408889634f;

struct EpiProj {
    static constexpr bool PERM = true, AFTER_DRAIN = false, MID = false; static constexpr int NST = 14;
    bf16_t* O;
    __device__ __forceinline__ void mid(f32x4 (&)[2][2][4][2], const Unit&, int, int, int, int) const {}
    __device__ __forceinline__ void operator()(const f32x4 (&acc)[2][2][4][2], const Unit& u, int wr, int wc, int fr, int fq) const {
        { const int l_ = lane_id_opaque(); fr = l_ & 15; fq = l_ >> 4; }
        const int row0 = u.pm * BM + wr * 64 + fr, col0 = u.pn * BM + wc * 32 + 8 * fq;
        const int mode = u.pn < 3 ? 0 : (u.pn < 7 ? 1 : 2); const float sc = u.pn < 2 ? QSCALE : 1.0f;
#pragma unroll
        for (int ai = 0; ai < 2; ++ai)
#pragma unroll
            for (int m = 0; m < 4; ++m) { bf16_t* rowp = O + (size_t)(row0 + ai * HALF + m * 16) * PROJ_LD + col0;
#pragma unroll
                for (int bj = 0; bj < 2; ++bj) { f32x4 v0 = acc[ai][bj][m][0], v1 = acc[ai][bj][m][1];
                    if (mode == 1) { f32x2 a = gelu_pk((f32x2){v0[0], v0[1]}), b = gelu_pk((f32x2){v0[2], v0[3]}), c = gelu_pk((f32x2){v1[0], v1[1]}), d = gelu_pk((f32x2){v1[2], v1[3]});
                        v0 = (f32x4){a.x, a.y, b.x, b.y}; v1 = (f32x4){c.x, c.y, d.x, d.y}; }
                    else if (mode == 2) { v0 = (f32x4){sigm(v0[0]), sigm(v0[1]), sigm(v0[2]), sigm(v0[3])}; v1 = (f32x4){sigm(v1[0]), sigm(v1[1]), sigm(v1[2]), sigm(v1[3])}; }
                    else { v0 = v0 * sc; v1 = v1 * sc; }
                    *(u32x4*)(rowp + bj * HALF) = pack8(v0, v1); } }
    }
};
struct EpiMerge {
    static constexpr bool PERM = true, AFTER_DRAIN = false, MID = true; static constexpr int NST = 14;
    const bf16_t* P; bf16_t* O;
    __device__ __forceinline__ void mid(f32x4 (&acc)[2][2][4][2], const Unit& u, int wr, int wc, int fr, int fq) const {
        { const int l_ = lane_id_opaque(); fr = l_ & 15; fq = l_ >> 4; }
        const int row0 = u.pm * BM + wr * 64 + fr, col0 = u.pn * BM + wc * 32 + 8 * fq;
#pragma unroll
        for (int ai = 0; ai < 2; ++ai)
#pragma unroll
            for (int m = 0; m < 4; ++m) { const bf16_t* rowp = P + (size_t)(row0 + ai * HALF + m * 16) * PROJ_LD + col0;
#pragma unroll
                for (int bj = 0; bj < 2; ++bj) { const u32x4 a = *(const u32x4*)(rowp + 1792 + bj * HALF), b = *(const u32x4*)(rowp + 2816 + bj * HALF);
                    f32x4 r0, r1;
                    r0[0] = bflo(a.x) * __builtin_amdgcn_rcpf(bflo(b.x)); r0[1] = bfhi(a.x) * __builtin_amdgcn_rcpf(bfhi(b.x)); r0[2] = bflo(a.y) * __builtin_amdgcn_rcpf(bflo(b.y)); r0[3] = bfhi(a.y) * __builtin_amdgcn_rcpf(bfhi(b.y));
                    r1[0] = bflo(a.z) * __builtin_amdgcn_rcpf(bflo(b.z)); r1[1] = bfhi(a.z) * __builtin_amdgcn_rcpf(bfhi(b.z)); r1[2] = bflo(a.w) * __builtin_amdgcn_rcpf(bflo(b.w)); r1[3] = bfhi(a.w) * __builtin_amdgcn_rcpf(bfhi(b.w));
                    acc[ai][bj][m][0] *= r0; acc[ai][bj][m][1] *= r1; }
                if (m & 1) asm volatile("" ::: "memory"); }
    }
    __device__ __forceinline__ void operator()(const f32x4 (&acc)[2][2][4][2], const Unit& u, int wr, int wc, int fr, int fq) const {
        { const int l_ = lane_id_opaque(); fr = l_ & 15; fq = l_ >> 4; }
        const int row0 = u.pm * BM + wr * 64 + fr, col0 = u.pn * BM + wc * 32 + 8 * fq;
#pragma unroll
        for (int ai = 0; ai < 2; ++ai)
#pragma unroll
            for (int m = 0; m < 4; ++m) { const size_t row = (size_t)(row0 + ai * HALF + m * 16); const bf16_t* rowp = P + row * PROJ_LD + col0;
#pragma unroll
                for (int bj = 0; bj < 2; ++bj) { const u32x4 b = *(const u32x4*)(rowp + 2816 + bj * HALF);
                    const f32x4 s0 = {bflo(b.x), bfhi(b.x), bflo(b.y), bfhi(b.y)}, s1 = {bflo(b.z), bfhi(b.z), bflo(b.w), bfhi(b.w)};
                    *(u32x4*)(O + row * 1024 + col0 + bj * HALF) = pack8(acc[ai][bj][m][0] * s0, acc[ai][bj][m][1] * s1); }
                asm volatile("" ::: "memory"); }
    }
};
struct EpiSsq {
    static constexpr bool PERM = true, AFTER_DRAIN = false, MID = false; static constexpr int NST = 20;
    bf16_t* O; float* ssq;
    __device__ __forceinline__ void mid(f32x4 (&)[2][2][4][2], const Unit&, int, int, int, int) const {}
    __device__ __forceinline__ void operator()(const f32x4 (&acc)[2][2][4][2], const Unit& u, int wr, int wc, int fr, int fq) const {
        { const int l_ = lane_id_opaque(); fr = l_ & 15; fq = l_ >> 4; }
        const int row0 = u.pm * BM + wr * 64 + fr, col0 = u.pn * BM + wc * 32 + 8 * fq;
#pragma unroll
        for (int ai = 0; ai < 2; ++ai)
#pragma unroll
            for (int m = 0; m < 4; ++m) { const size_t row = (size_t)(row0 + ai * HALF + m * 16); float s = 0.f;
#pragma unroll
                for (int bj = 0; bj < 2; ++bj) { const f32x4 v0 = acc[ai][bj][m][0], v1 = acc[ai][bj][m][1];
                    s += (v0[0] * v0[0] + v0[1] * v0[1]) + (v0[2] * v0[2] + v0[3] * v0[3]) + (v1[0] * v1[0] + v1[1] * v1[1]) + (v1[2] * v1[2] + v1[3] * v1[3]);
                    *(u32x4*)(O + row * 1024 + col0 + bj * HALF) = pack8(v0, v1); }
                s += __shfl_xor(s, 16); s += __shfl_xor(s, 32);
                if (fq == 0) ssq[row * 16 + u.pn * 4 + wc] = s; }
    }
};
struct EpiSwiglu {
    static constexpr bool PERM = true, AFTER_DRAIN = false, MID = false; static constexpr int NST = 7;
    bf16_t* O;
    __device__ __forceinline__ void mid(f32x4 (&)[2][2][4][2], const Unit&, int, int, int, int) const {}
    __device__ __forceinline__ void operator()(const f32x4 (&acc)[2][2][4][2], const Unit& u, int wr, int wc, int fr, int fq) const {
        { const int l_ = lane_id_opaque(); fr = l_ & 15; fq = l_ >> 4; }
        const int row0 = u.pm * BM + wr * 64 + fr, col0 = u.pn * HALF + wc * 32 + 8 * fq;
#pragma unroll
        for (int ai = 0; ai < 2; ++ai)
#pragma unroll
            for (int m = 0; m < 4; ++m) { const size_t row = (size_t)(row0 + ai * HALF + m * 16);
                const f32x4 g0 = acc[ai][0][m][0], g1 = acc[ai][0][m][1], u0 = acc[ai][1][m][0], u1 = acc[ai][1][m][1];
                f32x4 h0, h1;
#pragma unroll
                for (int e = 0; e < 4; ++e) { h0[e] = g0[e] * sigm(g0[e]) * u0[e]; h1[e] = g1[e] * sigm(g1[e]) * u1[e]; }
                *(u32x4*)(O + row * 2816 + col0) = pack8(h0, h1); }
    }
};
template <class Epi, class Sched, bool ALIGN_EPI = false, bool SP2 = false>
__device__ __forceinline__ void gemm_phase(PG8_LAS unsigned char* lds, const Gemm g, const Sched& S, const Epi& E, int wid) {
    const int lane = lane_id_opaque(), tid = wid * 64 + lane, wr = wid >> 2, wc = wid & 3, fr = lane & 15, fq = lane >> 4;
    const int K = g.K, nt = K / BK;
    unsigned voffA[2], voffB[2];
#pragma unroll
    for (int i = 0; i < 2; ++i) { int R, C; stage_rc(tid * 16 + i * 8192, R, C); const int Rb = Epi::PERM ? ((R & ~31) + perm32(R & 31)) : R;
        voffA[i] = (unsigned)(R * K + C) * 2u; voffB[i] = (unsigned)(Rb * K + C) * 2u; }
    const size_t kstep = (size_t)(BK * 2);
    const size_t hstep = (size_t)HALF * K * 2;
    const size_t tstep = 2 * hstep;
    const unsigned ldsw = (unsigned)wid * 1024u;
    const int aoff = lds_byte(wr * 64 + fr, fq * 8), boff = lds_byte(wc * 32 + fr, fq * 8);
#define PG8_SA(b, h) (((b) * 2 + (h)) * HTB)
#define PG8_SB(b, h) ((4 + (b) * 2 + (h)) * HTB)
#define PG8_STAGE(bufoff, gbase, voff) do { _Pragma("unroll") for (int _i = 0; _i < 2; ++_i) \
        __builtin_amdgcn_global_load_lds((const unsigned*)((const char*)(gbase) + (voff)[_i]), (PG8_LAS unsigned*)(lds + (bufoff) + ldsw + _i * 8192), 16, 0, 0); } while (0)
#define PG8_LDA(dst, b, h) do { _Pragma("unroll") for (int m = 0; m < 4; ++m) _Pragma("unroll") for (int k = 0; k < 2; ++k) dst[m][k] = *(const PG8_LAS bf16x8*)(lds + PG8_SA(b, h) + aoff + m * 2048 + k * 1024); } while (0)
#define PG8_LDB(dst, b, h) do { _Pragma("unroll") for (int n = 0; n < 2; ++n) _Pragma("unroll") for (int k = 0; k < 2; ++k) dst[n][k] = *(const PG8_LAS bf16x8*)(lds + PG8_SB(b, h) + boff + n * 2048 + k * 1024); } while (0)
#define PG8_MMA(ai, bj, At, Bt) do { __builtin_amdgcn_s_setprio(1); _Pragma("unroll") for (int m = 0; m < 4; ++m) _Pragma("unroll") for (int n = 0; n < 2; ++n) _Pragma("unroll") for (int k = 0; k < 2; ++k) \
        acc[ai][bj][m][n] = __builtin_amdgcn_mfma_f32_16x16x32_bf16(Bt[n][k], At[m][k], acc[ai][bj][m][n], 0, 0, 0); __builtin_amdgcn_s_setprio(0); } while (0)
#define PG8_WAIT_V(n) asm volatile("s_waitcnt vmcnt(" #n ")" ::: "memory")
#define PG8_WAIT_L(n) asm volatile("s_waitcnt lgkmcnt(" #n ")" ::: "memory")
#define PG8_WAIT_RLXC() PG8_WAIT_V(8)
#define PG8_BAR __builtin_amdgcn_s_barrier()
#define PG8_SCHED __builtin_amdgcn_sched_barrier(0)
    Unit cur, nxt; int ui = 0;
    if (!S.next(0, cur)) return;
    f32x4 acc[2][2][4][2];
#pragma unroll
    for (int a = 0; a < 2; ++a)
#pragma unroll
        for (int b = 0; b < 2; ++b)
#pragma unroll
            for (int m = 0; m < 4; ++m)
#pragma unroll
                for (int n = 0; n < 2; ++n) acc[a][b][m][n] = (f32x4){0.f, 0.f, 0.f, 0.f};
    bf16x8 At[4][2], B0[2][2], B1[2][2];
    const char* cA = (const char*)g.A + (size_t)cur.pm * tstep; const char* cB = (const char*)g.Bt + (size_t)cur.pn * tstep;
    S.a_ready(cur);
    if constexpr (SP2) {
        PG8_STAGE(PG8_SB(0, 0), cB, voffB); PG8_STAGE(PG8_SB(0, 1), cB + hstep, voffB); PG8_STAGE(PG8_SA(0, 0), cA, voffA); PG8_STAGE(PG8_SA(0, 1), cA + hstep, voffA);
        if (wr == 1) PG8_BAR;
        PG8_WAIT_V(2); PG8_BAR;
        PG8_STAGE(PG8_SB(1, 0), cB + kstep, voffB); PG8_STAGE(PG8_SA(1, 0), cA + kstep, voffA); PG8_STAGE(PG8_SB(1, 1), cB + hstep + kstep, voffB);
        PG8_WAIT_V(0); PG8_BAR;
    } else {
        PG8_STAGE(PG8_SB(0, 0), cB, voffB); PG8_STAGE(PG8_SA(0, 0), cA, voffA); PG8_STAGE(PG8_SB(0, 1), cB + hstep, voffB); PG8_STAGE(PG8_SA(0, 1), cA + hstep, voffA);
        if (wr == 1) PG8_BAR;
        PG8_WAIT_V(4); PG8_BAR;
        PG8_STAGE(PG8_SB(1, 0), cB + kstep, voffB); PG8_STAGE(PG8_SA(1, 0), cA + kstep, voffA); PG8_STAGE(PG8_SB(1, 1), cB + hstep + kstep, voffB);
        PG8_WAIT_V(6); PG8_BAR;
    }
    for (;;) {
        const bool has_next = S.next(ui + 1, nxt);
        const char* nA = has_next ? (const char*)g.A + (size_t)nxt.pm * tstep : cA; const char* nB = has_next ? (const char*)g.Bt + (size_t)nxt.pn * tstep : cB;
#define PG8_ITER(T, WAITV) do { const int t = (T); \
            const bool last = (t == nt - 2); \
            if constexpr (Epi::MID) { if (t == (nt >> 1)) E.mid(acc, cur, wr, wc, fr, fq); } \
            const char* a1 = cA + (size_t)(t + 1) * kstep; \
            const char* a2 = last ? nA : cA + (size_t)(t + 2) * kstep; const char* b2 = last ? nB : cB + (size_t)(t + 2) * kstep; \
            const char* a3 = a2 + kstep; const char* b3 = b2 + kstep; \
            if (last && has_next) S.a_ready(nxt); \
              \
            PG8_LDB(B0, 0, 0); PG8_LDB(B1, 0, 1); PG8_SCHED; PG8_LDA(At, 0, 0); PG8_STAGE(PG8_SA(1, 1), a1 + hstep, voffA); \
            WAITV; PG8_WAIT_L(0); PG8_BAR; PG8_MMA(0, 0, At, B0); PG8_MMA(0, 1, At, B1); PG8_BAR; PG8_SCHED; \
              \
            PG8_LDA(At, 0, 1); PG8_STAGE(PG8_SB(0, 0), b2, voffB); PG8_STAGE(PG8_SB(0, 1), b2 + hstep, voffB); PG8_STAGE(PG8_SA(0, 0), a2, voffA); \
            WAITV; PG8_WAIT_L(0); PG8_BAR; PG8_MMA(1, 0, At, B0); PG8_MMA(1, 1, At, B1); PG8_BAR; PG8_SCHED; \
              \
            PG8_LDB(B0, 1, 0); PG8_LDB(B1, 1, 1); PG8_SCHED; PG8_LDA(At, 1, 0); PG8_STAGE(PG8_SA(0, 1), a2 + hstep, voffA); \
            PG8_WAIT_V(8); PG8_WAIT_L(0); PG8_BAR; PG8_MMA(0, 0, At, B0); PG8_MMA(0, 1, At, B1); PG8_BAR; PG8_SCHED; \
              \
            PG8_LDA(At, 1, 1); PG8_STAGE(PG8_SB(1, 0), b3, voffB); PG8_STAGE(PG8_SB(1, 1), b3 + hstep, voffB); PG8_STAGE(PG8_SA(1, 0), a3, voffA); \
            PG8_WAIT_V(8); PG8_WAIT_L(0); PG8_BAR; PG8_MMA(1, 0, At, B0); PG8_MMA(1, 1, At, B1); PG8_BAR; PG8_SCHED; } while (0)
        static_assert(SP2, "only the SP2 loop is kept");
        PG8_ITER(0, PG8_WAIT_RLXC());
        for (int tt = 2; tt < nt; tt += 2) { PG8_ITER(tt, PG8_WAIT_V(8)); }
        if constexpr (ALIGN_EPI) { if (wr == 0) PG8_BAR; }
        if constexpr (!Epi::AFTER_DRAIN) { E(acc, cur, wr, wc, fr, fq); S.done(cur); }
        if (!has_next) break;
#pragma unroll
        for (int a = 0; a < 2; ++a)
#pragma unroll
            for (int b = 0; b < 2; ++b)
#pragma unroll
                for (int m = 0; m < 4; ++m)
#pragma unroll
                    for (int n = 0; n < 2; ++n) acc[a][b][m][n] = (f32x4){0.f, 0.f, 0.f, 0.f};
        cur = nxt; cA = nA; cB = nB; ++ui;
        if constexpr (ALIGN_EPI) { if (wr == 1) PG8_BAR; }
    }
    PG8_WAIT_V(0);
    if constexpr (!ALIGN_EPI) { if (wr == 0) PG8_BAR; }
    PG8_BAR;
    if constexpr (Epi::AFTER_DRAIN) { E.fused(acc, cur, wr, wc, fr, fq, lds, wid, lane); S.done(cur); }
#undef PG8_SA
#undef PG8_SB
#undef PG8_STAGE
#undef PG8_LDA
#undef PG8_LDB
#undef PG8_MMA
#undef PG8_WAIT_V
#undef PG8_WAIT_L
#undef PG8_WAIT_RLXC
#undef PG8_ITER
#undef PG8_BAR
#undef PG8_SCHED
}
}

constexpr int NWAVES = 8, NTHR = 512;
constexpr int BATCH = 32, SEQ = 2048, D = 1024, M = BATCH * SEQ;
constexpr int INW = 3840, FF = 2816;
constexpr int C_K = 512, C_V = 640, C_U = 768, C_VG = 1280;
constexpr float EPS = 1e-6f, LN_EPS = 1e-5f, LOG2E = 1.4426950408889634f;
constexpr size_t MiB = 1u << 20;
constexpr size_t WS_WIN = 0;
constexpr size_t WS_WAB = 8 * MiB;
constexpr size_t WS_WOUT = 10 * MiB;
constexpr size_t WS_WGU = 12 * MiB;
constexpr size_t WS_WD = 24 * MiB;
constexpr size_t WS_WSP = 30 * MiB;
constexpr size_t WS_CTL = 31 * MiB + 512 * 1024;
constexpr int CTL_BYTES = 3 * 16384, BAR_REGION_WORDS = 4096, MISC_OFF = 147456 - 64;
constexpr size_t WS_RSTD = 31 * MiB;
constexpr size_t WS_SSQA = 32 * MiB;
constexpr size_t WS_SSQB = 36 * MiB;
constexpr size_t WS_XN = 40 * MiB;
constexpr size_t WS_AG = 168 * MiB;
constexpr size_t WS_MG = 296 * MiB;
constexpr size_t WS_PROJ = 424 * MiB;
constexpr size_t WS_HB16 = WS_PROJ + 352 * MiB;
constexpr size_t WS_END = 904 * MiB;
constexpr int LDS_BYTES = 147456;

#define GAS __attribute__((address_space(1)))
#define LAS __attribute__((address_space(3)))
typedef unsigned short bf16;
typedef unsigned v4u __attribute__((ext_vector_type(4)));
typedef unsigned v2u __attribute__((ext_vector_type(2)));
typedef float f32x4 __attribute__((ext_vector_type(4)));
typedef float f32x16 __attribute__((ext_vector_type(16)));
typedef short bf16x8 __attribute__((ext_vector_type(8)));
typedef short s16x4 __attribute__((ext_vector_type(4)));
using pg8::cvtpk; using pg8::bflo; using pg8::bfhi;
#define LDS_WAIT() asm volatile("s_waitcnt lgkmcnt(0)" ::: "memory")
__device__ __forceinline__ unsigned short f2bf(float f) { return (unsigned short)(cvtpk(f, 0.f) & 0xffffu); }
__device__ __forceinline__ float bf2f(unsigned short h) { return __uint_as_float((unsigned)h << 16); }
__device__ __forceinline__ float wave_sum(float v) {
#pragma unroll
    for (int o = 1; o < 64; o <<= 1) v += __shfl_xor(v, o);
    return v;
}
__device__ __forceinline__ int crow(int r, int hi) { return (r & 3) + 8 * (r >> 2) + 4 * hi; }

struct Frame {
    LAS unsigned char* lds;
    int tid, lane, wave, G, bid;
    const float* in[17]; float* out; unsigned char* ws;
};
__device__ __forceinline__ int rowmap(int mode, int n) { return mode == 0 ? n : (((n >> 7) << 8) + (n & 127) + (mode == 2 ? 128 : 0)); }
__device__ __forceinline__ void p0_transpose_item(const float* W, int N, bf16* WT, int ldk, int koff, int mode, LAS float* scr, int item, int lane, const float* kscale = nullptr) {
    const int nblk = N / 32, kb = item / nblk, nb = item % nblk, k0 = 64 * kb, n0 = 32 * nb;
#pragma unroll 8
    for (int i = 0; i < 32; ++i) { const int kk = 2 * i + (lane >> 5); float w = W[(size_t)(k0 + kk) * N + n0 + (lane & 31)]; if (kscale) w *= kscale[k0 + kk]; scr[kk * 33 + (lane & 31)] = w; }
    LDS_WAIT(); asm volatile("" ::: "memory");
    const int c = lane & 7;
#pragma unroll
    for (int j = 0; j < 4; ++j) { const int n = (lane >> 3) + 8 * j; const LAS float* s = scr + (8 * c) * 33 + n;
        v4u o; o.x = cvtpk(s[0 * 33], s[1 * 33]); o.y = cvtpk(s[2 * 33], s[3 * 33]); o.z = cvtpk(s[4 * 33], s[5 * 33]); o.w = cvtpk(s[6 * 33], s[7 * 33]);
        *(GAS v4u*)(WT + (size_t)rowmap(mode, n0 + n) * ldk + koff + k0 + 8 * c) = o; }
    LDS_WAIT(); asm volatile("" ::: "memory");
}
__device__ __forceinline__ void rms_row_to_bf16(int lane, const float* xrow, float* rstd_out, bf16* orow) {
    const GAS f32x4* xr = (const GAS f32x4*)xrow + lane;
    f32x4 v[4]; float s = 0.f;
#pragma unroll
    for (int j = 0; j < 4; ++j) { v[j] = xr[64 * j]; s += (v[j].x * v[j].x + v[j].y * v[j].y) + (v[j].z * v[j].z + v[j].w * v[j].w); }
    const float rstd = 1.0f / sqrtf(wave_sum(s) * (1.f / D) + EPS);
    if (lane == 0) *rstd_out = rstd;
    GAS v2u* o8 = (GAS v2u*)orow + lane;
#pragma unroll
    for (int j = 0; j < 4; ++j) { v2u w; w.x = cvtpk(v[j].x * rstd, v[j].y * rstd); w.y = cvtpk(v[j].z * rstd, v[j].w * rstd); o8[64 * j] = w; }
}
__device__ __forceinline__ void p0_weights(Frame& F) {
    LAS float* scr = (LAS float*)(F.lds + F.wave * 16384);
    const int gw = F.bid * NWAVES + F.wave, NGW = F.G * NWAVES;
    unsigned char* ws = F.ws;
    constexpr int I_IN = (1024 / 64) * (INW / 32), I_A = (512 / 64) * (1024 / 32), I_O = (1024 / 64) * (1024 / 32), I_G = (1024 / 64) * (FF / 32), I_D = (FF / 64) * (1024 / 32);
    constexpr int NITEMS = I_IN + 2 * I_A + I_O + 2 * I_G + I_D;
    for (int it = gw; it < NITEMS; it += NGW) {
        int r = it;
        if (r < I_IN) { p0_transpose_item(F.in[2], INW, (bf16*)(ws + WS_WIN), 1024, 0, 0, scr, r, F.lane, F.in[1]); continue; } r -= I_IN;
        if (r < I_A) { p0_transpose_item(F.in[8], 1024, (bf16*)(ws + WS_WAB), 1024, 0, 0, scr, r, F.lane); continue; } r -= I_A;
        if (r < I_A) { p0_transpose_item(F.in[9], 1024, (bf16*)(ws + WS_WAB), 1024, 512, 0, scr, r, F.lane); continue; } r -= I_A;
        if (r < I_O) { p0_transpose_item(F.in[10], 1024, (bf16*)(ws + WS_WOUT), 1024, 0, 0, scr, r, F.lane); continue; } r -= I_O;
        if (r < I_G) { p0_transpose_item(F.in[13], FF, (bf16*)(ws + WS_WGU), 1024, 0, 1, scr, r, F.lane); continue; } r -= I_G;
        if (r < I_G) { p0_transpose_item(F.in[14], FF, (bf16*)(ws + WS_WGU), 1024, 0, 2, scr, r, F.lane); continue; } r -= I_G;
        p0_transpose_item(F.in[15], 1024, (bf16*)(ws + WS_WD), FF, 0, 0, scr, r, F.lane);
    }
    { const float* wsrc = F.in[6]; bf16* wdst = (bf16*)(ws + WS_WSP);
      for (int i = gw * 64 + F.lane; i < 4 * 128 * 128; i += NGW * 64) { const int t = (i >> 7) & 127, s = i & 127; wdst[i] = f2bf(s <= t ? wsrc[i] : 0.f); } }
}
__device__ __forceinline__ void p0_rows(Frame& F, const float* x, float* RSTD, bf16* XN, int MT) {
    const int gw = F.bid * NWAVES + F.wave, NGW = F.G * NWAVES;
    for (int m = gw; m < MT; m += NGW) rms_row_to_bf16(F.lane, x + (size_t)m * D, RSTD + m, XN + (size_t)m * D);
}
constexpr int KS_ROW = 144, VT_ROW = 260  , KS_BYTES = 256 * KS_ROW;
__device__ __forceinline__ void attn_unit(Frame& F, const bf16* PROJ, bf16* AG, const float* sinks, int unit) {
    const int tid = F.tid, lane = F.lane, wave = F.wave, lq = lane & 31, hi = lane >> 5;
    const int kvh = unit & 1, n = (unit >> 1) & 15, b = unit >> 5;
    const long T0 = (long)b * SEQ + n * 128;
    LAS unsigned char* Ks = F.lds; LAS unsigned short* VT = (LAS unsigned short*)(F.lds + KS_BYTES);
    const int jstart = (n == 0) ? 128 : 0;
#pragma unroll
    for (int it = 0; it < 4; ++it) { const int id = it * NTHR + tid, key = id >> 3, ch = id & 7;
        if (key >= jstart) { const bf16* src = PROJ + (T0 - 128 + key) * INW + C_K + kvh * 64 + ch * 8;
            const v4u kv = *(const GAS v4u*)src, vv = *(const GAS v4u*)(src + 128);
            *(LAS v4u*)(Ks + key * KS_ROW + ch * 16) = kv;
            LAS unsigned short* vt = VT + (ch * 8) * VT_ROW + key;
            vt[0 * VT_ROW] = (unsigned short)(vv.x & 0xffffu); vt[1 * VT_ROW] = (unsigned short)(vv.x >> 16);
            vt[2 * VT_ROW] = (unsigned short)(vv.y & 0xffffu); vt[3 * VT_ROW] = (unsigned short)(vv.y >> 16);
            vt[4 * VT_ROW] = (unsigned short)(vv.z & 0xffffu); vt[5 * VT_ROW] = (unsigned short)(vv.z >> 16);
            vt[6 * VT_ROW] = (unsigned short)(vv.w & 0xffffu); vt[7 * VT_ROW] = (unsigned short)(vv.w >> 16); } }
    __syncthreads();
#pragma unroll 1
    for (int pass = 0; pass < 2; ++pass) {
        int lqo = lq; asm volatile("" : "+v"(lqo));
        const int g = pass * 2 + (wave >> 2), wq = wave & 3, hq = kvh * 4 + g;
        const float slope2 = __builtin_amdgcn_exp2f(-(float)(hq + 1)) * LOG2E, sink2 = sinks[hq] * LOG2E;
        const bf16* qp = PROJ + (T0 + 32 * wq + lq) * INW + hq * 64 + 8 * hi;
        bf16x8 qf[4];
#pragma unroll
        for (int ds = 0; ds < 4; ++ds) qf[ds] = *(const GAS bf16x8*)(qp + 16 * ds);
        f32x16 S[5];
#pragma unroll
        for (int i = 0; i < 5; ++i) { const int kt = wq + i; const bool skip = (n == 0 && kt < 4);
#pragma unroll
            for (int r = 0; r < 16; ++r) S[i][r] = 0.f;
            if (!skip) {
#pragma unroll
                for (int ds = 0; ds < 4; ++ds) { const bf16x8 kf = *(const LAS bf16x8*)(Ks + (32 * kt + lq) * KS_ROW + (16 * ds + 8 * hi) * 2);
                    S[i] = __builtin_amdgcn_mfma_f32_32x32x16_bf16(kf, qf[ds], S[i], 0, 0, 0); } }
            __builtin_amdgcn_sched_barrier(0); }
        float mx = sink2;
#pragma unroll
        for (int i = 0; i < 5; ++i) { const bool skip = (n == 0 && wq + i < 4);
#pragma unroll
            for (int r = 0; r < 16; ++r) { const int rel = 128 - 32 * i + lqo - crow(r, hi);
                const bool valid = !skip && (i == 0 ? rel <= 127 : (i == 4 ? rel >= 0 : true));
                const float lg = valid ? S[i][r] - slope2 * (float)rel : -1e30f; S[i][r] = lg; mx = fmaxf(mx, lg); } }
        mx = fmaxf(mx, __shfl_xor(mx, 32));
        float sum = 0.f;
#pragma unroll
        for (int i = 0; i < 5; ++i)
#pragma unroll
            for (int r = 0; r < 16; ++r) { const float p = __builtin_amdgcn_exp2f(S[i][r] - mx); S[i][r] = p; sum += p; }
        sum += __shfl_xor(sum, 32); sum += __builtin_amdgcn_exp2f(sink2 - mx);
        const float inv = 1.0f / sum;
        f32x16 O[2];
#pragma unroll
        for (int r = 0; r < 16; ++r) { O[0][r] = 0.f; O[1][r] = 0.f; }
#pragma unroll
        for (int i = 0; i < 5; ++i) { const int kt = wq + i; const bool skip = (n == 0 && kt < 4);
            if (!skip) {
#pragma unroll
                for (int s = 0; s < 2; ++s) {
                    v4u pw; pw.x = cvtpk(S[i][8 * s + 0], S[i][8 * s + 1]); pw.y = cvtpk(S[i][8 * s + 2], S[i][8 * s + 3]); pw.z = cvtpk(S[i][8 * s + 4], S[i][8 * s + 5]); pw.w = cvtpk(S[i][8 * s + 6], S[i][8 * s + 7]);
                    const bf16x8 pf = __builtin_bit_cast(bf16x8, pw);
#pragma unroll
                    for (int dt = 0; dt < 2; ++dt) { const LAS unsigned short* vp = VT + (32 * dt + lq) * VT_ROW + 32 * kt + 16 * s + 4 * hi;
                        const s16x4 lo = *(const LAS s16x4*)vp, h8 = *(const LAS s16x4*)(vp + 8);
                        const bf16x8 vf = __builtin_shufflevector(lo, h8, 0, 1, 2, 3, 4, 5, 6, 7);
                        O[dt] = __builtin_amdgcn_mfma_f32_32x32x16_bf16(vf, pf, O[dt], 0, 0, 0); } } }
            __builtin_amdgcn_sched_barrier(0); }
        bf16* op = AG + (T0 + 32 * wq + lq) * 1024 + hq * 64 + 4 * hi;
#pragma unroll
        for (int dt = 0; dt < 2; ++dt)
#pragma unroll
            for (int j = 0; j < 4; ++j) { v2u w; w.x = cvtpk(O[dt][4 * j] * inv, O[dt][4 * j + 1] * inv); w.y = cvtpk(O[dt][4 * j + 2] * inv, O[dt][4 * j + 3] * inv);
                *(GAS v2u*)(op + 32 * dt + 8 * j) = w; }
    }
    __syncthreads();
}
constexpr int GV_ROW = 132;
__device__ __forceinline__ void gmlp_unit(Frame& F, const bf16* PROJ, bf16* AG, const float* ln_g, const float* ln_b, const bf16* WSP, const float* b_s, int unit) {
    const int lane = F.lane, wave = F.wave, lq = lane & 31, hi = lane >> 5;
    const int n = unit & 15, b = unit >> 4; const long T0 = (long)b * SEQ + n * 128;
    LAS unsigned short* VT = (LAS unsigned short*)F.lds;
    float gch[8], bch[8];
#pragma unroll
    for (int i = 0; i < 8; ++i) { gch[i] = ln_g[lane + 64 * i]; bch[i] = ln_b[lane + 64 * i]; }
#pragma unroll 1
    for (int hb = 0; hb < 2; ++hb) {
        unsigned short raw[8][8];
#pragma unroll
        for (int tk = 0; tk < 8; ++tk) { const bf16* vp = PROJ + (T0 + 16 * wave + 8 * hb + tk) * INW + C_VG + lane;
#pragma unroll
            for (int i = 0; i < 8; ++i) raw[tk][i] = vp[64 * i]; }
#pragma unroll
        for (int tk = 0; tk < 8; ++tk) { const int s = 16 * wave + 8 * hb + tk;
            float x[8]; float sm = 0.f;
#pragma unroll
            for (int i = 0; i < 8; ++i) { x[i] = bf2f(raw[tk][i]); sm += x[i]; }
            const float mean = wave_sum(sm) * (1.f / 512.f); float q = 0.f;
#pragma unroll
            for (int i = 0; i < 8; ++i) { x[i] -= mean; q += x[i] * x[i]; }
            const float rstd = 1.0f / sqrtf(wave_sum(q) * (1.f / 512.f) + LN_EPS);
#pragma unroll
            for (int i = 0; i < 8; ++i) VT[(lane + 64 * i) * GV_ROW + s] = f2bf(x[i] * rstd * gch[i] + bch[i]); } }
    __syncthreads();
    const int g = wave >> 1, cb = g * 128 + 64 * (wave & 1);
    f32x16 acc[2][4];
#pragma unroll
    for (int mt = 0; mt < 2; ++mt)
#pragma unroll
        for (int nt = 0; nt < 4; ++nt)
#pragma unroll
            for (int r = 0; r < 16; ++r) acc[mt][nt][r] = 0.f;
    const bf16* wg = WSP + (size_t)g * 128 * 128 + (size_t)lq * 128 + 8 * hi;
    bf16x8 bcur[4], bnxt[4];
#pragma unroll
    for (int nt = 0; nt < 4; ++nt) { bcur[nt] = *(const GAS bf16x8*)(wg + (size_t)(32 * nt) * 128); bnxt[nt] = bcur[nt]; }
#pragma unroll 1
    for (int ks = 0; ks < 8; ++ks) {
        if (ks < 7) {
#pragma unroll
            for (int nt = 0; nt < 4; ++nt) if (ks + 1 < 2 * (nt + 1)) bnxt[nt] = *(const GAS bf16x8*)(wg + (size_t)(32 * nt) * 128 + 16 * (ks + 1)); }
        bf16x8 af[2];
#pragma unroll
        for (int mt = 0; mt < 2; ++mt) { const LAS unsigned short* ap = VT + (cb + 32 * mt + lq) * GV_ROW + 16 * ks + 8 * hi;
            const s16x4 lo = *(const LAS s16x4*)ap, h8 = *(const LAS s16x4*)(ap + 4); af[mt] = __builtin_shufflevector(lo, h8, 0, 1, 2, 3, 4, 5, 6, 7); }
#pragma unroll
        for (int nt = 0; nt < 4; ++nt) if (ks < 2 * (nt + 1)) {
#pragma unroll
            for (int mt = 0; mt < 2; ++mt) acc[mt][nt] = __builtin_amdgcn_mfma_f32_32x32x16_bf16(af[mt], bcur[nt], acc[mt][nt], 0, 0, 0); }
#pragma unroll
        for (int nt = 0; nt < 4; ++nt) bcur[nt] = bnxt[nt];
    }
#pragma unroll
    for (int nt = 0; nt < 4; ++nt) { const int t = 32 * nt + lq; const float bias = b_s[g * 128 + t];
        const bf16* up = PROJ + (T0 + t) * INW + C_U + cb + 4 * hi; bf16* op = AG + (T0 + t) * 1024 + 512 + cb + 4 * hi;
#pragma unroll
        for (int mt = 0; mt < 2; ++mt)
#pragma unroll
            for (int j = 0; j < 4; ++j) { const v2u uu = *(const GAS v2u*)(up + 32 * mt + 8 * j);
                v2u w; w.x = cvtpk(bflo(uu.x) * (acc[mt][nt][4 * j] + bias), bfhi(uu.x) * (acc[mt][nt][4 * j + 1] + bias));
                w.y = cvtpk(bflo(uu.y) * (acc[mt][nt][4 * j + 2] + bias), bfhi(uu.y) * (acc[mt][nt][4 * j + 3] + bias));
                *(GAS v2u*)(op + 32 * mt + 8 * j) = w; } }
    __syncthreads();
}
__device__ __forceinline__ void unpack8(const v4u mv, f32x4& a, f32x4& b) { a = (f32x4){bflo(mv.x), bfhi(mv.x), bflo(mv.y), bfhi(mv.y)}; b = (f32x4){bflo(mv.z), bfhi(mv.z), bflo(mv.w), bfhi(mv.w)}; }
struct RowIn { v4u a[2], b[2]; float t; };
__device__ __forceinline__ RowIn row_load(int lane, const bf16* arow, const bf16* brow, const float* ssq) {
    RowIn r; r.t = (lane < 16) ? ssq[lane] : 0.f;
#pragma unroll
    for (int j = 0; j < 2; ++j) { const int c = 8 * lane + 512 * j; r.a[j] = *(const GAS v4u*)(arow + c); r.b[j] = *(const GAS v4u*)(brow + c); }
    return r;
}
__device__ __forceinline__ void e1_finish(int lane, const RowIn& in, bf16* xbrow, float rstd_x, const float* gpost, const float* gpre, bf16* hrow) {
    const float t = wave_sum(in.t);
    const float rstd = 1.0f / sqrtf(t * (1.f / D) + EPS), rx = 1.0f / rstd_x;
    f32x4 h[2][2]; float s = 0.f;
#pragma unroll
    for (int j = 0; j < 2; ++j) { const int c = 8 * lane + 512 * j;
        const f32x4 g0 = *(const GAS f32x4*)(gpost + c), g1 = *(const GAS f32x4*)(gpost + c + 4);
        f32x4 m0, m1, x0, x1; unpack8(in.a[j], m0, m1); unpack8(in.b[j], x0, x1);
        h[j][0] = x0 * rx + m0 * rstd * g0; h[j][1] = x1 * rx + m1 * rstd * g1;
        *(GAS v4u*)(hrow + c) = pg8::pack8(h[j][0], h[j][1]);
#pragma unroll
        for (int e = 0; e < 4; ++e) s += h[j][0][e] * h[j][0][e] + h[j][1][e] * h[j][1][e]; }
    const float r2 = 1.0f / sqrtf(wave_sum(s) * (1.f / D) + EPS);
#pragma unroll
    for (int j = 0; j < 2; ++j) { const int c = 8 * lane + 512 * j; const f32x4 g0 = *(const GAS f32x4*)(gpre + c), g1 = *(const GAS f32x4*)(gpre + c + 4);
        *(GAS v4u*)(xbrow + c) = pg8::pack8(h[j][0] * r2 * g0, h[j][1] * r2 * g1); }
}
__device__ __forceinline__ void e2_finish(int lane, const RowIn& in, const float* gpost, float* orow) {
    const float t = wave_sum(in.t);
    const float rstd = 1.0f / sqrtf(t * (1.f / D) + EPS);
#pragma unroll
    for (int j = 0; j < 2; ++j) { const int c = 8 * lane + 512 * j;
        const f32x4 g0 = *(const GAS f32x4*)(gpost + c), g1 = *(const GAS f32x4*)(gpost + c + 4);
        f32x4 m0, m1, x0, x1; unpack8(in.a[j], m0, m1); unpack8(in.b[j], x0, x1);
        *(GAS f32x4*)(orow + c) = x0 + m0 * rstd * g0; *(GAS f32x4*)(orow + c + 4) = x1 + m1 * rstd * g1; }
}
#define XB_TMO      128
#define XB_XCNT(j)  (256  + 64 * (j))
#define XB_XSUB(j)  (1280 + 64 * (j))
#define XB_XGEN(j)  (2304 + 64 * (j))
#define XB_TOP      3328
#define XB_TOPGEN   3392
#define XCD_BAR_WORDS 3456
#define XB_SPIN_CAP (1u << 18)

__device__ __forceinline__ unsigned xb_ld(unsigned* p)              { return __hip_atomic_load(p, __ATOMIC_RELAXED, __HIP_MEMORY_SCOPE_AGENT); }
__device__ __forceinline__ unsigned xb_add(unsigned* p, unsigned v) { return __hip_atomic_fetch_add(p, v, __ATOMIC_RELAXED, __HIP_MEMORY_SCOPE_AGENT); }
__device__ __forceinline__ unsigned xb_xcc_id() { return (unsigned)__builtin_amdgcn_s_getreg((3 << 11) | 20) & 0xFu; }
#define XB_SPIN(cond, bar) do { unsigned _sp = 0; while (cond) { __builtin_amdgcn_s_sleep(1); \
    if ((++_sp & 255u) == 0u) { if (xb_ld(&(bar)[XB_TMO])) break; if (_sp > XB_SPIN_CAP) { atomicAdd(&(bar)[XB_TMO], 1u); break; } } } } while (0)

struct XcdBarrier {
    unsigned* bar; unsigned x; unsigned G;
    volatile LAS unsigned* st;
};

__device__ __forceinline__ XcdBarrier xcd_barrier_post(unsigned* bar, volatile LAS unsigned* st, int wave, unsigned G) {
    XcdBarrier b; b.bar = bar; b.x = xb_xcc_id(); b.st = st; b.G = G;
    if (pg8::lane_id_opaque() == 0 && wave == 0) (void)xb_add(&bar[XB_XCNT(b.x)], 1u);
    return b;
}
__device__ __forceinline__ void xcd_barrier_complete(unsigned* bar, unsigned x, unsigned& nloc, unsigned& nx, const unsigned G) {
    unsigned sum, cnt, mine, sp = 0u;
    for (;;) {
        sum = 0u; cnt = 0u; mine = 0u;
#pragma unroll
        for (unsigned j = 0; j < 16; ++j) { const unsigned c = xb_ld(&bar[XB_XCNT(j)]); sum += c; cnt += (c > 0u) ? 1u : 0u; mine = (j == x) ? c : mine; }
        if (sum == G) break;
        __builtin_amdgcn_s_sleep(1);
        if ((++sp & 255u) == 0u) { if (xb_ld(&bar[XB_TMO])) break; if (sp > XB_SPIN_CAP) { atomicAdd(&bar[XB_TMO], 1u); break; } }
    }
    nloc = mine > 0u ? mine : 1u; nx = cnt > 0u ? cnt : 1u;
}

__device__ __forceinline__ void xcd_barrier(const XcdBarrier& b, int wave) {
    asm volatile("s_waitcnt vmcnt(0)" ::: "memory");
    __syncthreads();
    if (pg8::lane_id_opaque() == 0 && wave == 0) {
        unsigned* bar = b.bar;
        __builtin_amdgcn_s_waitcnt(0);
        unsigned nloc = b.st[0], nx = b.st[1];
        if (nloc == 0u) { xcd_barrier_complete(bar, b.x, nloc, nx, b.G); b.st[0] = nloc; b.st[1] = nx; }
        const unsigned old = xb_add(&bar[XB_XSUB(b.x)], 1u);
        const unsigned gen = old / nloc;
        if (old + 1u == (gen + 1u) * nloc) {
            __builtin_amdgcn_fence(__ATOMIC_RELEASE, "agent");
            asm volatile("s_waitcnt vmcnt(0)" ::: "memory");
            const unsigned og = xb_add(&bar[XB_TOP], 1u);
            const unsigned tg = og / nx;
            if (og + 1u == (tg + 1u) * nx) xb_add(&bar[XB_TOPGEN], 1u);
            else XB_SPIN(xb_ld(&bar[XB_TOPGEN]) == tg, bar);
            __builtin_amdgcn_fence(__ATOMIC_ACQUIRE, "agent");
            xb_add(&bar[XB_XGEN(b.x)], 1u);
            asm volatile("s_waitcnt vmcnt(0)" ::: "memory");
        } else {
            XB_SPIN(xb_ld(&bar[XB_XGEN(b.x)]) == gen, bar);
            __builtin_amdgcn_fence(__ATOMIC_ACQUIRE, "agent");
            asm volatile("s_waitcnt vmcnt(0)" ::: "memory");
        }
    }
    __syncthreads();
}

constexpr int N_PHASES = 9;
struct Args { const float* in[17]; float* out; unsigned char* ws; int ph_lo, ph_hi; };
__global__ void __launch_bounds__(NTHR, 2) fwd_megakernel(Args args) {
    extern __shared__ __attribute__((aligned(16))) unsigned char lds[];
    cg::grid_group grid = cg::this_grid();
    Frame F;
    F.lds = (LAS unsigned char*)lds;
    F.wave = __builtin_amdgcn_readfirstlane(threadIdx.x >> 6);
#define RETID() do { F.lane = pg8::lane_id_opaque(); F.tid = F.wave * 64 + F.lane; } while (0)
    RETID();
    const bool two = (gridDim.x == 256);
    const int team = two ? ((int)(blockIdx.x >> 3) & 1) : 0;
    const int GT = two ? 128 : (int)gridDim.x, tc = two ? (int)((blockIdx.x & 7) + 8 * (blockIdx.x >> 4)) : (int)blockIdx.x;
    const int MT = two ? M / 2 : M; const size_t roff = (size_t)team * (size_t)MT;
    F.G = GT; F.bid = tc;
    const __attribute__((address_space(4))) char* kargp = (const __attribute__((address_space(4))) char*)__builtin_amdgcn_kernarg_segment_ptr();
#define LAZY_IN(k) (F.in[k] = *(const float* const volatile __attribute__((address_space(4)))*)(kargp + 8 * (k)))
    F.out = args.out; F.ws = args.ws;
    unsigned char* ws = args.ws;
    const int lo = args.ph_lo, hi = args.ph_hi;
    volatile LAS unsigned* MISC = (volatile LAS unsigned*)(F.lds + MISC_OFF);
    if (F.tid < 16) MISC[F.tid] = 0u;
    __syncthreads();
    XcdBarrier bar = xcd_barrier_post((unsigned*)(ws + WS_CTL), MISC, F.wave, gridDim.x);
    XcdBarrier tbar = xcd_barrier_post((unsigned*)(ws + WS_CTL) + (1 + team) * BAR_REGION_WORDS, MISC + 2, F.wave, (unsigned)GT);
#define W_IN ((bf16*)(ws + WS_WIN))
#define W_AB ((bf16*)(ws + WS_WAB))
#define W_OUT ((bf16*)(ws + WS_WOUT))
#define W_GU ((bf16*)(ws + WS_WGU))
#define W_D ((bf16*)(ws + WS_WD))
#define W_SP ((bf16*)(ws + WS_WSP))
#define SSQA ((float*)(ws + WS_SSQA) + roff * 16)
#define SSQB ((float*)(ws + WS_SSQB) + roff * 16)
#define RSTDT ((float*)(ws + WS_RSTD) + roff)
#define XN ((bf16*)(ws + WS_XN) + roff * D)
#define AG ((bf16*)(ws + WS_AG) + roff * D)
#define MG ((bf16*)(ws + WS_MG) + roff * D)
#define PROJ ((bf16*)(ws + WS_PROJ) + roff * INW)
#define MIX AG
#define FFO MG
#define HN XN
#define HB PROJ
#define HB16 (PROJ + (size_t)MT * FF)
#define OUT (args.out + roff * D)
#define IN(k) (lo <= (k) && (k) < hi)
    if (hi < 0) grid.sync();
#define SEAM(k) do { if (IN(k) && IN((k) + 1)) xcd_barrier(tbar, F.wave); else __syncthreads(); RETID(); } while (0)

    if (IN(0)) { LAZY_IN(0); LAZY_IN(1); LAZY_IN(2); LAZY_IN(6); LAZY_IN(8); LAZY_IN(9); LAZY_IN(10); LAZY_IN(13); LAZY_IN(14); LAZY_IN(15);
        if (!two || team == 1) p0_weights(F);
        if (!two || team == 0) p0_rows(F, F.in[0] + roff * D, RSTDT, XN, MT);
        xcd_barrier(bar, F.wave); RETID();
        if (two && team == 1) { p0_rows(F, F.in[0] + roff * D, RSTDT, XN, MT); xcd_barrier(tbar, F.wave); RETID(); } }
    if (IN(1)) { pg8::Gemm g{XN, W_IN, MT, INW, D}; pg8::StaticOrder S; S.init(MT, INW, F.G, F.bid); pg8::EpiProj E{PROJ};
        pg8::gemm_phase<pg8::EpiProj, pg8::StaticOrder, true, true>(F.lds, g, S, E, F.wave); }
    SEAM(1);
    if (IN(2)) { LAZY_IN(3); LAZY_IN(4); LAZY_IN(5); LAZY_IN(7);
        for (int u = F.bid; u < MT / 64; u += F.G) attn_unit(F, PROJ, AG, F.in[3], u);
        for (int u = F.bid; u < MT / 128; u += F.G) gmlp_unit(F, PROJ, AG, F.in[4], F.in[5], W_SP, F.in[7], u);
    }
    SEAM(2);
    if (IN(3)) { pg8::Gemm g{AG, W_AB, MT, D, D}; pg8::StaticOrder S; S.init(MT, D, F.G, F.bid); pg8::EpiMerge E{PROJ, MG};
        pg8::gemm_phase<pg8::EpiMerge, pg8::StaticOrder, true, true>(F.lds, g, S, E, F.wave); }
    SEAM(3);
    if (IN(4)) { pg8::Gemm g{MG, W_OUT, MT, D, D}; pg8::StaticOrder S; S.init(MT, D, F.G, F.bid); pg8::EpiSsq E{MIX, SSQA};
        pg8::gemm_phase<pg8::EpiSsq, pg8::StaticOrder, true, true>(F.lds, g, S, E, F.wave); }
    SEAM(4);
    if (IN(5)) { LAZY_IN(11); LAZY_IN(12); const int gw = F.bid * NWAVES + F.wave, NGW = F.G * NWAVES;
        const float* RSTD = RSTDT;
        for (int m = gw; m < MT; m += 2 * NGW) { const int m2 = (m + NGW < MT) ? m + NGW : m;
            const RowIn ra = row_load(F.lane, MIX + (size_t)m * D, HN + (size_t)m * D, SSQA + (size_t)m * 16), rb = row_load(F.lane, MIX + (size_t)m2 * D, HN + (size_t)m2 * D, SSQA + (size_t)m2 * 16);
            const float rxa = RSTD[m], rxb = RSTD[m2];
            e1_finish(F.lane, ra, HN + (size_t)m * D, rxa, F.in[11], F.in[12], HB16 + (size_t)m * D);
            e1_finish(F.lane, rb, HN + (size_t)m2 * D, rxb, F.in[11], F.in[12], HB16 + (size_t)m2 * D); } }
    SEAM(5);
    if (IN(6)) { pg8::Gemm g{HN, W_GU, MT, 2 * FF, D}; pg8::StaticOrder S; S.init(MT, 2 * FF, F.G, F.bid); pg8::EpiSwiglu E{HB};
        pg8::gemm_phase<pg8::EpiSwiglu, pg8::StaticOrder, true, true>(F.lds, g, S, E, F.wave); }
    SEAM(6);
    if (IN(7)) { pg8::Gemm g{HB, W_D, MT, D, FF}; pg8::StaticOrder S; S.init(MT, D, F.G, F.bid); pg8::EpiSsq E{FFO, SSQB};
        pg8::gemm_phase<pg8::EpiSsq, pg8::StaticOrder, true, true>(F.lds, g, S, E, F.wave); }
    SEAM(7);
    if (IN(8)) { LAZY_IN(16); const int gw = F.bid * NWAVES + F.wave, NGW = F.G * NWAVES;
        for (int m = gw; m < MT; m += 2 * NGW) { const int m2 = (m + NGW < MT) ? m + NGW : m;
            const RowIn ra = row_load(F.lane, FFO + (size_t)m * D, HB16 + (size_t)m * D, SSQB + (size_t)m * 16), rb = row_load(F.lane, FFO + (size_t)m2 * D, HB16 + (size_t)m2 * D, SSQB + (size_t)m2 * 16);
            e2_finish(F.lane, ra, F.in[16], OUT + (size_t)m * D);
            e2_finish(F.lane, rb, F.in[16], OUT + (size_t)m2 * D); } }
#undef IN
#undef SEAM
}

extern "C" void kernel_launch(void* const* d_in, const int* in_sizes, int n_in, void* d_out, int out_size, void* d_ws, size_t ws_size, hipStream_t stream) {
    static int grid = 0;
    if (grid == 0) {
        if (n_in != 17 || out_size != M * D || ws_size < WS_END) { fprintf(stderr, "kernel_launch: unexpected problem: n_in %d out %d ws %zu\n", n_in, out_size, ws_size); grid = -1; return; }
        int dev = 0, cus = 0, per_cu = 0;
        (void)hipGetDevice(&dev); (void)hipDeviceGetAttribute(&cus, hipDeviceAttributeMultiprocessorCount, dev);
        if (hipFuncSetAttribute((const void*)fwd_megakernel, hipFuncAttributeMaxDynamicSharedMemorySize, LDS_BYTES) != hipSuccess) fprintf(stderr, "kernel_launch: hipFuncSetAttribute failed\n");
        if (hipOccupancyMaxActiveBlocksPerMultiprocessor(&per_cu, (const void*)fwd_megakernel, NTHR, LDS_BYTES) != hipSuccess || per_cu < 1) { fprintf(stderr, "kernel_launch: occupancy query says %d\n", per_cu); per_cu = 1; }
        (void)hipGetLastError();
        grid = cus * per_cu;
        fprintf(stderr, "kernel_launch: grid %d (cus %d x %d)\n", grid, cus, per_cu);
    }
    if (grid < 0) return;
    if (hipMemsetAsync((char*)d_ws + WS_CTL, 0, CTL_BYTES, stream) != hipSuccess) { fprintf(stderr, "kernel_launch: hipMemsetAsync failed\n"); return; }
    Args a{};
    for (int i = 0; i < 17; ++i) a.in[i] = (const float*)d_in[i];
    a.out = (float*)d_out; a.ws = (unsigned char*)d_ws;
#if MK_N_LAUNCHES == 1
    a.ph_lo = 0; a.ph_hi = N_PHASES;
    void* kargs[] = {&a};
    hipError_t e = hipLaunchCooperativeKernel((const void*)fwd_megakernel, dim3(grid), dim3(NTHR), kargs, LDS_BYTES, stream);
    if (e != hipSuccess) fprintf(stderr, "kernel_launch: cooperative launch failed: %s (grid %d)\n", hipGetErrorString(e), grid);
#else
    for (int k = 0; k < N_PHASES; ++k) { a.ph_lo = k; a.ph_hi = k + 1;
        hipLaunchKernelGGL(fwd_megakernel, dim3(grid), dim3(NTHR), LDS_BYTES, stream, a);
        const hipError_t le = hipPeekAtLastError(); if (le != hipSuccess) { fprintf(stderr, "kernel_launch: launch %d failed: %s\n", k, hipGetErrorName(le)); break; } }
#endif
}
```

```cpp
#include <hip/hip_runtime.h>
#include <hip/hip_cooperative_groups.h>
#include <cstdio>
#include <cstdint>
namespace cg = cooperative_groups;
#ifndef MK_N_LAUNCHES
#define MK_N_LAUNCHES 1
#endif
namespace pg8 {
#define PG8_LAS __attribute__((address_space(3)))
typedef unsigned short bf16_t;
typedef short bf16x8 __attribute__((ext_vector_type(8)));
typedef float f32x4 __attribute__((ext_vector_type(4)));
typedef unsigned u32x4 __attribute__((ext_vector_type(4)));
constexpr int BM = 256, BK = 64, HALF = 128, HTB = HALF * BK * 2  , STAGE_BYTES = 8 * HTB, NXCD = 8, WGM = 8;

__host__ __device__ __forceinline__ int lds_byte(int r, int c) { const int st = (r >> 4) * 2 + (c >> 5), rr = r & 15, cc = c & 31, ob = rr * 64 + cc * 2; return st * 1024 + (ob ^ (((ob >> 9) & 1) << 5)); }
__host__ __device__ __forceinline__ void stage_rc(int b, int& R, int& C) { const int st = b / 1024, sb = b % 1024, swz = sb ^ (((sb >> 9) & 1) << 5); R = (st >> 1) * 16 + swz / 64; C = (st & 1) * 32 + (swz % 64) / 2; }
__host__ __device__ __forceinline__ int perm32(int rho) { const int n = rho >> 4, i = rho & 15; return 8 * (i >> 2) + 4 * n + (i & 3); }

__device__ __forceinline__ int lane_id_opaque() { int l; asm volatile("v_mbcnt_lo_u32_b32 %0, -1, 0\n\tv_mbcnt_hi_u32_b32 %0, -1, %0" : "=v"(l)); return l; }
struct Unit { int pm, pn; };
struct Gemm { const bf16_t* A; const bf16_t* Bt; int M, N, K; };

struct StaticOrder {
    int nM, nN, nwg, G, c;
    __host__ __device__ void init(int M, int N, int G_, int c_) { nM = M / BM; nN = N / BM; nwg = nM * nN; G = G_; c = c_; }
    __host__ __device__ bool next(int i, Unit& u) const {
        const long L = (long)i * G + c; if (L >= nwg) return false;
        int wgid = (int)L; { const int q = nwg / NXCD, r = nwg % NXCD, xcd = wgid % NXCD, off = wgid / NXCD; wgid = (xcd < r ? xcd * (q + 1) : r * (q + 1) + (xcd - r) * q) + off; }
        const int nig = WGM * nN, gid = wgid / nig, fm = gid * WGM, gsz = (nM - fm) < WGM ? (nM - fm) : WGM;
        u.pm = fm + ((wgid % nig) % gsz); u.pn = (wgid % nig) / gsz; return true;
    }
    __device__ __forceinline__ void a_ready(const Unit&) const {}
    __device__ __forceinline__ void done(const Unit&) const {}
};

__device__ __forceinline__ unsigned cvt_pk_bf16(float lo, float hi) { unsigned r; asm volatile("v_cvt_pk_bf16_f32 %0, %1, %2" : "=v"(r) : "v"(lo), "v"(hi)); return r; }
typedef float f32x2 __attribute__((ext_vector_type(2)));
__device__ __forceinline__ f32x2 gelu_pk(f32x2 v) {
    const f32x2 av = __builtin_elementwise_abs(v), d = av * 0.2316418882f + 1.0f;
    f32x2 t; t.x = __builtin_amdgcn_rcpf(d.x); t.y = __builtin_amdgcn_rcpf(d.y);
    f32x2 q = t * 0.5307027145f + (-0.7265760135f); q = q * t + 0.7107068705f; q = q * t + (-0.142248368f); q = q * t + 0.127414796f; q = q * t;
    const f32x2 s = (v * v) * (-0.72134752044f);
    f32x2 e; e.x = __builtin_amdgcn_exp2f(s.x); e.y = __builtin_amdgcn_exp2f(s.y);
    const f32x2 m = v * (q * e), r = v - m;
    f32x2 o; o.x = v.x < 0.f ? m.x : r.x; o.y = v.y < 0.f ? m.y : r.y; return o;
}
typedef __bf16 bf16x2_t __attribute__((ext_vector_type(2)));
__device__ __forceinline__ unsigned cvtpk(float lo, float hi) { f32x2 v = {lo, hi}; bf16x2_t b = __builtin_convertvector(v, bf16x2_t); return __builtin_bit_cast(unsigned, b); }
__device__ __forceinline__ float bflo(unsigned u) { return __uint_as_float(u << 16); }
__device__ __forceinline__ float bfhi(unsigned u) { return __uint_as_float(u & 0xffff0000u); }
__device__ __forceinline__ float sigm(float x) { return __builtin_amdgcn_rcpf(1.0f + __builtin_amdgcn_exp2f(-1.4426950408889634f * x)); }
__device__ __forceinline__ u32x4 pack8(f32x4 v0, f32x4 v1) { u32x4 w; w.x = cvtpk(v0[0], v0[1]); w.y = cvtpk(v0[2], v0[3]); w.z = cvtpk(v1[0], v1[1]); w.w = cvtpk(v1[2], v1[3]); return w; }
constexpr int PROJ_LD = 3840;
constexpr float QSCALE = 0.125f * 1.4426950408889634f;

struct EpiProj {
    static constexpr bool PERM = true, AFTER_DRAIN = false, MID = false; static constexpr int NST = 14;
    bf16_t* O;
    __device__ __forceinline__ void mid(f32x4 (&)[2][2][4][2], const Unit&, int, int, int, int) const {}
    __device__ __forceinline__ void operator()(const f32x4 (&acc)[2][2][4][2], const Unit& u, int wr, int wc, int fr, int fq) const {
        { const int l_ = lane_id_opaque(); fr = l_ & 15; fq = l_ >> 4; }
        const int row0 = u.pm * BM + wr * 64 + fr, col0 = u.pn * BM + wc * 32 + 8 * fq;
        const int mode = u.pn < 3 ? 0 : (u.pn < 7 ? 1 : 2); const float sc = u.pn < 2 ? QSCALE : 1.0f;
#pragma unroll
        for (int ai = 0; ai < 2; ++ai)
#pragma unroll
            for (int m = 0; m < 4; ++m) { bf16_t* rowp = O + (size_t)(row0 + ai * HALF + m * 16) * PROJ_LD + col0;
#pragma unroll
                for (int bj = 0; bj < 2; ++bj) { f32x4 v0 = acc[ai][bj][m][0], v1 = acc[ai][bj][m][1];
                    if (mode == 1) { f32x2 a = gelu_pk((f32x2){v0[0], v0[1]}), b = gelu_pk((f32x2){v0[2], v0[3]}), c = gelu_pk((f32x2){v1[0], v1[1]}), d = gelu_pk((f32x2){v1[2], v1[3]});
                        v0 = (f32x4){a.x, a.y, b.x, b.y}; v1 = (f32x4){c.x, c.y, d.x, d.y}; }
                    else if (mode == 2) { v0 = (f32x4){sigm(v0[0]), sigm(v0[1]), sigm(v0[2]), sigm(v0[3])}; v1 = (f32x4){sigm(v1[0]), sigm(v1[1]), sigm(v1[2]), sigm(v1[3])}; }
                    else { v0 = v0 * sc; v1 = v1 * sc; }
                    *(u32x4*)(rowp + bj * HALF) = pack8(v0, v1); } }
    }
};
struct EpiMerge {
    static constexpr bool PERM = true, AFTER_DRAIN = false, MID = true; static constexpr int NST = 14;
    const bf16_t* P; bf16_t* O;
    __device__ __forceinline__ void mid(f32x4 (&acc)[2][2][4][2], const Unit& u, int wr, int wc, int fr, int fq) const {
        { const int l_ = lane_id_opaque(); fr = l_ & 15; fq = l_ >> 4; }
        const int row0 = u.pm * BM + wr * 64 + fr, col0 = u.pn * BM + wc * 32 + 8 * fq;
#pragma unroll
        for (int ai = 0; ai < 2; ++ai)
#pragma unroll
            for (int m = 0; m < 4; ++m) { const bf16_t* rowp = P + (size_t)(row0 + ai * HALF + m * 16) * PROJ_LD + col0;
#pragma unroll
                for (int bj = 0; bj < 2; ++bj) { const u32x4 a = *(const u32x4*)(rowp + 1792 + bj * HALF), b = *(const u32x4*)(rowp + 2816 + bj * HALF);
                    f32x4 r0, r1;
                    r0[0] = bflo(a.x) * __builtin_amdgcn_rcpf(bflo(b.x)); r0[1] = bfhi(a.x) * __builtin_amdgcn_rcpf(bfhi(b.x)); r0[2] = bflo(a.y) * __builtin_amdgcn_rcpf(bflo(b.y)); r0[3] = bfhi(a.y) * __builtin_amdgcn_rcpf(bfhi(b.y));
                    r1[0] = bflo(a.z) * __builtin_amdgcn_rcpf(bflo(b.z)); r1[1] = bfhi(a.z) * __builtin_amdgcn_rcpf(bfhi(b.z)); r1[2] = bflo(a.w) * __builtin_amdgcn_rcpf(bflo(b.w)); r1[3] = bfhi(a.w) * __builtin_amdgcn_rcpf(bfhi(b.w));
                    acc[ai][bj][m][0] *= r0; acc[ai][bj][m][1] *= r1; }
                if (m & 1) asm volatile("" ::: "memory"); }
    }
    __device__ __forceinline__ void operator()(const f32x4 (&acc)[2][2][4][2], const Unit& u, int wr, int wc, int fr, int fq) const {
        { const int l_ = lane_id_opaque(); fr = l_ & 15; fq = l_ >> 4; }
        const int row0 = u.pm * BM + wr * 64 + fr, col0 = u.pn * BM + wc * 32 + 8 * fq;
#pragma unroll
        for (int ai = 0; ai < 2; ++ai)
#pragma unroll
            for (int m = 0; m < 4; ++m) { const size_t row = (size_t)(row0 + ai * HALF + m * 16); const bf16_t* rowp = P + row * PROJ_LD + col0;
#pragma unroll
                for (int bj = 0; bj < 2; ++bj) { const u32x4 b = *(const u32x4*)(rowp + 2816 + bj * HALF);
                    const f32x4 s0 = {bflo(b.x), bfhi(b.x), bflo(b.y), bfhi(b.y)}, s1 = {bflo(b.z), bfhi(b.z), bflo(b.w), bfhi(b.w)};
                    *(u32x4*)(O + row * 1024 + col0 + bj * HALF) = pack8(acc[ai][bj][m][0] * s0, acc[ai][bj][m][1] * s1); }
                asm volatile("" ::: "memory"); }
    }
};
struct EpiSsq {
    static constexpr bool PERM = true, AFTER_DRAIN = false, MID = false; static constexpr int NST = 20;
    bf16_t* O; float* ssq;
    __device__ __forceinline__ void mid(f32x4 (&)[2][2][4][2], const Unit&, int, int, int, int) const {}
    __device__ __forceinline__ void operator()(const f32x4 (&acc)[2][2][4][2], const Unit& u, int wr, int wc, int fr, int fq) const {
        { const int l_ = lane_id_opaque(); fr = l_ & 15; fq = l_ >> 4; }
        const int row0 = u.pm * BM + wr * 64 + fr, col0 = u.pn * BM + wc * 32 + 8 * fq;
#pragma unroll
        for (int ai = 0; ai < 2; ++ai)
#pragma unroll
            for (int m = 0; m < 4; ++m) { const size_t row = (size_t)(row0 + ai * HALF + m * 16); float s = 0.f;
#pragma unroll
                for (int bj = 0; bj < 2; ++bj) { const f32x4 v0 = acc[ai][bj][m][0], v1 = acc[ai][bj][m][1];
                    s += (v0[0] * v0[0] + v0[1] * v0[1]) + (v0[2] * v0[2] + v0[3] * v0[3]) + (v1[0] * v1[0] + v1[1] * v1[1]) + (v1[2] * v1[2] + v1[3] * v1[3]);
                    *(u32x4*)(O + row * 1024 + col0 + bj * HALF) = pack8(v0, v1); }
                s += __shfl_xor(s, 16); s += __shfl_xor(s, 32);
                if (fq == 0) ssq[row * 16 + u.pn * 4 + wc] = s; }
    }
};
struct EpiSwiglu {
    static constexpr bool PERM = true, AFTER_DRAIN = false, MID = false; static constexpr int NST = 7;
    bf16_t* O;
    __device__ __forceinline__ void mid(f32x4 (&)[2][2][4][2], const Unit&, int, int, int, int) const {}
    __device__ __forceinline__ void operator()(const f32x4 (&acc)[2][2][4][2], const Unit& u, int wr, int wc, int fr, int fq) const {
        { const int l_ = lane_id_opaque(); fr = l_ & 15; fq = l_ >> 4; }
        const int row0 = u.pm * BM + wr * 64 + fr, col0 = u.pn * HALF + wc * 32 + 8 * fq;
#pragma unroll
        for (int ai = 0; ai < 2; ++ai)
#pragma unroll
            for (int m = 0; m < 4; ++m) { const size_t row = (size_t)(row0 + ai * HALF + m * 16);
                const f32x4 g0 = acc[ai][0][m][0], g1 = acc[ai][0][m][1], u0 = acc[ai][1][m][0], u1 = acc[ai][1][m][1];
                f32x4 h0, h1;
#pragma unroll
                for (int e = 0; e < 4; ++e) { h0[e] = g0[e] * sigm(g0[e]) * u0[e]; h1[e] = g1[e] * sigm(g1[e]) * u1[e]; }
                *(u32x4*)(O + row * 2816 + col0) = pack8(h0, h1); }
    }
};
template <class Epi, class Sched, bool ALIGN_EPI = false, bool SP2 = false>
__device__ __forceinline__ void gemm_phase(PG8_LAS unsigned char* lds, const Gemm g, const Sched& S, const Epi& E, int wid) {
    const int lane = lane_id_opaque(), tid = wid * 64 + lane, wr = wid >> 2, wc = wid & 3, fr = lane & 15, fq = lane >> 4;
    const int K = g.K, nt = K / BK;
    unsigned voffA[2], voffB[2];
#pragma unroll
    for (int i = 0; i < 2; ++i) { int R, C; stage_rc(tid * 16 + i * 8192, R, C); const int Rb = Epi::PERM ? ((R & ~31) + perm32(R & 31)) : R;
        voffA[i] = (unsigned)(R * K + C) * 2u; voffB[i] = (unsigned)(Rb * K + C) * 2u; }
    const size_t kstep = (size_t)(BK * 2);
    const size_t hstep = (size_t)HALF * K * 2;
    const size_t tstep = 2 * hstep;
    const unsigned ldsw = (unsigned)wid * 1024u;
    const int aoff = lds_byte(wr * 64 + fr, fq * 8), boff = lds_byte(wc * 32 + fr, fq * 8);
#define PG8_SA(b, h) (((b) * 2 + (h)) * HTB)
#define PG8_SB(b, h) ((4 + (b) * 2 + (h)) * HTB)
#define PG8_STAGE(bufoff, gbase, voff) do { _Pragma("unroll") for (int _i = 0; _i < 2; ++_i) \
        __builtin_amdgcn_global_load_lds((const unsigned*)((const char*)(gbase) + (voff)[_i]), (PG8_LAS unsigned*)(lds + (bufoff) + ldsw + _i * 8192), 16, 0, 0); } while (0)
#define PG8_LDA(dst, b, h) do { _Pragma("unroll") for (int m = 0; m < 4; ++m) _Pragma("unroll") for (int k = 0; k < 2; ++k) dst[m][k] = *(const PG8_LAS bf16x8*)(lds + PG8_SA(b, h) + aoff + m * 2048 + k * 1024); } while (0)
#define PG8_LDB(dst, b, h) do { _Pragma("unroll") for (int n = 0; n < 2; ++n) _Pragma("unroll") for (int k = 0; k < 2; ++k) dst[n][k] = *(const PG8_LAS bf16x8*)(lds + PG8_SB(b, h) + boff + n * 2048 + k * 1024); } while (0)
#define PG8_MMA(ai, bj, At, Bt) do { __builtin_amdgcn_s_setprio(1); _Pragma("unroll") for (int m = 0; m < 4; ++m) _Pragma("unroll") for (int n = 0; n < 2; ++n) _Pragma("unroll") for (int k = 0; k < 2; ++k) \
        acc[ai][bj][m][n] = __builtin_amdgcn_mfma_f32_16x16x32_bf16(Bt[n][k], At[m][k], acc[ai][bj][m][n], 0, 0, 0); __builtin_amdgcn_s_setprio(0); } while (0)
#define PG8_WAIT_V(n) asm volatile("s_waitcnt vmcnt(" #n ")" ::: "memory")
#define PG8_WAIT_L(n) asm volatile("s_waitcnt lgkmcnt(" #n ")" ::: "memory")
#define PG8_WAIT_RLXC() PG8_WAIT_V(8)
#define PG8_BAR __builtin_amdgcn_s_barrier()
#define PG8_SCHED __builtin_amdgcn_sched_barrier(0)
    Unit cur, nxt; int ui = 0;
    if (!S.next(0, cur)) return;
    f32x4 acc[2][2][4][2];
#pragma unroll
    for (int a = 0; a < 2; ++a)
#pragma unroll
        for (int b = 0; b < 2; ++b)
#pragma unroll
            for (int m = 0; m < 4; ++m)
#pragma unroll
                for (int n = 0; n < 2; ++n) acc[a][b][m][n] = (f32x4){0.f, 0.f, 0.f, 0.f};
    bf16x8 At[4][2], B0[2][2], B1[2][2];
    const char* cA = (const char*)g.A + (size_t)cur.pm * tstep; const char* cB = (const char*)g.Bt + (size_t)cur.pn * tstep;
    S.a_ready(cur);
    if constexpr (SP2) {
        PG8_STAGE(PG8_SB(0, 0), cB, voffB); PG8_STAGE(PG8_SB(0, 1), cB + hstep, voffB); PG8_STAGE(PG8_SA(0, 0), cA, voffA); PG8_STAGE(PG8_SA(0, 1), cA + hstep, voffA);
        if (wr == 1) PG8_BAR;
        PG8_WAIT_V(2); PG8_BAR;
        PG8_STAGE(PG8_SB(1, 0), cB + kstep, voffB); PG8_STAGE(PG8_SA(1, 0), cA + kstep, voffA); PG8_STAGE(PG8_SB(1, 1), cB + hstep + kstep, voffB);
        PG8_WAIT_V(0); PG8_BAR;
    } else {
        PG8_STAGE(PG8_SB(0, 0), cB, voffB); PG8_STAGE(PG8_SA(0, 0), cA, voffA); PG8_STAGE(PG8_SB(0, 1), cB + hstep, voffB); PG8_STAGE(PG8_SA(0, 1), cA + hstep, voffA);
        if (wr == 1) PG8_BAR;
        PG8_WAIT_V(4); PG8_BAR;
        PG8_STAGE(PG8_SB(1, 0), cB + kstep, voffB); PG8_STAGE(PG8_SA(1, 0), cA + kstep, voffA); PG8_STAGE(PG8_SB(1, 1), cB + hstep + kstep, voffB);
        PG8_WAIT_V(6); PG8_BAR;
    }
    for (;;) {
        const bool has_next = S.next(ui + 1, nxt);
        const char* nA = has_next ? (const char*)g.A + (size_t)nxt.pm * tstep : cA; const char* nB = has_next ? (const char*)g.Bt + (size_t)nxt.pn * tstep : cB;
#define PG8_ITER(T, WAITV) do { const int t = (T); \
            const bool last = (t == nt - 2); \
            if constexpr (Epi::MID) { if (t == (nt >> 1)) E.mid(acc, cur, wr, wc, fr, fq); } \
            const char* a1 = cA + (size_t)(t + 1) * kstep; \
            const char* a2 = last ? nA : cA + (size_t)(t + 2) * kstep; const char* b2 = last ? nB : cB + (size_t)(t + 2) * kstep; \
            const char* a3 = a2 + kstep; const char* b3 = b2 + kstep; \
            if (last && has_next) S.a_ready(nxt); \
              \
            PG8_LDB(B0, 0, 0); PG8_LDB(B1, 0, 1); PG8_SCHED; PG8_LDA(At, 0, 0); PG8_STAGE(PG8_SA(1, 1), a1 + hstep, voffA); \
            WAITV; PG8_WAIT_L(0); PG8_BAR; PG8_MMA(0, 0, At, B0); PG8_MMA(0, 1, At, B1); PG8_BAR; PG8_SCHED; \
              \
            PG8_LDA(At, 0, 1); PG8_STAGE(PG8_SB(0, 0), b2, voffB); PG8_STAGE(PG8_SB(0, 1), b2 + hstep, voffB); PG8_STAGE(PG8_SA(0, 0), a2, voffA); \
            WAITV; PG8_WAIT_L(0); PG8_BAR; PG8_MMA(1, 0, At, B0); PG8_MMA(1, 1, At, B1); PG8_BAR; PG8_SCHED; \
              \
            PG8_LDB(B0, 1, 0); PG8_LDB(B1, 1, 1); PG8_SCHED; PG8_LDA(At, 1, 0); PG8_STAGE(PG8_SA(0, 1), a2 + hstep, voffA); \
            PG8_WAIT_V(8); PG8_WAIT_L(0); PG8_BAR; PG8_MMA(0, 0, At, B0); PG8_MMA(0, 1, At, B1); PG8_BAR; PG8_SCHED; \
              \
            PG8_LDA(At, 1, 1); PG8_STAGE(PG8_SB(1, 0), b3, voffB); PG8_STAGE(PG8_SB(1, 1), b3 + hstep, voffB); PG8_STAGE(PG8_SA(1, 0), a3, voffA); \
            PG8_WAIT_V(8); PG8_WAIT_L(0); PG8_BAR; PG8_MMA(1, 0, At, B0); PG8_MMA(1, 1, At, B1); PG8_BAR; PG8_SCHED; } while (0)
        static_assert(SP2, "only the SP2 loop is kept");
        PG8_ITER(0, PG8_WAIT_RLXC());
        for (int tt = 2; tt < nt; tt += 2) { PG8_ITER(tt, PG8_WAIT_V(8)); }
        if constexpr (ALIGN_EPI) { if (wr == 0) PG8_BAR; }
        if constexpr (!Epi::AFTER_DRAIN) { E(acc, cur, wr, wc, fr, fq); S.done(cur); }
        if (!has_next) break;
#pragma unroll
        for (int a = 0; a < 2; ++a)
#pragma unroll
            for (int b = 0; b < 2; ++b)
#pragma unroll
                for (int m = 0; m < 4; ++m)
#pragma unroll
                    for (int n = 0; n < 2; ++n) acc[a][b][m][n] = (f32x4){0.f, 0.f, 0.f, 0.f};
        cur = nxt; cA = nA; cB = nB; ++ui;
        if constexpr (ALIGN_EPI) { if (wr == 1) PG8_BAR; }
    }
    PG8_WAIT_V(0);
    if constexpr (!ALIGN_EPI) { if (wr == 0) PG8_BAR; }
    PG8_BAR;
    if constexpr (Epi::AFTER_DRAIN) { E.fused(acc, cur, wr, wc, fr, fq, lds, wid, lane); S.done(cur); }
#undef PG8_SA
#undef PG8_SB
#undef PG8_STAGE
#undef PG8_LDA
#undef PG8_LDB
#undef PG8_MMA
#undef PG8_WAIT_V
#undef PG8_WAIT_L
#undef PG8_WAIT_RLXC
#undef PG8_ITER
#undef PG8_BAR
#undef PG8_SCHED
}
}

constexpr int NWAVES = 8, NTHR = 512;
constexpr int BATCH = 32, SEQ = 2048, D = 1024, M = BATCH * SEQ;
constexpr int INW = 3840, FF = 2816;
constexpr int C_K = 512, C_V = 640, C_U = 768, C_VG = 1280;
constexpr float EPS = 1e-6f, LN_EPS = 1e-5f, LOG2E = 1.4426950408889634f;
constexpr size_t MiB = 1u << 20;
constexpr size_t WS_WIN = 0;
constexpr size_t WS_WAB = 8 * MiB;
constexpr size_t WS_WOUT = 10 * MiB;
constexpr size_t WS_WGU = 12 * MiB;
constexpr size_t WS_WD = 24 * MiB;
constexpr size_t WS_WSP = 30 * MiB;
constexpr size_t WS_CTL = 31 * MiB + 512 * 1024;
constexpr int CTL_BYTES = 3 * 16384, BAR_REGION_WORDS = 4096, MISC_OFF = 147456 - 64;
constexpr size_t WS_RSTD = 31 * MiB;
constexpr size_t WS_SSQA = 32 * MiB;
constexpr size_t WS_SSQB = 36 * MiB;
constexpr size_t WS_XN = 40 * MiB;
constexpr size_t WS_AG = 168 * MiB;
constexpr size_t WS_MG = 296 * MiB;
constexpr size_t WS_PROJ = 424 * MiB;
constexpr size_t WS_HB16 = WS_PROJ + 352 * MiB;
constexpr size_t WS_END = 904 * MiB;
constexpr int LDS_BYTES = 147456;

#define GAS __attribute__((address_space(1)))
#define LAS __attribute__((address_space(3)))
typedef unsigned short bf16;
typedef unsigned v4u __attribute__((ext_vector_type(4)));
typedef unsigned v2u __attribute__((ext_vector_type(2)));
typedef float f32x4 __attribute__((ext_vector_type(4)));
typedef float f32x16 __attribute__((ext_vector_type(16)));
typedef short bf16x8 __attribute__((ext_vector_type(8)));
typedef short s16x4 __attribute__((ext_vector_type(4)));
using pg8::cvtpk; using pg8::bflo; using pg8::bfhi;
#define LDS_WAIT() asm volatile("s_waitcnt lgkmcnt(0)" ::: "memory")
__device__ __forceinline__ unsigned short f2bf(float f) { return (unsigned short)(cvtpk(f, 0.f) & 0xffffu); }
__device__ __forceinline__ float bf2f(unsigned short h) { return __uint_as_float((unsigned)h << 16); }
__device__ __forceinline__ float wave_sum(float v) {
#pragma unroll
    for (int o = 1; o < 64; o <<= 1) v += __shfl_xor(v, o);
    return v;
}
__device__ __forceinline__ int crow(int r, int hi) { return (r & 3) + 8 * (r >> 2) + 4 * hi; }

struct Frame {
    LAS unsigned char* lds;
    int tid, lane, wave, G, bid;
    const float* in[17]; float* out; unsigned char* ws;
};
__device__ __forceinline__ int rowmap(int mode, int n) { return mode == 0 ? n : (((n >> 7) << 8) + (n & 127) + (mode == 2 ? 128 : 0)); }
__device__ __forceinline__ void p0_transpose_item(const float* W, int N, bf16* WT, int ldk, int koff, int mode, LAS float* scr, int item, int lane, const float* kscale = nullptr) {
    const int nblk = N / 32, kb = item / nblk, nb = item % nblk, k0 = 64 * kb, n0 = 32 * nb;
#pragma unroll 8
    for (int i = 0; i < 32; ++i) { const int kk = 2 * i + (lane >> 5); float w = W[(size_t)(k0 + kk) * N + n0 + (lane & 31)]; if (kscale) w *= kscale[k0 + kk]; scr[kk * 33 + (lane & 31)] = w; }
    LDS_WAIT(); asm volatile("" ::: "memory");
    const int c = lane & 7;
#pragma unroll
    for (int j = 0; j < 4; ++j) { const int n = (lane >> 3) + 8 * j; const LAS float* s = scr + (8 * c) * 33 + n;
        v4u o; o.x = cvtpk(s[0 * 33], s[1 * 33]); o.y = cvtpk(s[2 * 33], s[3 * 33]); o.z = cvtpk(s[4 * 33], s[5 * 33]); o.w = cvtpk(s[6 * 33], s[7 * 33]);
        *(GAS v4u*)(WT + (size_t)rowmap(mode, n0 + n) * ldk + koff + k0 + 8 * c) = o; }
    LDS_WAIT(); asm volatile("" ::: "memory");
}
__device__ __forceinline__ void rms_row_to_bf16(int lane, const float* xrow, float* rstd_out, bf16* orow) {
    const GAS f32x4* xr = (const GAS f32x4*)xrow + lane;
    f32x4 v[4]; float s = 0.f;
#pragma unroll
    for (int j = 0; j < 4; ++j) { v[j] = xr[64 * j]; s += (v[j].x * v[j].x + v[j].y * v[j].y) + (v[j].z * v[j].z + v[j].w * v[j].w); }
    const float rstd = 1.0f / sqrtf(wave_sum(s) * (1.f / D) + EPS);
    if (lane == 0) *rstd_out = rstd;
    GAS v2u* o8 = (GAS v2u*)orow + lane;
#pragma unroll
    for (int j = 0; j < 4; ++j) { v2u w; w.x = cvtpk(v[j].x * rstd, v[j].y * rstd); w.y = cvtpk(v[j].z * rstd, v[j].w * rstd); o8[64 * j] = w; }
}
__device__ __forceinline__ void rms_vals_to_bf16(int lane, const f32x4 (&v)[4], float* rstd_out, bf16* orow) {
    float s = 0.f;
#pragma unroll
    for (int j = 0; j < 4; ++j) s += (v[j].x * v[j].x + v[j].y * v[j].y) + (v[j].z * v[j].z + v[j].w * v[j].w);
    const float rstd = 1.0f / sqrtf(wave_sum(s) * (1.f / D) + EPS);
    if (lane == 0) *rstd_out = rstd;
    GAS v2u* o8 = (GAS v2u*)orow + lane;
#pragma unroll
    for (int j = 0; j < 4; ++j) { v2u w; w.x = cvtpk(v[j].x * rstd, v[j].y * rstd); w.y = cvtpk(v[j].z * rstd, v[j].w * rstd); o8[64 * j] = w; }
}
__device__ __forceinline__ void p0_weights(Frame& F) {
    LAS float* scr = (LAS float*)(F.lds + F.wave * 16384);
    const int gw = F.bid * NWAVES + F.wave, NGW = F.G * NWAVES;
    unsigned char* ws = F.ws;
    constexpr int I_IN = (1024 / 64) * (INW / 32), I_A = (512 / 64) * (1024 / 32), I_O = (1024 / 64) * (1024 / 32), I_G = (1024 / 64) * (FF / 32), I_D = (FF / 64) * (1024 / 32);
    constexpr int NITEMS = I_IN + 2 * I_A + I_O + 2 * I_G + I_D;
    for (int it = gw; it < NITEMS; it += NGW) {
        int r = it;
        if (r < I_IN) { p0_transpose_item(F.in[2], INW, (bf16*)(ws + WS_WIN), 1024, 0, 0, scr, r, F.lane, F.in[1]); continue; } r -= I_IN;
        if (r < I_A) { p0_transpose_item(F.in[8], 1024, (bf16*)(ws + WS_WAB), 1024, 0, 0, scr, r, F.lane); continue; } r -= I_A;
        if (r < I_A) { p0_transpose_item(F.in[9], 1024, (bf16*)(ws + WS_WAB), 1024, 512, 0, scr, r, F.lane); continue; } r -= I_A;
        if (r < I_O) { p0_transpose_item(F.in[10], 1024, (bf16*)(ws + WS_WOUT), 1024, 0, 0, scr, r, F.lane); continue; } r -= I_O;
        if (r < I_G) { p0_transpose_item(F.in[13], FF, (bf16*)(ws + WS_WGU), 1024, 0, 1, scr, r, F.lane); continue; } r -= I_G;
        if (r < I_G) { p0_transpose_item(F.in[14], FF, (bf16*)(ws + WS_WGU), 1024, 0, 2, scr, r, F.lane); continue; } r -= I_G;
        p0_transpose_item(F.in[15], 1024, (bf16*)(ws + WS_WD), FF, 0, 0, scr, r, F.lane);
    }
    { const float* wsrc = F.in[6]; bf16* wdst = (bf16*)(ws + WS_WSP);
      for (int i = gw * 64 + F.lane; i < 4 * 128 * 128; i += NGW * 64) { const int t = (i >> 7) & 127, s = i & 127; wdst[i] = f2bf(s <= t ? wsrc[i] : 0.f); } }
}
__device__ __forceinline__ void p0_rows(Frame& F, const float* x, float* RSTD, bf16* XN, int MT) {
    const int gw = F.bid * NWAVES + F.wave, NGW = F.G * NWAVES;
    for (int m = gw; m < MT; m += 2 * NGW) { const int m2 = (m + NGW < MT) ? m + NGW : m;
        const GAS f32x4* xa = (const GAS f32x4*)(x + (size_t)m * D) + F.lane; const GAS f32x4* xb = (const GAS f32x4*)(x + (size_t)m2 * D) + F.lane;
        f32x4 va[4], vb[4];
#pragma unroll
        for (int j = 0; j < 4; ++j) { va[j] = xa[64 * j]; vb[j] = xb[64 * j]; }
        rms_vals_to_bf16(F.lane, va, RSTD + m, XN + (size_t)m * D); rms_vals_to_bf16(F.lane, vb, RSTD + m2, XN + (size_t)m2 * D); }
}
constexpr int KS_ROW = 144, VT_ROW = 260  , KS_BYTES = 256 * KS_ROW;
__device__ __forceinline__ void attn_unit(Frame& F, const bf16* PROJ, bf16* AG, const float* sinks, int unit) {
    const int tid = F.tid, lane = F.lane, wave = F.wave, lq = lane & 31, hi = lane >> 5;
    const int kvh = unit & 1, n = (unit >> 1) & 15, b = unit >> 5;
    const long T0 = (long)b * SEQ + n * 128;
    LAS unsigned char* Ks = F.lds; LAS unsigned short* VT = (LAS unsigned short*)(F.lds + KS_BYTES);
    const int jstart = (n == 0) ? 128 : 0;
#pragma unroll
    for (int it = 0; it < 4; ++it) { const int id = it * NTHR + tid, key = id >> 3, ch = id & 7;
        if (key >= jstart) { const bf16* src = PROJ + (T0 - 128 + key) * INW + C_K + kvh * 64 + ch * 8;
            const v4u kv = *(const GAS v4u*)src, vv = *(const GAS v4u*)(src + 128);
            *(LAS v4u*)(Ks + key * KS_ROW + ch * 16) = kv;
            LAS unsigned short* vt = VT + (ch * 8) * VT_ROW + key;
            vt[0 * VT_ROW] = (unsigned short)(vv.x & 0xffffu); vt[1 * VT_ROW] = (unsigned short)(vv.x >> 16);
            vt[2 * VT_ROW] = (unsigned short)(vv.y & 0xffffu); vt[3 * VT_ROW] = (unsigned short)(vv.y >> 16);
            vt[4 * VT_ROW] = (unsigned short)(vv.z & 0xffffu); vt[5 * VT_ROW] = (unsigned short)(vv.z >> 16);
            vt[6 * VT_ROW] = (unsigned short)(vv.w & 0xffffu); vt[7 * VT_ROW] = (unsigned short)(vv.w >> 16); } }
    __syncthreads();
#pragma unroll 1
    for (int pass = 0; pass < 2; ++pass) {
        int lqo = lq; asm volatile("" : "+v"(lqo));
        const int g = pass * 2 + (wave >> 2), wq = wave & 3, hq = kvh * 4 + g;
        const float slope2 = __builtin_amdgcn_exp2f(-(float)(hq + 1)) * LOG2E, sink2 = sinks[hq] * LOG2E;
        const bf16* qp = PROJ + (T0 + 32 * wq + lq) * INW + hq * 64 + 8 * hi;
        bf16x8 qf[4];
#pragma unroll
        for (int ds = 0; ds < 4; ++ds) qf[ds] = *(const GAS bf16x8*)(qp + 16 * ds);
        f32x16 S[5];
#pragma unroll
        for (int i = 0; i < 5; ++i) { const int kt = wq + i; const bool skip = (n == 0 && kt < 4);
#pragma unroll
            for (int r = 0; r < 16; ++r) S[i][r] = 0.f;
            if (!skip) {
#pragma unroll
                for (int ds = 0; ds < 4; ++ds) { const bf16x8 kf = *(const LAS bf16x8*)(Ks + (32 * kt + lq) * KS_ROW + (16 * ds + 8 * hi) * 2);
                    S[i] = __builtin_amdgcn_mfma_f32_32x32x16_bf16(kf, qf[ds], S[i], 0, 0, 0); } }
            __builtin_amdgcn_sched_barrier(0); }
        float mx = sink2;
#pragma unroll
        for (int i = 0; i < 5; ++i) { const bool skip = (n == 0 && wq + i < 4);
#pragma unroll
            for (int r = 0; r < 16; ++r) { const int rel = 128 - 32 * i + lqo - crow(r, hi);
                const bool valid = !skip && (i == 0 ? rel <= 127 : (i == 4 ? rel >= 0 : true));
                const float lg = valid ? S[i][r] - slope2 * (float)rel : -1e30f; S[i][r] = lg; mx = fmaxf(mx, lg); } }
        mx = fmaxf(mx, __shfl_xor(mx, 32));
        float sum = 0.f;
#pragma unroll
        for (int i = 0; i < 5; ++i)
#pragma unroll
            for (int r = 0; r < 16; ++r) { const float p = __builtin_amdgcn_exp2f(S[i][r] - mx); S[i][r] = p; sum += p; }
        sum += __shfl_xor(sum, 32); sum += __builtin_amdgcn_exp2f(sink2 - mx);
        const float inv = 1.0f / sum;
        f32x16 O[2];
#pragma unroll
        for (int r = 0; r < 16; ++r) { O[0][r] = 0.f; O[1][r] = 0.f; }
#pragma unroll
        for (int i = 0; i < 5; ++i) { const int kt = wq + i; const bool skip = (n == 0 && kt < 4);
            if (!skip) {
#pragma unroll
                for (int s = 0; s < 2; ++s) {
                    v4u pw; pw.x = cvtpk(S[i][8 * s + 0], S[i][8 * s + 1]); pw.y = cvtpk(S[i][8 * s + 2], S[i][8 * s + 3]); pw.z = cvtpk(S[i][8 * s + 4], S[i][8 * s + 5]); pw.w = cvtpk(S[i][8 * s + 6], S[i][8 * s + 7]);
                    const bf16x8 pf = __builtin_bit_cast(bf16x8, pw);
#pragma unroll
                    for (int dt = 0; dt < 2; ++dt) { const LAS unsigned short* vp = VT + (32 * dt + lq) * VT_ROW + 32 * kt + 16 * s + 4 * hi;
                        const s16x4 lo = *(const LAS s16x4*)vp, h8 = *(const LAS s16x4*)(vp + 8);
                        const bf16x8 vf = __builtin_shufflevector(lo, h8, 0, 1, 2, 3, 4, 5, 6, 7);
                        O[dt] = __builtin_amdgcn_mfma_f32_32x32x16_bf16(vf, pf, O[dt], 0, 0, 0); } } }
            __builtin_amdgcn_sched_barrier(0); }
        bf16* op = AG + (T0 + 32 * wq + lq) * 1024 + hq * 64 + 4 * hi;
#pragma unroll
        for (int dt = 0; dt < 2; ++dt)
#pragma unroll
            for (int j = 0; j < 4; ++j) { v2u w; w.x = cvtpk(O[dt][4 * j] * inv, O[dt][4 * j + 1] * inv); w.y = cvtpk(O[dt][4 * j + 2] * inv, O[dt][4 * j + 3] * inv);
                *(GAS v2u*)(op + 32 * dt + 8 * j) = w; }
    }
    __syncthreads();
}
constexpr int GV_ROW = 132;
__device__ __forceinline__ void gmlp_unit(Frame& F, const bf16* PROJ, bf16* AG, const float* ln_g, const float* ln_b, const bf16* WSP, const float* b_s, int unit) {
    const int lane = F.lane, wave = F.wave, lq = lane & 31, hi = lane >> 5;
    const int n = unit & 15, b = unit >> 4; const long T0 = (long)b * SEQ + n * 128;
    LAS unsigned short* VT = (LAS unsigned short*)F.lds;
    float gch[8], bch[8];
#pragma unroll
    for (int i = 0; i < 8; ++i) { gch[i] = ln_g[lane + 64 * i]; bch[i] = ln_b[lane + 64 * i]; }
#pragma unroll 1
    for (int hb = 0; hb < 2; ++hb) {
        unsigned short raw[8][8];
#pragma unroll
        for (int tk = 0; tk < 8; ++tk) { const bf16* vp = PROJ + (T0 + 16 * wave + 8 * hb + tk) * INW + C_VG + lane;
#pragma unroll
            for (int i = 0; i < 8; ++i) raw[tk][i] = vp[64 * i]; }
#pragma unroll
        for (int tk = 0; tk < 8; ++tk) { const int s = 16 * wave + 8 * hb + tk;
            float x[8]; float sm = 0.f;
#pragma unroll
            for (int i = 0; i < 8; ++i) { x[i] = bf2f(raw[tk][i]); sm += x[i]; }
            const float mean = wave_sum(sm) * (1.f / 512.f); float q = 0.f;
#pragma unroll
            for (int i = 0; i < 8; ++i) { x[i] -= mean; q += x[i] * x[i]; }
            const float rstd = 1.0f / sqrtf(wave_sum(q) * (1.f / 512.f) + LN_EPS);
#pragma unroll
            for (int i = 0; i < 8; ++i) VT[(lane + 64 * i) * GV_ROW + s] = f2bf(x[i] * rstd * gch[i] + bch[i]); } }
    __syncthreads();
    const int g = wave >> 1, cb = g * 128 + 64 * (wave & 1);
    f32x16 acc[2][4];
#pragma unroll
    for (int mt = 0; mt < 2; ++mt)
#pragma unroll
        for (int nt = 0; nt < 4; ++nt)
#pragma unroll
            for (int r = 0; r < 16; ++r) acc[mt][nt][r] = 0.f;
    const bf16* wg = WSP + (size_t)g * 128 * 128 + (size_t)lq * 128 + 8 * hi;
    bf16x8 bcur[4], bnxt[4];
#pragma unroll
    for (int nt = 0; nt < 4; ++nt) { bcur[nt] = *(const GAS bf16x8*)(wg + (size_t)(32 * nt) * 128); bnxt[nt] = bcur[nt]; }
#pragma unroll 1
    for (int ks = 0; ks < 8; ++ks) {
        if (ks < 7) {
#pragma unroll
            for (int nt = 0; nt < 4; ++nt) if (ks + 1 < 2 * (nt + 1)) bnxt[nt] = *(const GAS bf16x8*)(wg + (size_t)(32 * nt) * 128 + 16 * (ks + 1)); }
        bf16x8 af[2];
#pragma unroll
        for (int mt = 0; mt < 2; ++mt) { const LAS unsigned short* ap = VT + (cb + 32 * mt + lq) * GV_ROW + 16 * ks + 8 * hi;
            const s16x4 lo = *(const LAS s16x4*)ap, h8 = *(const LAS s16x4*)(ap + 4); af[mt] = __builtin_shufflevector(lo, h8, 0, 1, 2, 3, 4, 5, 6, 7); }
#pragma unroll
        for (int nt = 0; nt < 4; ++nt) if (ks < 2 * (nt + 1)) {
#pragma unroll
            for (int mt = 0; mt < 2; ++mt) acc[mt][nt] = __builtin_amdgcn_mfma_f32_32x32x16_bf16(af[mt], bcur[nt], acc[mt][nt], 0, 0, 0); }
#pragma unroll
        for (int nt = 0; nt < 4; ++nt) bcur[nt] = bnxt[nt];
    }
#pragma unroll
    for (int nt = 0; nt < 4; ++nt) { const int t = 32 * nt + lq; const float bias = b_s[g * 128 + t];
        const bf16* up = PROJ + (T0 + t) * INW + C_U + cb + 4 * hi; bf16* op = AG + (T0 + t) * 1024 + 512 + cb + 4 * hi;
#pragma unroll
        for (int mt = 0; mt < 2; ++mt)
#pragma unroll
            for (int j = 0; j < 4; ++j) { const v2u uu = *(const GAS v2u*)(up + 32 * mt + 8 * j);
                v2u w; w.x = cvtpk(bflo(uu.x) * (acc[mt][nt][4 * j] + bias), bfhi(uu.x) * (acc[mt][nt][4 * j + 1] + bias));
                w.y = cvtpk(bflo(uu.y) * (acc[mt][nt][4 * j + 2] + bias), bfhi(uu.y) * (acc[mt][nt][4 * j + 3] + bias));
                *(GAS v2u*)(op + 32 * mt + 8 * j) = w; } }
    __syncthreads();
}
__device__ __forceinline__ void unpack8(const v4u mv, f32x4& a, f32x4& b) { a = (f32x4){bflo(mv.x), bfhi(mv.x), bflo(mv.y), bfhi(mv.y)}; b = (f32x4){bflo(mv.z), bfhi(mv.z), bflo(mv.w), bfhi(mv.w)}; }
struct RowIn { v4u a[2], b[2]; float t; };
__device__ __forceinline__ RowIn row_load(int lane, const bf16* arow, const bf16* brow, const float* ssq) {
    RowIn r; r.t = (lane < 16) ? ssq[lane] : 0.f;
#pragma unroll
    for (int j = 0; j < 2; ++j) { const int c = 8 * lane + 512 * j; r.a[j] = *(const GAS v4u*)(arow + c); r.b[j] = *(const GAS v4u*)(brow + c); }
    return r;
}
__device__ __forceinline__ void e1_finish(int lane, const RowIn& in, bf16* xbrow, float rstd_x, const float* gpost, const float* gpre, bf16* hrow) {
    const float t = wave_sum(in.t);
    const float rstd = 1.0f / sqrtf(t * (1.f / D) + EPS), rx = 1.0f / rstd_x;
    f32x4 h[2][2]; float s = 0.f;
#pragma unroll
    for (int j = 0; j < 2; ++j) { const int c = 8 * lane + 512 * j;
        const f32x4 g0 = *(const GAS f32x4*)(gpost + c), g1 = *(const GAS f32x4*)(gpost + c + 4);
        f32x4 m0, m1, x0, x1; unpack8(in.a[j], m0, m1); unpack8(in.b[j], x0, x1);
        h[j][0] = x0 * rx + m0 * rstd * g0; h[j][1] = x1 * rx + m1 * rstd * g1;
        *(GAS v4u*)(hrow + c) = pg8::pack8(h[j][0], h[j][1]);
#pragma unroll
        for (int e = 0; e < 4; ++e) s += h[j][0][e] * h[j][0][e] + h[j][1][e] * h[j][1][e]; }
    const float r2 = 1.0f / sqrtf(wave_sum(s) * (1.f / D) + EPS);
#pragma unroll
    for (int j = 0; j < 2; ++j) { const int c = 8 * lane + 512 * j; const f32x4 g0 = *(const GAS f32x4*)(gpre + c), g1 = *(const GAS f32x4*)(gpre + c + 4);
        *(GAS v4u*)(xbrow + c) = pg8::pack8(h[j][0] * r2 * g0, h[j][1] * r2 * g1); }
}
__device__ __forceinline__ void e2_finish(int lane, const RowIn& in, const float* gpost, float* orow) {
    const float t = wave_sum(in.t);
    const float rstd = 1.0f / sqrtf(t * (1.f / D) + EPS);
#pragma unroll
    for (int j = 0; j < 2; ++j) { const int c = 8 * lane + 512 * j;
        const f32x4 g0 = *(const GAS f32x4*)(gpost + c), g1 = *(const GAS f32x4*)(gpost + c + 4);
        f32x4 m0, m1, x0, x1; unpack8(in.a[j], m0, m1); unpack8(in.b[j], x0, x1);
        *(GAS f32x4*)(orow + c) = x0 + m0 * rstd * g0; *(GAS f32x4*)(orow + c + 4) = x1 + m1 * rstd * g1; }
}
#define XB_TMO      128
#define XB_XCNT(j)  (256  + 64 * (j))
#define XB_XSUB(j)  (1280 + 64 * (j))
#define XB_XGEN(j)  (2304 + 64 * (j))
#define XB_TOP      3328
#define XB_TOPGEN   3392
#define XCD_BAR_WORDS 3456
#define XB_SPIN_CAP (1u << 18)

__device__ __forceinline__ unsigned xb_ld(unsigned* p)              { return __hip_atomic_load(p, __ATOMIC_RELAXED, __HIP_MEMORY_SCOPE_AGENT); }
__device__ __forceinline__ unsigned xb_add(unsigned* p, unsigned v) { return __hip_atomic_fetch_add(p, v, __ATOMIC_RELAXED, __HIP_MEMORY_SCOPE_AGENT); }
__device__ __forceinline__ unsigned xb_xcc_id() { return (unsigned)__builtin_amdgcn_s_getreg((3 << 11) | 20) & 0xFu; }
#define XB_SPIN(cond, bar) do { unsigned _sp = 0; while (cond) { __builtin_amdgcn_s_sleep(1); \
    if ((++_sp & 255u) == 0u) { if (xb_ld(&(bar)[XB_TMO])) break; if (_sp > XB_SPIN_CAP) { atomicAdd(&(bar)[XB_TMO], 1u); break; } } } } while (0)

struct XcdBarrier {
    unsigned* bar; unsigned x; unsigned G;
    volatile LAS unsigned* st;
};

__device__ __forceinline__ XcdBarrier xcd_barrier_post(unsigned* bar, volatile LAS unsigned* st, int wave, unsigned G) {
    XcdBarrier b; b.bar = bar; b.x = xb_xcc_id(); b.st = st; b.G = G;
    if (pg8::lane_id_opaque() == 0 && wave == 0) (void)xb_add(&bar[XB_XCNT(b.x)], 1u);
    return b;
}
__device__ __forceinline__ void xcd_barrier_complete(unsigned* bar, unsigned x, unsigned& nloc, unsigned& nx, const unsigned G) {
    unsigned sum, cnt, mine, sp = 0u;
    for (;;) {
        sum = 0u; cnt = 0u; mine = 0u;
#pragma unroll
        for (unsigned j = 0; j < 16; ++j) { const unsigned c = xb_ld(&bar[XB_XCNT(j)]); sum += c; cnt += (c > 0u) ? 1u : 0u; mine = (j == x) ? c : mine; }
        if (sum == G) break;
        __builtin_amdgcn_s_sleep(1);
        if ((++sp & 255u) == 0u) { if (xb_ld(&bar[XB_TMO])) break; if (sp > XB_SPIN_CAP) { atomicAdd(&bar[XB_TMO], 1u); break; } }
    }
    nloc = mine > 0u ? mine : 1u; nx = cnt > 0u ? cnt : 1u;
}

__device__ __forceinline__ void xcd_barrier(const XcdBarrier& b, int wave) {
    asm volatile("s_waitcnt vmcnt(0)" ::: "memory");
    __syncthreads();
    if (pg8::lane_id_opaque() == 0 && wave == 0) {
        unsigned* bar = b.bar;
        __builtin_amdgcn_s_waitcnt(0);
        unsigned nloc = b.st[0], nx = b.st[1];
        if (nloc == 0u) { xcd_barrier_complete(bar, b.x, nloc, nx, b.G); b.st[0] = nloc; b.st[1] = nx; }
        const unsigned old = xb_add(&bar[XB_XSUB(b.x)], 1u);
        const unsigned gen = old / nloc;
        if (old + 1u == (gen + 1u) * nloc) {
            __builtin_amdgcn_fence(__ATOMIC_RELEASE, "agent");
            asm volatile("s_waitcnt vmcnt(0)" ::: "memory");
            const unsigned og = xb_add(&bar[XB_TOP], 1u);
            const unsigned tg = og / nx;
            if (og + 1u == (tg + 1u) * nx) xb_add(&bar[XB_TOPGEN], 1u);
            else XB_SPIN(xb_ld(&bar[XB_TOPGEN]) == tg, bar);
            __builtin_amdgcn_fence(__ATOMIC_ACQUIRE, "agent");
            xb_add(&bar[XB_XGEN(b.x)], 1u);
            asm volatile("s_waitcnt vmcnt(0)" ::: "memory");
        } else {
            XB_SPIN(xb_ld(&bar[XB_XGEN(b.x)]) == gen, bar);
            __builtin_amdgcn_fence(__ATOMIC_ACQUIRE, "agent");
            asm volatile("s_waitcnt vmcnt(0)" ::: "memory");
        }
    }
    __syncthreads();
}

constexpr int N_PHASES = 9;
struct Args { const float* in[17]; float* out; unsigned char* ws; int ph_lo, ph_hi; };
__global__ void __launch_bounds__(NTHR, 2) fwd_megakernel(Args args) {
    extern __shared__ __attribute__((aligned(16))) unsigned char lds[];
    cg::grid_group grid = cg::this_grid();
    Frame F;
    F.lds = (LAS unsigned char*)lds;
    F.wave = __builtin_amdgcn_readfirstlane(threadIdx.x >> 6);
#define RETID() do { F.lane = pg8::lane_id_opaque(); F.tid = F.wave * 64 + F.lane; } while (0)
    RETID();
    const bool two = (gridDim.x == 256);
    const int team = two ? ((int)(blockIdx.x >> 3) & 1) : 0;
    const int GT = two ? 128 : (int)gridDim.x, tc = two ? (int)((blockIdx.x & 7) + 8 * (blockIdx.x >> 4)) : (int)blockIdx.x;
    const int MT = two ? M / 2 : M; const size_t roff = (size_t)team * (size_t)MT;
    F.G = GT; F.bid = tc;
    const __attribute__((address_space(4))) char* kargp = (const __attribute__((address_space(4))) char*)__builtin_amdgcn_kernarg_segment_ptr();
#define LAZY_IN(k) (F.in[k] = *(const float* const volatile __attribute__((address_space(4)))*)(kargp + 8 * (k)))
    F.out = args.out; F.ws = args.ws;
    unsigned char* ws = args.ws;
    const int lo = args.ph_lo, hi = args.ph_hi;
    volatile LAS unsigned* MISC = (volatile LAS unsigned*)(F.lds + MISC_OFF);
    if (F.tid < 16) MISC[F.tid] = 0u;
    __syncthreads();
    XcdBarrier bar = xcd_barrier_post((unsigned*)(ws + WS_CTL), MISC, F.wave, gridDim.x);
    XcdBarrier tbar = xcd_barrier_post((unsigned*)(ws + WS_CTL) + (1 + team) * BAR_REGION_WORDS, MISC + 2, F.wave, (unsigned)GT);
#define W_IN ((bf16*)(ws + WS_WIN))
#define W_AB ((bf16*)(ws + WS_WAB))
#define W_OUT ((bf16*)(ws + WS_WOUT))
#define W_GU ((bf16*)(ws + WS_WGU))
#define W_D ((bf16*)(ws + WS_WD))
#define W_SP ((bf16*)(ws + WS_WSP))
#define SSQA ((float*)(ws + WS_SSQA) + roff * 16)
#define SSQB ((float*)(ws + WS_SSQB) + roff * 16)
#define RSTDT ((float*)(ws + WS_RSTD) + roff)
#define XN ((bf16*)(ws + WS_XN) + roff * D)
#define AG ((bf16*)(ws + WS_AG) + roff * D)
#define MG ((bf16*)(ws + WS_MG) + roff * D)
#define PROJ ((bf16*)(ws + WS_PROJ) + roff * INW)
#define MIX AG
#define FFO MG
#define HN XN
#define HB PROJ
#define HB16 (PROJ + (size_t)MT * FF)
#define OUT (args.out + roff * D)
#define IN(k) (lo <= (k) && (k) < hi)
    if (hi < 0) grid.sync();
#define SEAM(k) do { if (IN(k) && IN((k) + 1)) xcd_barrier(tbar, F.wave); else __syncthreads(); RETID(); } while (0)

    if (IN(0)) { LAZY_IN(0); LAZY_IN(1); LAZY_IN(2); LAZY_IN(6); LAZY_IN(8); LAZY_IN(9); LAZY_IN(10); LAZY_IN(13); LAZY_IN(14); LAZY_IN(15);
        if (!two || team == 1) p0_weights(F);
        if (!two || team == 0) p0_rows(F, F.in[0] + roff * D, RSTDT, XN, MT);
        xcd_barrier(bar, F.wave); RETID();
        if (two && team == 1) { p0_rows(F, F.in[0] + roff * D, RSTDT, XN, MT); xcd_barrier(tbar, F.wave); RETID(); } }
    if (IN(1)) { pg8::Gemm g{XN, W_IN, MT, INW, D}; pg8::StaticOrder S; S.init(MT, INW, F.G, F.bid); pg8::EpiProj E{PROJ};
        pg8::gemm_phase<pg8::EpiProj, pg8::StaticOrder, true, true>(F.lds, g, S, E, F.wave); }
    SEAM(1);
    if (IN(2)) { LAZY_IN(3); LAZY_IN(4); LAZY_IN(5); LAZY_IN(7);
        for (int u = F.bid; u < MT / 64; u += F.G) attn_unit(F, PROJ, AG, F.in[3], u);
        for (int u = F.bid; u < MT / 128; u += F.G) gmlp_unit(F, PROJ, AG, F.in[4], F.in[5], W_SP, F.in[7], u);
    }
    SEAM(2);
    if (IN(3)) { pg8::Gemm g{AG, W_AB, MT, D, D}; pg8::StaticOrder S; S.init(MT, D, F.G, F.bid); pg8::EpiMerge E{PROJ, MG};
        pg8::gemm_phase<pg8::EpiMerge, pg8::StaticOrder, true, true>(F.lds, g, S, E, F.wave); }
    SEAM(3);
    if (IN(4)) { pg8::Gemm g{MG, W_OUT, MT, D, D}; pg8::StaticOrder S; S.init(MT, D, F.G, F.bid); pg8::EpiSsq E{MIX, SSQA};
        pg8::gemm_phase<pg8::EpiSsq, pg8::StaticOrder, true, true>(F.lds, g, S, E, F.wave); }
    SEAM(4);
    if (IN(5)) { LAZY_IN(11); LAZY_IN(12); const int gw = F.bid * NWAVES + F.wave, NGW = F.G * NWAVES;
        const float* RSTD = RSTDT;
        for (int m = gw; m < MT; m += 4 * NGW) {
            int mm[4]; RowIn rr[4]; float rx[4];
#pragma unroll
            for (int q = 0; q < 4; ++q) { mm[q] = (m + q * NGW < MT) ? m + q * NGW : m; rr[q] = row_load(F.lane, MIX + (size_t)mm[q] * D, HN + (size_t)mm[q] * D, SSQA + (size_t)mm[q] * 16); rx[q] = RSTD[mm[q]]; }
#pragma unroll
            for (int q = 0; q < 4; ++q) e1_finish(F.lane, rr[q], HN + (size_t)mm[q] * D, rx[q], F.in[11], F.in[12], HB16 + (size_t)mm[q] * D); } }
    SEAM(5);
    if (IN(6)) { pg8::Gemm g{HN, W_GU, MT, 2 * FF, D}; pg8::StaticOrder S; S.init(MT, 2 * FF, F.G, F.bid); pg8::EpiSwiglu E{HB};
        pg8::gemm_phase<pg8::EpiSwiglu, pg8::StaticOrder, true, true>(F.lds, g, S, E, F.wave); }
    SEAM(6);
    if (IN(7)) { pg8::Gemm g{HB, W_D, MT, D, FF}; pg8::StaticOrder S; S.init(MT, D, F.G, F.bid); pg8::EpiSsq E{FFO, SSQB};
        pg8::gemm_phase<pg8::EpiSsq, pg8::StaticOrder, true, true>(F.lds, g, S, E, F.wave); }
    SEAM(7);
    if (IN(8)) { LAZY_IN(16); const int gw = F.bid * NWAVES + F.wave, NGW = F.G * NWAVES;
        for (int m = gw; m < MT; m += 4 * NGW) {
            int mm[4]; RowIn rr[4];
#pragma unroll
            for (int q = 0; q < 4; ++q) { mm[q] = (m + q * NGW < MT) ? m + q * NGW : m; rr[q] = row_load(F.lane, FFO + (size_t)mm[q] * D, HB16 + (size_t)mm[q] * D, SSQB + (size_t)mm[q] * 16); }
#pragma unroll
            for (int q = 0; q < 4; ++q) e2_finish(F.lane, rr[q], F.in[16], OUT + (size_t)mm[q] * D); } }
#undef IN
#undef SEAM
}

extern "C" void kernel_launch(void* const* d_in, const int* in_sizes, int n_in, void* d_out, int out_size, void* d_ws, size_t ws_size, hipStream_t stream) {
    static int grid = 0;
    if (grid == 0) {
        if (n_in != 17 || out_size != M * D || ws_size < WS_END) { fprintf(stderr, "kernel_launch: unexpected problem: n_in %d out %d ws %zu\n", n_in, out_size, ws_size); grid = -1; return; }
        int dev = 0, cus = 0, per_cu = 0;
        (void)hipGetDevice(&dev); (void)hipDeviceGetAttribute(&cus, hipDeviceAttributeMultiprocessorCount, dev);
        if (hipFuncSetAttribute((const void*)fwd_megakernel, hipFuncAttributeMaxDynamicSharedMemorySize, LDS_BYTES) != hipSuccess) fprintf(stderr, "kernel_launch: hipFuncSetAttribute failed\n");
        if (hipOccupancyMaxActiveBlocksPerMultiprocessor(&per_cu, (const void*)fwd_megakernel, NTHR, LDS_BYTES) != hipSuccess || per_cu < 1) { fprintf(stderr, "kernel_launch: occupancy query says %d\n", per_cu); per_cu = 1; }
        (void)hipGetLastError();
        grid = cus * per_cu;
        fprintf(stderr, "kernel_launch: grid %d (cus %d x %d)\n", grid, cus, per_cu);
    }
    if (grid < 0) return;
    if (hipMemsetAsync((char*)d_ws + WS_CTL, 0, CTL_BYTES, stream) != hipSuccess) { fprintf(stderr, "kernel_launch: hipMemsetAsync failed\n"); return; }
    Args a{};
    for (int i = 0; i < 17; ++i) a.in[i] = (const float*)d_in[i];
    a.out = (float*)d_out; a.ws = (unsigned char*)d_ws;
#if MK_N_LAUNCHES == 1
    a.ph_lo = 0; a.ph_hi = N_PHASES;
    void* kargs[] = {&a};
    hipError_t e = hipLaunchCooperativeKernel((const void*)fwd_megakernel, dim3(grid), dim3(NTHR), kargs, LDS_BYTES, stream);
    if (e != hipSuccess) fprintf(stderr, "kernel_launch: cooperative launch failed: %s (grid %d)\n", hipGetErrorString(e), grid);
#else
    for (int k = 0; k < N_PHASES; ++k) { a.ph_lo = k; a.ph_hi = k + 1;
        hipLaunchKernelGGL(fwd_megakernel, dim3(grid), dim3(NTHR), LDS_BYTES, stream, a);
        const hipError_t le = hipPeekAtLastError(); if (le != hipSuccess) { fprintf(stderr, "kernel_launch: launch %d failed: %s\n", k, hipGetErrorName(le)); break; } }
#endif
}
```

```cpp
#include <hip/hip_runtime.h>
#include <hip/hip_cooperative_groups.h>
#include <cstdio>
#include <cstdint>
namespace cg = cooperative_groups;
#ifndef MK_N_LAUNCHES
#define MK_N_LAUNCHES 1
#endif
namespace pg8 {
#define PG8_LAS __attribute__((address_space(3)))
typedef unsigned short bf16_t;
typedef short bf16x8 __attribute__((ext_vector_type(8)));
typedef float f32x4 __attribute__((ext_vector_type(4)));
typedef unsigned u32x4 __attribute__((ext_vector_type(4)));
constexpr int BM = 256, BK = 64, HALF = 128, HTB = HALF * BK * 2  , STAGE_BYTES = 8 * HTB, NXCD = 8, WGM = 4;

__host__ __device__ __forceinline__ int lds_byte(int r, int c) { const int st = (r >> 4) * 2 + (c >> 5), rr = r & 15, cc = c & 31, ob = rr * 64 + cc * 2; return st * 1024 + (ob ^ (((ob >> 9) & 1) << 5)); }
__host__ __device__ __forceinline__ void stage_rc(int b, int& R, int& C) { const int st = b / 1024, sb = b % 1024, swz = sb ^ (((sb >> 9) & 1) << 5); R = (st >> 1) * 16 + swz / 64; C = (st & 1) * 32 + (swz % 64) / 2; }
__host__ __device__ __forceinline__ int perm32(int rho) { const int n = rho >> 4, i = rho & 15; return 8 * (i >> 2) + 4 * n + (i & 3); }

__device__ __forceinline__ int lane_id_opaque() { int l; asm volatile("v_mbcnt_lo_u32_b32 %0, -1, 0\n\tv_mbcnt_hi_u32_b32 %0, -1, %0" : "=v"(l)); return l; }
struct Unit { int pm, pn; };
struct Gemm { const bf16_t* A; const bf16_t* Bt; int M, N, K; };

struct StaticOrder {
    int nM, nN, nwg, G, c;
    __host__ __device__ void init(int M, int N, int G_, int c_) { nM = M / BM; nN = N / BM; nwg = nM * nN; G = G_; c = c_; }
    __host__ __device__ bool next(int i, Unit& u) const {
        const long L = (long)i * G + c; if (L >= nwg) return false;
        int wgid = (int)L; { const int q = nwg / NXCD, r = nwg % NXCD, xcd = wgid % NXCD, off = wgid / NXCD; wgid = (xcd < r ? xcd * (q + 1) : r * (q + 1) + (xcd - r) * q) + off; }
        const int nig = WGM * nN, gid = wgid / nig, fm = gid * WGM, gsz = (nM - fm) < WGM ? (nM - fm) : WGM;
        u.pm = fm + ((wgid % nig) % gsz); u.pn = (wgid % nig) / gsz; return true;
    }
    __device__ __forceinline__ void a_ready(const Unit&) const {}
    __device__ __forceinline__ void done(const Unit&) const {}
};

__device__ __forceinline__ unsigned cvt_pk_bf16(float lo, float hi) { unsigned r; asm volatile("v_cvt_pk_bf16_f32 %0, %1, %2" : "=v"(r) : "v"(lo), "v"(hi)); return r; }
typedef float f32x2 __attribute__((ext_vector_type(2)));
__device__ __forceinline__ f32x2 gelu_pk(f32x2 v) {
    const f32x2 av = __builtin_elementwise_abs(v), d = av * 0.2316418882f + 1.0f;
    f32x2 t; t.x = __builtin_amdgcn_rcpf(d.x); t.y = __builtin_amdgcn_rcpf(d.y);
    f32x2 q = t * 0.5307027145f + (-0.7265760135f); q = q * t + 0.7107068705f; q = q * t + (-0.142248368f); q = q * t + 0.127414796f; q = q * t;
    const f32x2 s = (v * v) * (-0.72134752044f);
    f32x2 e; e.x = __builtin_amdgcn_exp2f(s.x); e.y = __builtin_amdgcn_exp2f(s.y);
    const f32x2 m = v * (q * e), r = v - m;
    f32x2 o; o.x = v.x < 0.f ? m.x : r.x; o.y = v.y < 0.f ? m.y : r.y; return o;
}
typedef __bf16 bf16x2_t __attribute__((ext_vector_type(2)));
__device__ __forceinline__ unsigned cvtpk(float lo, float hi) { f32x2 v = {lo, hi}; bf16x2_t b = __builtin_convertvector(v, bf16x2_t); return __builtin_bit_cast(unsigned, b); }
__device__ __forceinline__ float bflo(unsigned u) { return __uint_as_float(u << 16); }
__device__ __forceinline__ float bfhi(unsigned u) { return __uint_as_float(u & 0xffff0000u); }
__device__ __forceinline__ float sigm(float x) { return __builtin_amdgcn_rcpf(1.0f + __builtin_amdgcn_exp2f(-1.4426950408889634f * x)); }
__device__ __forceinline__ u32x4 pack8(f32x4 v0, f32x4 v1) { u32x4 w; w.x = cvtpk(v0[0], v0[1]); w.y = cvtpk(v0[2], v0[3]); w.z = cvtpk(v1[0], v1[1]); w.w = cvtpk(v1[2], v1[3]); return w; }
constexpr int PROJ_LD = 3840;
constexpr float QSCALE = 0.125f * 1.4426950408889634f;

struct EpiProj {
    static constexpr bool PERM = true, AFTER_DRAIN = false, MID = false; static constexpr int NST = 14;
    bf16_t* O;
    __device__ __forceinline__ void mid(f32x4 (&)[2][2][4][2], const Unit&, int, int, int, int) const {}
    __device__ __forceinline__ void operator()(const f32x4 (&acc)[2][2][4][2], const Unit& u, int wr, int wc, int fr, int fq) const {
        { const int l_ = lane_id_opaque(); fr = l_ & 15; fq = l_ >> 4; }
        const int row0 = u.pm * BM + wr * 64 + fr, col0 = u.pn * BM + wc * 32 + 8 * fq;
        const int mode = u.pn < 3 ? 0 : (u.pn < 7 ? 1 : 2); const float sc = u.pn < 2 ? QSCALE : 1.0f;
#pragma unroll
        for (int ai = 0; ai < 2; ++ai)
#pragma unroll
            for (int m = 0; m < 4; ++m) { bf16_t* rowp = O + (size_t)(row0 + ai * HALF + m * 16) * PROJ_LD + col0;
#pragma unroll
                for (int bj = 0; bj < 2; ++bj) { f32x4 v0 = acc[ai][bj][m][0], v1 = acc[ai][bj][m][1];
                    if (mode == 1) { f32x2 a = gelu_pk((f32x2){v0[0], v0[1]}), b = gelu_pk((f32x2){v0[2], v0[3]}), c = gelu_pk((f32x2){v1[0], v1[1]}), d = gelu_pk((f32x2){v1[2], v1[3]});
                        v0 = (f32x4){a.x, a.y, b.x, b.y}; v1 = (f32x4){c.x, c.y, d.x, d.y}; }
                    else if (mode == 2) { v0 = (f32x4){sigm(v0[0]), sigm(v0[1]), sigm(v0[2]), sigm(v0[3])}; v1 = (f32x4){sigm(v1[0]), sigm(v1[1]), sigm(v1[2]), sigm(v1[3])}; }
                    else { v0 = v0 * sc; v1 = v1 * sc; }
                    *(u32x4*)(rowp + bj * HALF) = pack8(v0, v1); } }
    }
};
struct EpiMerge {
    static constexpr bool PERM = true, AFTER_DRAIN = false, MID = true; static constexpr int NST = 14;
    const bf16_t* P; bf16_t* O;
    __device__ __forceinline__ void mid(f32x4 (&acc)[2][2][4][2], const Unit& u, int wr, int wc, int fr, int fq) const {
        { const int l_ = lane_id_opaque(); fr = l_ & 15; fq = l_ >> 4; }
        const int row0 = u.pm * BM + wr * 64 + fr, col0 = u.pn * BM + wc * 32 + 8 * fq;
#pragma unroll
        for (int ai = 0; ai < 2; ++ai)
#pragma unroll
            for (int m = 0; m < 4; ++m) { const bf16_t* rowp = P + (size_t)(row0 + ai * HALF + m * 16) * PROJ_LD + col0;
#pragma unroll
                for (int bj = 0; bj < 2; ++bj) { const u32x4 a = *(const u32x4*)(rowp + 1792 + bj * HALF), b = *(const u32x4*)(rowp + 2816 + bj * HALF);
                    f32x4 r0, r1;
                    r0[0] = bflo(a.x) * __builtin_amdgcn_rcpf(bflo(b.x)); r0[1] = bfhi(a.x) * __builtin_amdgcn_rcpf(bfhi(b.x)); r0[2] = bflo(a.y) * __builtin_amdgcn_rcpf(bflo(b.y)); r0[3] = bfhi(a.y) * __builtin_amdgcn_rcpf(bfhi(b.y));
                    r1[0] = bflo(a.z) * __builtin_amdgcn_rcpf(bflo(b.z)); r1[1] = bfhi(a.z) * __builtin_amdgcn_rcpf(bfhi(b.z)); r1[2] = bflo(a.w) * __builtin_amdgcn_rcpf(bflo(b.w)); r1[3] = bfhi(a.w) * __builtin_amdgcn_rcpf(bfhi(b.w));
                    acc[ai][bj][m][0] *= r0; acc[ai][bj][m][1] *= r1; }
                if (m & 1) asm volatile("" ::: "memory"); }
    }
    __device__ __forceinline__ void operator()(const f32x4 (&acc)[2][2][4][2], const Unit& u, int wr, int wc, int fr, int fq) const {
        { const int l_ = lane_id_opaque(); fr = l_ & 15; fq = l_ >> 4; }
        const int row0 = u.pm * BM + wr * 64 + fr, col0 = u.pn * BM + wc * 32 + 8 * fq;
#pragma unroll
        for (int ai = 0; ai < 2; ++ai)
#pragma unroll
            for (int m = 0; m < 4; ++m) { const size_t row = (size_t)(row0 + ai * HALF + m * 16); const bf16_t* rowp = P + row * PROJ_LD + col0;
#pragma unroll
                for (int bj = 0; bj < 2; ++bj) { const u32x4 b = *(const u32x4*)(rowp + 2816 + bj * HALF);
                    const f32x4 s0 = {bflo(b.x), bfhi(b.x), bflo(b.y), bfhi(b.y)}, s1 = {bflo(b.z), bfhi(b.z), bflo(b.w), bfhi(b.w)};
                    *(u32x4*)(O + row * 1024 + col0 + bj * HALF) = pack8(acc[ai][bj][m][0] * s0, acc[ai][bj][m][1] * s1); }
                asm volatile("" ::: "memory"); }
    }
};
struct EpiSsq {
    static constexpr bool PERM = true, AFTER_DRAIN = false, MID = false; static constexpr int NST = 20;
    bf16_t* O; float* ssq;
    __device__ __forceinline__ void mid(f32x4 (&)[2][2][4][2], const Unit&, int, int, int, int) const {}
    __device__ __forceinline__ void operator()(const f32x4 (&acc)[2][2][4][2], const Unit& u, int wr, int wc, int fr, int fq) const {
        { const int l_ = lane_id_opaque(); fr = l_ & 15; fq = l_ >> 4; }
        const int row0 = u.pm * BM + wr * 64 + fr, col0 = u.pn * BM + wc * 32 + 8 * fq;
#pragma unroll
        for (int ai = 0; ai < 2; ++ai)
#pragma unroll
            for (int m = 0; m < 4; ++m) { const size_t row = (size_t)(row0 + ai * HALF + m * 16); float s = 0.f;
#pragma unroll
                for (int bj = 0; bj < 2; ++bj) { const f32x4 v0 = acc[ai][bj][m][0], v1 = acc[ai][bj][m][1];
                    s += (v0[0] * v0[0] + v0[1] * v0[1]) + (v0[2] * v0[2] + v0[3] * v0[3]) + (v1[0] * v1[0] + v1[1] * v1[1]) + (v1[2] * v1[2] + v1[3] * v1[3]);
                    *(u32x4*)(O + row * 1024 + col0 + bj * HALF) = pack8(v0, v1); }
                s += __shfl_xor(s, 16); s += __shfl_xor(s, 32);
                if (fq == 0) ssq[row * 16 + u.pn * 4 + wc] = s; }
    }
};
struct EpiSwiglu {
    static constexpr bool PERM = true, AFTER_DRAIN = false, MID = false; static constexpr int NST = 7;
    bf16_t* O;
    __device__ __forceinline__ void mid(f32x4 (&)[2][2][4][2], const Unit&, int, int, int, int) const {}
    __device__ __forceinline__ void operator()(const f32x4 (&acc)[2][2][4][2], const Unit& u, int wr, int wc, int fr, int fq) const {
        { const int l_ = lane_id_opaque(); fr = l_ & 15; fq = l_ >> 4; }
        const int row0 = u.pm * BM + wr * 64 + fr, col0 = u.pn * HALF + wc * 32 + 8 * fq;
#pragma unroll
        for (int ai = 0; ai < 2; ++ai)
#pragma unroll
            for (int m = 0; m < 4; ++m) { const size_t row = (size_t)(row0 + ai * HALF + m * 16);
                const f32x4 g0 = acc[ai][0][m][0], g1 = acc[ai][0][m][1], u0 = acc[ai][1][m][0], u1 = acc[ai][1][m][1];
                f32x4 h0, h1;
#pragma unroll
                for (int e = 0; e < 4; ++e) { h0[e] = g0[e] * sigm(g0[e]) * u0[e]; h1[e] = g1[e] * sigm(g1[e]) * u1[e]; }
                *(u32x4*)(O + row * 2816 + col0) = pack8(h0, h1); }
    }
};
template <class Epi, class Sched, bool ALIGN_EPI = false, bool SP2 = false>
__device__ __forceinline__ void gemm_phase(PG8_LAS unsigned char* lds, const Gemm g, const Sched& S, const Epi& E, int wid) {
    const int lane = lane_id_opaque(), tid = wid * 64 + lane, wr = wid >> 2, wc = wid & 3, fr = lane & 15, fq = lane >> 4;
    const int K = g.K, nt = K / BK;
    unsigned voffA[2], voffB[2];
#pragma unroll
    for (int i = 0; i < 2; ++i) { int R, C; stage_rc(tid * 16 + i * 8192, R, C); const int Rb = Epi::PERM ? ((R & ~31) + perm32(R & 31)) : R;
        voffA[i] = (unsigned)(R * K + C) * 2u; voffB[i] = (unsigned)(Rb * K + C) * 2u; }
    const size_t kstep = (size_t)(BK * 2);
    const size_t hstep = (size_t)HALF * K * 2;
    const size_t tstep = 2 * hstep;
    const unsigned ldsw = (unsigned)wid * 1024u;
    const int aoff = lds_byte(wr * 64 + fr, fq * 8), boff = lds_byte(wc * 32 + fr, fq * 8);
#define PG8_SA(b, h) (((b) * 2 + (h)) * HTB)
#define PG8_SB(b, h) ((4 + (b) * 2 + (h)) * HTB)
#define PG8_STAGE(bufoff, gbase, voff) do { _Pragma("unroll") for (int _i = 0; _i < 2; ++_i) \
        __builtin_amdgcn_global_load_lds((const unsigned*)((const char*)(gbase) + (voff)[_i]), (PG8_LAS unsigned*)(lds + (bufoff) + ldsw + _i * 8192), 16, 0, 0); } while (0)
#define PG8_LDA(dst, b, h) do { _Pragma("unroll") for (int m = 0; m < 4; ++m) _Pragma("unroll") for (int k = 0; k < 2; ++k) dst[m][k] = *(const PG8_LAS bf16x8*)(lds + PG8_SA(b, h) + aoff + m * 2048 + k * 1024); } while (0)
#define PG8_LDB(dst, b, h) do { _Pragma("unroll") for (int n = 0; n < 2; ++n) _Pragma("unroll") for (int k = 0; k < 2; ++k) dst[n][k] = *(const PG8_LAS bf16x8*)(lds + PG8_SB(b, h) + boff + n * 2048 + k * 1024); } while (0)
#define PG8_MMA(ai, bj, At, Bt) do { __builtin_amdgcn_s_setprio(1); _Pragma("unroll") for (int m = 0; m < 4; ++m) _Pragma("unroll") for (int n = 0; n < 2; ++n) _Pragma("unroll") for (int k = 0; k < 2; ++k) \
        acc[ai][bj][m][n] = __builtin_amdgcn_mfma_f32_16x16x32_bf16(Bt[n][k], At[m][k], acc[ai][bj][m][n], 0, 0, 0); __builtin_amdgcn_s_setprio(0); } while (0)
#define PG8_WAIT_V(n) asm volatile("s_waitcnt vmcnt(" #n ")" ::: "memory")
#define PG8_WAIT_L(n) asm volatile("s_waitcnt lgkmcnt(" #n ")" ::: "memory")
#define PG8_WAIT_RLXC() PG8_WAIT_V(8)
#define PG8_BAR __builtin_amdgcn_s_barrier()
#define PG8_SCHED __builtin_amdgcn_sched_barrier(0)
    Unit cur, nxt; int ui = 0;
    if (!S.next(0, cur)) return;
    f32x4 acc[2][2][4][2];
#pragma unroll
    for (int a = 0; a < 2; ++a)
#pragma unroll
        for (int b = 0; b < 2; ++b)
#pragma unroll
            for (int m = 0; m < 4; ++m)
#pragma unroll
                for (int n = 0; n < 2; ++n) acc[a][b][m][n] = (f32x4){0.f, 0.f, 0.f, 0.f};
    bf16x8 At[4][2], B0[2][2], B1[2][2];
    const char* cA = (const char*)g.A + (size_t)cur.pm * tstep; const char* cB = (const char*)g.Bt + (size_t)cur.pn * tstep;
    S.a_ready(cur);
    if constexpr (SP2) {
        PG8_STAGE(PG8_SB(0, 0), cB, voffB); PG8_STAGE(PG8_SB(0, 1), cB + hstep, voffB); PG8_STAGE(PG8_SA(0, 0), cA, voffA); PG8_STAGE(PG8_SA(0, 1), cA + hstep, voffA);
        if (wr == 1) PG8_BAR;
        PG8_WAIT_V(2); PG8_BAR;
        PG8_STAGE(PG8_SB(1, 0), cB + kstep, voffB); PG8_STAGE(PG8_SA(1, 0), cA + kstep, voffA); PG8_STAGE(PG8_SB(1, 1), cB + hstep + kstep, voffB);
        PG8_WAIT_V(0); PG8_BAR;
    } else {
        PG8_STAGE(PG8_SB(0, 0), cB, voffB); PG8_STAGE(PG8_SA(0, 0), cA, voffA); PG8_STAGE(PG8_SB(0, 1), cB + hstep, voffB); PG8_STAGE(PG8_SA(0, 1), cA + hstep, voffA);
        if (wr == 1) PG8_BAR;
        PG8_WAIT_V(4); PG8_BAR;
        PG8_STAGE(PG8_SB(1, 0), cB + kstep, voffB); PG8_STAGE(PG8_SA(1, 0), cA + kstep, voffA); PG8_STAGE(PG8_SB(1, 1), cB + hstep + kstep, voffB);
        PG8_WAIT_V(6); PG8_BAR;
    }
    for (;;) {
        const bool has_next = S.next(ui + 1, nxt);
        const char* nA = has_next ? (const char*)g.A + (size_t)nxt.pm * tstep : cA; const char* nB = has_next ? (const char*)g.Bt + (size_t)nxt.pn * tstep : cB;
#define PG8_ITER(T, WAITV) do { const int t = (T); \
            const bool last = (t == nt - 2); \
            if constexpr (Epi::MID) { if (t == (nt >> 1)) E.mid(acc, cur, wr, wc, fr, fq); } \
            const char* a1 = cA + (size_t)(t + 1) * kstep; \
            const char* a2 = last ? nA : cA + (size_t)(t + 2) * kstep; const char* b2 = last ? nB : cB + (size_t)(t + 2) * kstep; \
            const char* a3 = a2 + kstep; const char* b3 = b2 + kstep; \
            if (last && has_next) S.a_ready(nxt); \
              \
            PG8_LDB(B0, 0, 0); PG8_LDB(B1, 0, 1); PG8_SCHED; PG8_LDA(At, 0, 0); PG8_STAGE(PG8_SA(1, 1), a1 + hstep, voffA); \
            WAITV; PG8_WAIT_L(0); PG8_BAR; PG8_MMA(0, 0, At, B0); PG8_MMA(0, 1, At, B1); PG8_BAR; PG8_SCHED; \
              \
            PG8_LDA(At, 0, 1); PG8_STAGE(PG8_SB(0, 0), b2, voffB); PG8_STAGE(PG8_SB(0, 1), b2 + hstep, voffB); PG8_STAGE(PG8_SA(0, 0), a2, voffA); \
            WAITV; PG8_WAIT_L(0); PG8_BAR; PG8_MMA(1, 0, At, B0); PG8_MMA(1, 1, At, B1); PG8_BAR; PG8_SCHED; \
              \
            PG8_LDB(B0, 1, 0); PG8_LDB(B1, 1, 1); PG8_SCHED; PG8_LDA(At, 1, 0); PG8_STAGE(PG8_SA(0, 1), a2 + hstep, voffA); \
            PG8_WAIT_V(8); PG8_WAIT_L(0); PG8_BAR; PG8_MMA(0, 0, At, B0); PG8_MMA(0, 1, At, B1); PG8_BAR; PG8_SCHED; \
              \
            PG8_LDA(At, 1, 1); PG8_STAGE(PG8_SB(1, 0), b3, voffB); PG8_STAGE(PG8_SB(1, 1), b3 + hstep, voffB); PG8_STAGE(PG8_SA(1, 0), a3, voffA); \
            PG8_WAIT_V(8); PG8_WAIT_L(0); PG8_BAR; PG8_MMA(1, 0, At, B0); PG8_MMA(1, 1, At, B1); PG8_BAR; PG8_SCHED; } while (0)
        static_assert(SP2, "only the SP2 loop is kept");
        PG8_ITER(0, PG8_WAIT_RLXC());
        for (int tt = 2; tt < nt; tt += 2) { PG8_ITER(tt, PG8_WAIT_V(8)); }
        if constexpr (ALIGN_EPI) { if (wr == 0) PG8_BAR; }
        if constexpr (!Epi::AFTER_DRAIN) { E(acc, cur, wr, wc, fr, fq); S.done(cur); }
        if (!has_next) break;
#pragma unroll
        for (int a = 0; a < 2; ++a)
#pragma unroll
            for (int b = 0; b < 2; ++b)
#pragma unroll
                for (int m = 0; m < 4; ++m)
#pragma unroll
                    for (int n = 0; n < 2; ++n) acc[a][b][m][n] = (f32x4){0.f, 0.f, 0.f, 0.f};
        cur = nxt; cA = nA; cB = nB; ++ui;
        if constexpr (ALIGN_EPI) { if (wr == 1) PG8_BAR; }
    }
    PG8_WAIT_V(0);
    if constexpr (!ALIGN_EPI) { if (wr == 0) PG8_BAR; }
    PG8_BAR;
    if constexpr (Epi::AFTER_DRAIN) { E.fused(acc, cur, wr, wc, fr, fq, lds, wid, lane); S.done(cur); }
#undef PG8_SA
#undef PG8_SB
#undef PG8_STAGE
#undef PG8_LDA
#undef PG8_LDB
#undef PG8_MMA
#undef PG8_WAIT_V
#undef PG8_WAIT_L
#undef PG8_WAIT_RLXC
#undef PG8_ITER
#undef PG8_BAR
#undef PG8_SCHED
}
}

constexpr int NWAVES = 8, NTHR = 512;
constexpr int BATCH = 32, SEQ = 2048, D = 1024, M = BATCH * SEQ;
constexpr int INW = 3840, FF = 2816;
constexpr int C_K = 512, C_V = 640, C_U = 768, C_VG = 1280;
constexpr float EPS = 1e-6f, LN_EPS = 1e-5f, LOG2E = 1.4426950408889634f;
constexpr size_t MiB = 1u << 20;
constexpr size_t WS_WIN = 0;
constexpr size_t WS_WAB = 8 * MiB;
constexpr size_t WS_WOUT = 10 * MiB;
constexpr size_t WS_WGU = 12 * MiB;
constexpr size_t WS_WD = 24 * MiB;
constexpr size_t WS_WSP = 30 * MiB;
constexpr size_t WS_CTL = 31 * MiB + 512 * 1024;
constexpr int CTL_BYTES = 3 * 16384, BAR_REGION_WORDS = 4096, MISC_OFF = 147456 - 64;
constexpr size_t WS_RSTD = 31 * MiB;
constexpr size_t WS_SSQA = 32 * MiB;
constexpr size_t WS_SSQB = 36 * MiB;
constexpr size_t WS_XN = 40 * MiB;
constexpr size_t WS_AG = 168 * MiB;
constexpr size_t WS_MG = 296 * MiB;
constexpr size_t WS_PROJ = 424 * MiB;
constexpr size_t WS_HB16 = WS_PROJ + 352 * MiB;
constexpr size_t WS_END = 904 * MiB;
constexpr int LDS_BYTES = 147456;

#define GAS __attribute__((address_space(1)))
#define LAS __attribute__((address_space(3)))
typedef unsigned short bf16;
typedef unsigned v4u __attribute__((ext_vector_type(4)));
typedef unsigned v2u __attribute__((ext_vector_type(2)));
typedef float f32x4 __attribute__((ext_vector_type(4)));
typedef float f32x16 __attribute__((ext_vector_type(16)));
typedef short bf16x8 __attribute__((ext_vector_type(8)));
typedef short s16x4 __attribute__((ext_vector_type(4)));
using pg8::cvtpk; using pg8::bflo; using pg8::bfhi;
#define LDS_WAIT() asm volatile("s_waitcnt lgkmcnt(0)" ::: "memory")
__device__ __forceinline__ unsigned short f2bf(float f) { return (unsigned short)(cvtpk(f, 0.f) & 0xffffu); }
__device__ __forceinline__ float bf2f(unsigned short h) { return __uint_as_float((unsigned)h << 16); }
__device__ __forceinline__ float wave_sum(float v) {
#pragma unroll
    for (int o = 1; o < 64; o <<= 1) v += __shfl_xor(v, o);
    return v;
}
__device__ __forceinline__ int crow(int r, int hi) { return (r & 3) + 8 * (r >> 2) + 4 * hi; }

struct Frame {
    LAS unsigned char* lds;
    int tid, lane, wave, G, bid;
    const float* in[17]; float* out; unsigned char* ws;
};
__device__ __forceinline__ int rowmap(int mode, int n) { return mode == 0 ? n : (((n >> 7) << 8) + (n & 127) + (mode == 2 ? 128 : 0)); }
__device__ __forceinline__ void p0_transpose_item(const float* W, int N, bf16* WT, int ldk, int koff, int mode, LAS float* scr, int item, int lane, const float* kscale = nullptr) {
    const int nblk = N / 32, kb = item / nblk, nb = item % nblk, k0 = 64 * kb, n0 = 32 * nb;
#pragma unroll 8
    for (int i = 0; i < 32; ++i) { const int kk = 2 * i + (lane >> 5); float w = W[(size_t)(k0 + kk) * N + n0 + (lane & 31)]; if (kscale) w *= kscale[k0 + kk]; scr[kk * 33 + (lane & 31)] = w; }
    LDS_WAIT(); asm volatile("" ::: "memory");
    const int c = lane & 7;
#pragma unroll
    for (int j = 0; j < 4; ++j) { const int n = (lane >> 3) + 8 * j; const LAS float* s = scr + (8 * c) * 33 + n;
        v4u o; o.x = cvtpk(s[0 * 33], s[1 * 33]); o.y = cvtpk(s[2 * 33], s[3 * 33]); o.z = cvtpk(s[4 * 33], s[5 * 33]); o.w = cvtpk(s[6 * 33], s[7 * 33]);
        *(GAS v4u*)(WT + (size_t)rowmap(mode, n0 + n) * ldk + koff + k0 + 8 * c) = o; }
    LDS_WAIT(); asm volatile("" ::: "memory");
}
__device__ __forceinline__ void rms_row_to_bf16(int lane, const float* xrow, float* rstd_out, bf16* orow) {
    const GAS f32x4* xr = (const GAS f32x4*)xrow + lane;
    f32x4 v[4]; float s = 0.f;
#pragma unroll
    for (int j = 0; j < 4; ++j) { v[j] = xr[64 * j]; s += (v[j].x * v[j].x + v[j].y * v[j].y) + (v[j].z * v[j].z + v[j].w * v[j].w); }
    const float rstd = 1.0f / sqrtf(wave_sum(s) * (1.f / D) + EPS);
    if (lane == 0) *rstd_out = rstd;
    GAS v2u* o8 = (GAS v2u*)orow + lane;
#pragma unroll
    for (int j = 0; j < 4; ++j) { v2u w; w.x = cvtpk(v[j].x * rstd, v[j].y * rstd); w.y = cvtpk(v[j].z * rstd, v[j].w * rstd); o8[64 * j] = w; }
}
__device__ __forceinline__ void rms_vals_to_bf16(int lane, const f32x4 (&v)[4], float* rstd_out, bf16* orow) {
    float s = 0.f;
#pragma unroll
    for (int j = 0; j < 4; ++j) s += (v[j].x * v[j].x + v[j].y * v[j].y) + (v[j].z * v[j].z + v[j].w * v[j].w);
    const float rstd = 1.0f / sqrtf(wave_sum(s) * (1.f / D) + EPS);
    if (lane == 0) *rstd_out = rstd;
    GAS v2u* o8 = (GAS v2u*)orow + lane;
#pragma unroll
    for (int j = 0; j < 4; ++j) { v2u w; w.x = cvtpk(v[j].x * rstd, v[j].y * rstd); w.y = cvtpk(v[j].z * rstd, v[j].w * rstd); o8[64 * j] = w; }
}
__device__ __forceinline__ void p0_weights(Frame& F) {
    LAS float* scr = (LAS float*)(F.lds + F.wave * 16384);
    const int gw = F.bid * NWAVES + F.wave, NGW = F.G * NWAVES;
    unsigned char* ws = F.ws;
    constexpr int I_IN = (1024 / 64) * (INW / 32), I_A = (512 / 64) * (1024 / 32), I_O = (1024 / 64) * (1024 / 32), I_G = (1024 / 64) * (FF / 32), I_D = (FF / 64) * (1024 / 32);
    constexpr int NITEMS = I_IN + 2 * I_A + I_O + 2 * I_G + I_D;
    for (int it = gw; it < NITEMS; it += NGW) {
        int r = it;
        if (r < I_IN) { p0_transpose_item(F.in[2], INW, (bf16*)(ws + WS_WIN), 1024, 0, 0, scr, r, F.lane, F.in[1]); continue; } r -= I_IN;
        if (r < I_A) { p0_transpose_item(F.in[8], 1024, (bf16*)(ws + WS_WAB), 1024, 0, 0, scr, r, F.lane); continue; } r -= I_A;
        if (r < I_A) { p0_transpose_item(F.in[9], 1024, (bf16*)(ws + WS_WAB), 1024, 512, 0, scr, r, F.lane); continue; } r -= I_A;
        if (r < I_O) { p0_transpose_item(F.in[10], 1024, (bf16*)(ws + WS_WOUT), 1024, 0, 0, scr, r, F.lane); continue; } r -= I_O;
        if (r < I_G) { p0_transpose_item(F.in[13], FF, (bf16*)(ws + WS_WGU), 1024, 0, 1, scr, r, F.lane); continue; } r -= I_G;
        if (r < I_G) { p0_transpose_item(F.in[14], FF, (bf16*)(ws + WS_WGU), 1024, 0, 2, scr, r, F.lane); continue; } r -= I_G;
        p0_transpose_item(F.in[15], 1024, (bf16*)(ws + WS_WD), FF, 0, 0, scr, r, F.lane);
    }
    { const float* wsrc = F.in[6]; bf16* wdst = (bf16*)(ws + WS_WSP);
      for (int i = gw * 64 + F.lane; i < 4 * 128 * 128; i += NGW * 64) { const int t = (i >> 7) & 127, s = i & 127; wdst[i] = f2bf(s <= t ? wsrc[i] : 0.f); } }
}
__device__ __forceinline__ void p0_rows(Frame& F, const float* x, float* RSTD, bf16* XN, int MT) {
    const int gw = F.bid * NWAVES + F.wave, NGW = F.G * NWAVES;
    for (int m = gw; m < MT; m += 2 * NGW) { const int m2 = (m + NGW < MT) ? m + NGW : m;
        const GAS f32x4* xa = (const GAS f32x4*)(x + (size_t)m * D) + F.lane; const GAS f32x4* xb = (const GAS f32x4*)(x + (size_t)m2 * D) + F.lane;
        f32x4 va[4], vb[4];
#pragma unroll
        for (int j = 0; j < 4; ++j) { va[j] = xa[64 * j]; vb[j] = xb[64 * j]; }
        rms_vals_to_bf16(F.lane, va, RSTD + m, XN + (size_t)m * D); rms_vals_to_bf16(F.lane, vb, RSTD + m2, XN + (size_t)m2 * D); }
}
constexpr int KS_ROW = 144, VT_ROW = 260  , KS_BYTES = 256 * KS_ROW;
__device__ __forceinline__ void attn_unit(Frame& F, const bf16* PROJ, bf16* AG, const float* sinks, int unit) {
    const int tid = F.tid, lane = F.lane, wave = F.wave, lq = lane & 31, hi = lane >> 5;
    const int kvh = unit & 1, n = (unit >> 1) & 15, b = unit >> 5;
    const long T0 = (long)b * SEQ + n * 128;
    LAS unsigned char* Ks = F.lds; LAS unsigned short* VT = (LAS unsigned short*)(F.lds + KS_BYTES);
    const int jstart = (n == 0) ? 128 : 0;
#pragma unroll
    for (int it = 0; it < 4; ++it) { const int id = it * NTHR + tid, key = id >> 3, ch = id & 7;
        if (key >= jstart) { const bf16* src = PROJ + (T0 - 128 + key) * INW + C_K + kvh * 64 + ch * 8;
            const v4u kv = *(const GAS v4u*)src, vv = *(const GAS v4u*)(src + 128);
            *(LAS v4u*)(Ks + key * KS_ROW + ch * 16) = kv;
            LAS unsigned short* vt = VT + (ch * 8) * VT_ROW + key;
            vt[0 * VT_ROW] = (unsigned short)(vv.x & 0xffffu); vt[1 * VT_ROW] = (unsigned short)(vv.x >> 16);
            vt[2 * VT_ROW] = (unsigned short)(vv.y & 0xffffu); vt[3 * VT_ROW] = (unsigned short)(vv.y >> 16);
            vt[4 * VT_ROW] = (unsigned short)(vv.z & 0xffffu); vt[5 * VT_ROW] = (unsigned short)(vv.z >> 16);
            vt[6 * VT_ROW] = (unsigned short)(vv.w & 0xffffu); vt[7 * VT_ROW] = (unsigned short)(vv.w >> 16); } }
    __syncthreads();
#pragma unroll 1
    for (int pass = 0; pass < 2; ++pass) {
        int lqo = lq; asm volatile("" : "+v"(lqo));
        const int g = pass * 2 + (wave >> 2), wq = wave & 3, hq = kvh * 4 + g;
        const float slope2 = __builtin_amdgcn_exp2f(-(float)(hq + 1)) * LOG2E, sink2 = sinks[hq] * LOG2E;
        const bf16* qp = PROJ + (T0 + 32 * wq + lq) * INW + hq * 64 + 8 * hi;
        bf16x8 qf[4];
#pragma unroll
        for (int ds = 0; ds < 4; ++ds) qf[ds] = *(const GAS bf16x8*)(qp + 16 * ds);
        f32x16 S[5];
#pragma unroll
        for (int i = 0; i < 5; ++i) { const int kt = wq + i; const bool skip = (n == 0 && kt < 4);
#pragma unroll
            for (int r = 0; r < 16; ++r) S[i][r] = 0.f;
            if (!skip) {
#pragma unroll
                for (int ds = 0; ds < 4; ++ds) { const bf16x8 kf = *(const LAS bf16x8*)(Ks + (32 * kt + lq) * KS_ROW + (16 * ds + 8 * hi) * 2);
                    S[i] = __builtin_amdgcn_mfma_f32_32x32x16_bf16(kf, qf[ds], S[i], 0, 0, 0); } }
            __builtin_amdgcn_sched_barrier(0); }
        float mx = sink2;
#pragma unroll
        for (int i = 0; i < 5; ++i) { const bool skip = (n == 0 && wq + i < 4);
#pragma unroll
            for (int r = 0; r < 16; ++r) { const int rel = 128 - 32 * i + lqo - crow(r, hi);
                const bool valid = !skip && (i == 0 ? rel <= 127 : (i == 4 ? rel >= 0 : true));
                const float lg = valid ? S[i][r] - slope2 * (float)rel : -1e30f; S[i][r] = lg; mx = fmaxf(mx, lg); } }
        mx = fmaxf(mx, __shfl_xor(mx, 32));
        float sum = 0.f;
#pragma unroll
        for (int i = 0; i < 5; ++i)
#pragma unroll
            for (int r = 0; r < 16; ++r) { const float p = __builtin_amdgcn_exp2f(S[i][r] - mx); S[i][r] = p; sum += p; }
        sum += __shfl_xor(sum, 32); sum += __builtin_amdgcn_exp2f(sink2 - mx);
        const float inv = 1.0f / sum;
        f32x16 O[2];
#pragma unroll
        for (int r = 0; r < 16; ++r) { O[0][r] = 0.f; O[1][r] = 0.f; }
#pragma unroll
        for (int i = 0; i < 5; ++i) { const int kt = wq + i; const bool skip = (n == 0 && kt < 4);
            if (!skip) {
#pragma unroll
                for (int s = 0; s < 2; ++s) {
                    v4u pw; pw.x = cvtpk(S[i][8 * s + 0], S[i][8 * s + 1]); pw.y = cvtpk(S[i][8 * s + 2], S[i][8 * s + 3]); pw.z = cvtpk(S[i][8 * s + 4], S[i][8 * s + 5]); pw.w = cvtpk(S[i][8 * s + 6], S[i][8 * s + 7]);
                    const bf16x8 pf = __builtin_bit_cast(bf16x8, pw);
#pragma unroll
                    for (int dt = 0; dt < 2; ++dt) { const LAS unsigned short* vp = VT + (32 * dt + lq) * VT_ROW + 32 * kt + 16 * s + 4 * hi;
                        const s16x4 lo = *(const LAS s16x4*)vp, h8 = *(const LAS s16x4*)(vp + 8);
                        const bf16x8 vf = __builtin_shufflevector(lo, h8, 0, 1, 2, 3, 4, 5, 6, 7);
                        O[dt] = __builtin_amdgcn_mfma_f32_32x32x16_bf16(vf, pf, O[dt], 0, 0, 0); } } }
            __builtin_amdgcn_sched_barrier(0); }
        bf16* op = AG + (T0 + 32 * wq + lq) * 1024 + hq * 64 + 4 * hi;
#pragma unroll
        for (int dt = 0; dt < 2; ++dt)
#pragma unroll
            for (int j = 0; j < 4; ++j) { v2u w; w.x = cvtpk(O[dt][4 * j] * inv, O[dt][4 * j + 1] * inv); w.y = cvtpk(O[dt][4 * j + 2] * inv, O[dt][4 * j + 3] * inv);
                *(GAS v2u*)(op + 32 * dt + 8 * j) = w; }
    }
    __syncthreads();
}
constexpr int GV_ROW = 132;
__device__ __forceinline__ void gmlp_unit(Frame& F, const bf16* PROJ, bf16* AG, const float* ln_g, const float* ln_b, const bf16* WSP, const float* b_s, int unit) {
    const int lane = F.lane, wave = F.wave, lq = lane & 31, hi = lane >> 5;
    const int n = unit & 15, b = unit >> 4; const long T0 = (long)b * SEQ + n * 128;
    LAS unsigned short* VT = (LAS unsigned short*)F.lds;
    float gch[8], bch[8];
#pragma unroll
    for (int i = 0; i < 8; ++i) { gch[i] = ln_g[lane + 64 * i]; bch[i] = ln_b[lane + 64 * i]; }
#pragma unroll 1
    for (int hb = 0; hb < 2; ++hb) {
        unsigned short raw[8][8];
#pragma unroll
        for (int tk = 0; tk < 8; ++tk) { const bf16* vp = PROJ + (T0 + 16 * wave + 8 * hb + tk) * INW + C_VG + lane;
#pragma unroll
            for (int i = 0; i < 8; ++i) raw[tk][i] = vp[64 * i]; }
#pragma unroll
        for (int tk = 0; tk < 8; ++tk) { const int s = 16 * wave + 8 * hb + tk;
            float x[8]; float sm = 0.f;
#pragma unroll
            for (int i = 0; i < 8; ++i) { x[i] = bf2f(raw[tk][i]); sm += x[i]; }
            const float mean = wave_sum(sm) * (1.f / 512.f); float q = 0.f;
#pragma unroll
            for (int i = 0; i < 8; ++i) { x[i] -= mean; q += x[i] * x[i]; }
            const float rstd = 1.0f / sqrtf(wave_sum(q) * (1.f / 512.f) + LN_EPS);
#pragma unroll
            for (int i = 0; i < 8; ++i) VT[(lane + 64 * i) * GV_ROW + s] = f2bf(x[i] * rstd * gch[i] + bch[i]); } }
    __syncthreads();
    const int g = wave >> 1, cb = g * 128 + 64 * (wave & 1);
    f32x16 acc[2][4];
#pragma unroll
    for (int mt = 0; mt < 2; ++mt)
#pragma unroll
        for (int nt = 0; nt < 4; ++nt)
#pragma unroll
            for (int r = 0; r < 16; ++r) acc[mt][nt][r] = 0.f;
    const bf16* wg = WSP + (size_t)g * 128 * 128 + (size_t)lq * 128 + 8 * hi;
    bf16x8 bcur[4], bnxt[4];
#pragma unroll
    for (int nt = 0; nt < 4; ++nt) { bcur[nt] = *(const GAS bf16x8*)(wg + (size_t)(32 * nt) * 128); bnxt[nt] = bcur[nt]; }
#pragma unroll 1
    for (int ks = 0; ks < 8; ++ks) {
        if (ks < 7) {
#pragma unroll
            for (int nt = 0; nt < 4; ++nt) if (ks + 1 < 2 * (nt + 1)) bnxt[nt] = *(const GAS bf16x8*)(wg + (size_t)(32 * nt) * 128 + 16 * (ks + 1)); }
        bf16x8 af[2];
#pragma unroll
        for (int mt = 0; mt < 2; ++mt) { const LAS unsigned short* ap = VT + (cb + 32 * mt + lq) * GV_ROW + 16 * ks + 8 * hi;
            const s16x4 lo = *(const LAS s16x4*)ap, h8 = *(const LAS s16x4*)(ap + 4); af[mt] = __builtin_shufflevector(lo, h8, 0, 1, 2, 3, 4, 5, 6, 7); }
#pragma unroll
        for (int nt = 0; nt < 4; ++nt) if (ks < 2 * (nt + 1)) {
#pragma unroll
            for (int mt = 0; mt < 2; ++mt) acc[mt][nt] = __builtin_amdgcn_mfma_f32_32x32x16_bf16(af[mt], bcur[nt], acc[mt][nt], 0, 0, 0); }
#pragma unroll
        for (int nt = 0; nt < 4; ++nt) bcur[nt] = bnxt[nt];
    }
#pragma unroll
    for (int nt = 0; nt < 4; ++nt) { const int t = 32 * nt + lq; const float bias = b_s[g * 128 + t];
        const bf16* up = PROJ + (T0 + t) * INW + C_U + cb + 4 * hi; bf16* op = AG + (T0 + t) * 1024 + 512 + cb + 4 * hi;
#pragma unroll
        for (int mt = 0; mt < 2; ++mt)
#pragma unroll
            for (int j = 0; j < 4; ++j) { const v2u uu = *(const GAS v2u*)(up + 32 * mt + 8 * j);
                v2u w; w.x = cvtpk(bflo(uu.x) * (acc[mt][nt][4 * j] + bias), bfhi(uu.x) * (acc[mt][nt][4 * j + 1] + bias));
                w.y = cvtpk(bflo(uu.y) * (acc[mt][nt][4 * j + 2] + bias), bfhi(uu.y) * (acc[mt][nt][4 * j + 3] + bias));
                *(GAS v2u*)(op + 32 * mt + 8 * j) = w; } }
    __syncthreads();
}
__device__ __forceinline__ void unpack8(const v4u mv, f32x4& a, f32x4& b) { a = (f32x4){bflo(mv.x), bfhi(mv.x), bflo(mv.y), bfhi(mv.y)}; b = (f32x4){bflo(mv.z), bfhi(mv.z), bflo(mv.w), bfhi(mv.w)}; }
struct RowIn { v4u a[2], b[2]; float t; };
__device__ __forceinline__ RowIn row_load(int lane, const bf16* arow, const bf16* brow, const float* ssq) {
    RowIn r; r.t = (lane < 16) ? ssq[lane] : 0.f;
#pragma unroll
    for (int j = 0; j < 2; ++j) { const int c = 8 * lane + 512 * j; r.a[j] = *(const GAS v4u*)(arow + c); r.b[j] = *(const GAS v4u*)(brow + c); }
    return r;
}
__device__ __forceinline__ void e1_finish(int lane, const RowIn& in, bf16* xbrow, float rstd_x, const float* gpost, const float* gpre, bf16* hrow) {
    const float t = wave_sum(in.t);
    const float rstd = 1.0f / sqrtf(t * (1.f / D) + EPS), rx = 1.0f / rstd_x;
    f32x4 h[2][2]; float s = 0.f;
#pragma unroll
    for (int j = 0; j < 2; ++j) { const int c = 8 * lane + 512 * j;
        const f32x4 g0 = *(const GAS f32x4*)(gpost + c), g1 = *(const GAS f32x4*)(gpost + c + 4);
        f32x4 m0, m1, x0, x1; unpack8(in.a[j], m0, m1); unpack8(in.b[j], x0, x1);
        h[j][0] = x0 * rx + m0 * rstd * g0; h[j][1] = x1 * rx + m1 * rstd * g1;
        *(GAS v4u*)(hrow + c) = pg8::pack8(h[j][0], h[j][1]);
#pragma unroll
        for (int e = 0; e < 4; ++e) s += h[j][0][e] * h[j][0][e] + h[j][1][e] * h[j][1][e]; }
    const float r2 = 1.0f / sqrtf(wave_sum(s) * (1.f / D) + EPS);
#pragma unroll
    for (int j = 0; j < 2; ++j) { const int c = 8 * lane + 512 * j; const f32x4 g0 = *(const GAS f32x4*)(gpre + c), g1 = *(const GAS f32x4*)(gpre + c + 4);
        *(GAS v4u*)(xbrow + c) = pg8::pack8(h[j][0] * r2 * g0, h[j][1] * r2 * g1); }
}
__device__ __forceinline__ void e2_finish(int lane, const RowIn& in, const float* gpost, float* orow) {
    const float t = wave_sum(in.t);
    const float rstd = 1.0f / sqrtf(t * (1.f / D) + EPS);
#pragma unroll
    for (int j = 0; j < 2; ++j) { const int c = 8 * lane + 512 * j;
        const f32x4 g0 = *(const GAS f32x4*)(gpost + c), g1 = *(const GAS f32x4*)(gpost + c + 4);
        f32x4 m0, m1, x0, x1; unpack8(in.a[j], m0, m1); unpack8(in.b[j], x0, x1);
        *(GAS f32x4*)(orow + c) = x0 + m0 * rstd * g0; *(GAS f32x4*)(orow + c + 4) = x1 + m1 * rstd * g1; }
}
#define XB_TMO      128
#define XB_XCNT(j)  (256  + 64 * (j))
#define XB_XSUB(j)  (1280 + 64 * (j))
#define XB_XGEN(j)  (2304 + 64 * (j))
#define XB_TOP      3328
#define XB_TOPGEN   3392
#define XCD_BAR_WORDS 3456
#define XB_SPIN_CAP (1u << 18)

__device__ __forceinline__ unsigned xb_ld(unsigned* p)              { return __hip_atomic_load(p, __ATOMIC_RELAXED, __HIP_MEMORY_SCOPE_AGENT); }
__device__ __forceinline__ unsigned xb_add(unsigned* p, unsigned v) { return __hip_atomic_fetch_add(p, v, __ATOMIC_RELAXED, __HIP_MEMORY_SCOPE_AGENT); }
__device__ __forceinline__ unsigned xb_xcc_id() { return (unsigned)__builtin_amdgcn_s_getreg((3 << 11) | 20) & 0xFu; }
#define XB_SPIN(cond, bar) do { unsigned _sp = 0; while (cond) { __builtin_amdgcn_s_sleep(1); \
    if ((++_sp & 255u) == 0u) { if (xb_ld(&(bar)[XB_TMO])) break; if (_sp > XB_SPIN_CAP) { atomicAdd(&(bar)[XB_TMO], 1u); break; } } } } while (0)

struct XcdBarrier {
    unsigned* bar; unsigned x; unsigned G;
    volatile LAS unsigned* st;
};

__device__ __forceinline__ XcdBarrier xcd_barrier_post(unsigned* bar, volatile LAS unsigned* st, int wave, unsigned G) {
    XcdBarrier b; b.bar = bar; b.x = xb_xcc_id(); b.st = st; b.G = G;
    if (pg8::lane_id_opaque() == 0 && wave == 0) (void)xb_add(&bar[XB_XCNT(b.x)], 1u);
    return b;
}
__device__ __forceinline__ void xcd_barrier_complete(unsigned* bar, unsigned x, unsigned& nloc, unsigned& nx, const unsigned G) {
    unsigned sum, cnt, mine, sp = 0u;
    for (;;) {
        sum = 0u; cnt = 0u; mine = 0u;
#pragma unroll
        for (unsigned j = 0; j < 16; ++j) { const unsigned c = xb_ld(&bar[XB_XCNT(j)]); sum += c; cnt += (c > 0u) ? 1u : 0u; mine = (j == x) ? c : mine; }
        if (sum == G) break;
        __builtin_amdgcn_s_sleep(1);
        if ((++sp & 255u) == 0u) { if (xb_ld(&bar[XB_TMO])) break; if (sp > XB_SPIN_CAP) { atomicAdd(&bar[XB_TMO], 1u); break; } }
    }
    nloc = mine > 0u ? mine : 1u; nx = cnt > 0u ? cnt : 1u;
}

__device__ __forceinline__ void xcd_barrier(const XcdBarrier& b, int wave) {
    asm volatile("s_waitcnt vmcnt(0)" ::: "memory");
    __syncthreads();
    if (pg8::lane_id_opaque() == 0 && wave == 0) {
        unsigned* bar = b.bar;
        __builtin_amdgcn_s_waitcnt(0);
        unsigned nloc = b.st[0], nx = b.st[1];
        if (nloc == 0u) { xcd_barrier_complete(bar, b.x, nloc, nx, b.G); b.st[0] = nloc; b.st[1] = nx; }
        const unsigned old = xb_add(&bar[XB_XSUB(b.x)], 1u);
        const unsigned gen = old / nloc;
        if (old + 1u == (gen + 1u) * nloc) {
            __builtin_amdgcn_fence(__ATOMIC_RELEASE, "agent");
            asm volatile("s_waitcnt vmcnt(0)" ::: "memory");
            const unsigned og = xb_add(&bar[XB_TOP], 1u);
            const unsigned tg = og / nx;
            if (og + 1u == (tg + 1u) * nx) xb_add(&bar[XB_TOPGEN], 1u);
            else XB_SPIN(xb_ld(&bar[XB_TOPGEN]) == tg, bar);
            __builtin_amdgcn_fence(__ATOMIC_ACQUIRE, "agent");
            xb_add(&bar[XB_XGEN(b.x)], 1u);
            asm volatile("s_waitcnt vmcnt(0)" ::: "memory");
        } else {
            XB_SPIN(xb_ld(&bar[XB_XGEN(b.x)]) == gen, bar);
            __builtin_amdgcn_fence(__ATOMIC_ACQUIRE, "agent");
            asm volatile("s_waitcnt vmcnt(0)" ::: "memory");
        }
    }
    __syncthreads();
}

constexpr int N_PHASES = 9;
struct Args { const float* in[17]; float* out; unsigned char* ws; int ph_lo, ph_hi; };
__global__ void __launch_bounds__(NTHR, 2) fwd_megakernel(Args args) {
    extern __shared__ __attribute__((aligned(16))) unsigned char lds[];
    cg::grid_group grid = cg::this_grid();
    Frame F;
    F.lds = (LAS unsigned char*)lds;
    F.wave = __builtin_amdgcn_readfirstlane(threadIdx.x >> 6);
#define RETID() do { F.lane = pg8::lane_id_opaque(); F.tid = F.wave * 64 + F.lane; } while (0)
    RETID();
    const bool two = (gridDim.x == 256);
    const int team = two ? ((int)(blockIdx.x >> 3) & 1) : 0;
    const int GT = two ? 128 : (int)gridDim.x, tc = two ? (int)((blockIdx.x & 7) + 8 * (blockIdx.x >> 4)) : (int)blockIdx.x;
    const int MT = two ? M / 2 : M; const size_t roff = (size_t)team * (size_t)MT;
    F.G = GT; F.bid = tc;
    const __attribute__((address_space(4))) char* kargp = (const __attribute__((address_space(4))) char*)__builtin_amdgcn_kernarg_segment_ptr();
#define LAZY_IN(k) (F.in[k] = *(const float* const volatile __attribute__((address_space(4)))*)(kargp + 8 * (k)))
    F.out = args.out; F.ws = args.ws;
    unsigned char* ws = args.ws;
    const int lo = args.ph_lo, hi = args.ph_hi;
    volatile LAS unsigned* MISC = (volatile LAS unsigned*)(F.lds + MISC_OFF);
    if (F.tid < 16) MISC[F.tid] = 0u;
    __syncthreads();
    XcdBarrier bar = xcd_barrier_post((unsigned*)(ws + WS_CTL), MISC, F.wave, gridDim.x);
    XcdBarrier tbar = xcd_barrier_post((unsigned*)(ws + WS_CTL) + (1 + team) * BAR_REGION_WORDS, MISC + 2, F.wave, (unsigned)GT);
#define W_IN ((bf16*)(ws + WS_WIN))
#define W_AB ((bf16*)(ws + WS_WAB))
#define W_OUT ((bf16*)(ws + WS_WOUT))
#define W_GU ((bf16*)(ws + WS_WGU))
#define W_D ((bf16*)(ws + WS_WD))
#define W_SP ((bf16*)(ws + WS_WSP))
#define SSQA ((float*)(ws + WS_SSQA) + roff * 16)
#define SSQB ((float*)(ws + WS_SSQB) + roff * 16)
#define RSTDT ((float*)(ws + WS_RSTD) + roff)
#define XN ((bf16*)(ws + WS_XN) + roff * D)
#define AG ((bf16*)(ws + WS_AG) + roff * D)
#define MG ((bf16*)(ws + WS_MG) + roff * D)
#define PROJ ((bf16*)(ws + WS_PROJ) + roff * INW)
#define MIX AG
#define FFO MG
#define HN XN
#define HB PROJ
#define HB16 (PROJ + (size_t)MT * FF)
#define OUT (args.out + roff * D)
#define IN(k) (lo <= (k) && (k) < hi)
    if (hi < 0) grid.sync();
#define SEAM(k) do { if (IN(k) && IN((k) + 1)) xcd_barrier(tbar, F.wave); else __syncthreads(); RETID(); } while (0)

    if (IN(0)) { LAZY_IN(0); LAZY_IN(1); LAZY_IN(2); LAZY_IN(6); LAZY_IN(8); LAZY_IN(9); LAZY_IN(10); LAZY_IN(13); LAZY_IN(14); LAZY_IN(15);
        if (!two || team == 1) p0_weights(F);
        if (!two || team == 0) p0_rows(F, F.in[0] + roff * D, RSTDT, XN, MT);
        xcd_barrier(bar, F.wave); RETID();
        if (two && team == 1) { p0_rows(F, F.in[0] + roff * D, RSTDT, XN, MT); xcd_barrier(tbar, F.wave); RETID(); } }
    if (IN(1)) { pg8::Gemm g{XN, W_IN, MT, INW, D}; pg8::StaticOrder S; S.init(MT, INW, F.G, F.bid); pg8::EpiProj E{PROJ};
        pg8::gemm_phase<pg8::EpiProj, pg8::StaticOrder, true, true>(F.lds, g, S, E, F.wave); }
    SEAM(1);
    if (IN(2)) { LAZY_IN(3); LAZY_IN(4); LAZY_IN(5); LAZY_IN(7);
        for (int u = F.bid; u < MT / 64; u += F.G) attn_unit(F, PROJ, AG, F.in[3], u);
        for (int u = F.bid; u < MT / 128; u += F.G) gmlp_unit(F, PROJ, AG, F.in[4], F.in[5], W_SP, F.in[7], u);
    }
    SEAM(2);
    if (IN(3)) { pg8::Gemm g{AG, W_AB, MT, D, D}; pg8::StaticOrder S; S.init(MT, D, F.G, F.bid); pg8::EpiMerge E{PROJ, MG};
        pg8::gemm_phase<pg8::EpiMerge, pg8::StaticOrder, true, true>(F.lds, g, S, E, F.wave); }
    SEAM(3);
    if (IN(4)) { pg8::Gemm g{MG, W_OUT, MT, D, D}; pg8::StaticOrder S; S.init(MT, D, F.G, F.bid); pg8::EpiSsq E{MIX, SSQA};
        pg8::gemm_phase<pg8::EpiSsq, pg8::StaticOrder, true, true>(F.lds, g, S, E, F.wave); }
    SEAM(4);
    if (IN(5)) { LAZY_IN(11); LAZY_IN(12); const int gw = F.bid * NWAVES + F.wave, NGW = F.G * NWAVES;
        const float* RSTD = RSTDT;
        for (int m = gw; m < MT; m += 4 * NGW) {
            int mm[4]; RowIn rr[4]; float rx[4];
#pragma unroll
            for (int q = 0; q < 4; ++q) { mm[q] = (m + q * NGW < MT) ? m + q * NGW : m; rr[q] = row_load(F.lane, MIX + (size_t)mm[q] * D, HN + (size_t)mm[q] * D, SSQA + (size_t)mm[q] * 16); rx[q] = RSTD[mm[q]]; }
#pragma unroll
            for (int q = 0; q < 4; ++q) e1_finish(F.lane, rr[q], HN + (size_t)mm[q] * D, rx[q], F.in[11], F.in[12], HB16 + (size_t)mm[q] * D); } }
    SEAM(5);
    if (IN(6)) { pg8::Gemm g{HN, W_GU, MT, 2 * FF, D}; pg8::StaticOrder S; S.init(MT, 2 * FF, F.G, F.bid); pg8::EpiSwiglu E{HB};
        pg8::gemm_phase<pg8::EpiSwiglu, pg8::StaticOrder, true, true>(F.lds, g, S, E, F.wave); }
    SEAM(6);
    if (IN(7)) { pg8::Gemm g{HB, W_D, MT, D, FF}; pg8::StaticOrder S; S.init(MT, D, F.G, F.bid); pg8::EpiSsq E{FFO, SSQB};
        pg8::gemm_phase<pg8::EpiSsq, pg8::StaticOrder, true, true>(F.lds, g, S, E, F.wave); }
    SEAM(7);
    if (IN(8)) { LAZY_IN(16); const int gw = F.bid * NWAVES + F.wave, NGW = F.G * NWAVES;
        for (int m = gw; m < MT; m += 4 * NGW) {
            int mm[4]; RowIn rr[4];
#pragma unroll
            for (int q = 0; q < 4; ++q) { mm[q] = (m + q * NGW < MT) ? m + q * NGW : m; rr[q] = row_load(F.lane, FFO + (size_t)mm[q] * D, HB16 + (size_t)mm[q] * D, SSQB + (size_t)mm[q] * 16); }
#pragma unroll
            for (int q = 0; q < 4; ++q) e2_finish(F.lane, rr[q], F.in[16], OUT + (size_t)mm[q] * D); } }
#undef IN
#undef SEAM
}

extern "C" void kernel_launch(void* const* d_in, const int* in_sizes, int n_in, void* d_out, int out_size, void* d_ws, size_t ws_size, hipStream_t stream) {
    static int grid = 0;
    if (grid == 0) {
        if (n_in != 17 || out_size != M * D || ws_size < WS_END) { fprintf(stderr, "kernel_launch: unexpected problem: n_in %d out %d ws %zu\n", n_in, out_size, ws_size); grid = -1; return; }
        int dev = 0, cus = 0, per_cu = 0;
        (void)hipGetDevice(&dev); (void)hipDeviceGetAttribute(&cus, hipDeviceAttributeMultiprocessorCount, dev);
        if (hipFuncSetAttribute((const void*)fwd_megakernel, hipFuncAttributeMaxDynamicSharedMemorySize, LDS_BYTES) != hipSuccess) fprintf(stderr, "kernel_launch: hipFuncSetAttribute failed\n");
        if (hipOccupancyMaxActiveBlocksPerMultiprocessor(&per_cu, (const void*)fwd_megakernel, NTHR, LDS_BYTES) != hipSuccess || per_cu < 1) { fprintf(stderr, "kernel_launch: occupancy query says %d\n", per_cu); per_cu = 1; }
        (void)hipGetLastError();
        grid = cus * per_cu;
        fprintf(stderr, "kernel_launch: grid %d (cus %d x %d)\n", grid, cus, per_cu);
    }
    if (grid < 0) return;
    if (hipMemsetAsync((char*)d_ws + WS_CTL, 0, CTL_BYTES, stream) != hipSuccess) { fprintf(stderr, "kernel_launch: hipMemsetAsync failed\n"); return; }
    Args a{};
    for (int i = 0; i < 17; ++i) a.in[i] = (const float*)d_in[i];
    a.out = (float*)d_out; a.ws = (unsigned char*)d_ws;
#if MK_N_LAUNCHES == 1
    a.ph_lo = 0; a.ph_hi = N_PHASES;
    void* kargs[] = {&a};
    hipError_t e = hipLaunchCooperativeKernel((const void*)fwd_megakernel, dim3(grid), dim3(NTHR), kargs, LDS_BYTES, stream);
    if (e != hipSuccess) fprintf(stderr, "kernel_launch: cooperative launch failed: %s (grid %d)\n", hipGetErrorString(e), grid);
#else
    for (int k = 0; k < N_PHASES; ++k) { a.ph_lo = k; a.ph_hi = k + 1;
        hipLaunchKernelGGL(fwd_megakernel, dim3(grid), dim3(NTHR), LDS_BYTES, stream, a);
        const hipError_t le = hipPeekAtLastError(); if (le != hipSuccess) { fprintf(stderr, "kernel_launch: launch %d failed: %s\n", k, hipGetErrorName(le)); break; } }
#endif
}
```
